# Optimizing an MI355X kernel written in HIP

```python
import math
import jax
import jax.numpy as jnp
from jax import lax
import numpy as np

D_MODEL = 1024
BATCH = 2
SEQ = 8192
DEPTH = 2

CHUNK = 64
CONV_K = 4
GDN_HEADS = 4
GDN_DK = 128
GDN_DV = 128
MLSTM_HEADS = 4
MLSTM_DQK = 64
MLSTM_DV = 128
MLSTM_SOFTCAP = 15.0
RWKV_HEADS = 8
RWKV_DH = 64
RWKV_WIDTH = RWKV_HEADS * RWKV_DH
LORA_W = 64
LORA_A = 64
LORA_V = 32
LORA_G = 128
N_BRANCH = 3
BRANCH_WIDTH = 512
D_FF = 2816
N_EXPERTS = 8
TOP_K = 2
D_FF_EXPERT = 3584
MOE_BLOCK = 256
DEEPNORM_ALPHA = (2 * DEPTH) ** 0.25
DEEPNORM_BETA = (8 * DEPTH) ** -0.25
LN_EPS = 1e-5
RWKV_GN_EPS = 64e-5

GDN_SIZES = (GDN_HEADS * GDN_DK, GDN_HEADS * GDN_DK, GDN_HEADS * GDN_DV, GDN_HEADS * GDN_DV, GDN_HEADS, GDN_HEADS)
MLSTM_SIZES = (MLSTM_HEADS * MLSTM_DQK, MLSTM_HEADS * MLSTM_DQK, MLSTM_HEADS * MLSTM_DV, MLSTM_HEADS * MLSTM_DV, MLSTM_HEADS, MLSTM_HEADS)
RWKV_SIZES = (RWKV_WIDTH, RWKV_WIDTH, RWKV_WIDTH, LORA_W, LORA_A, LORA_G)
GATE_SIZES = (D_MODEL,) * N_BRANCH
IN_GROUPS = (sum(GDN_SIZES), sum(MLSTM_SIZES), sum(RWKV_SIZES), sum(GATE_SIZES))
IN_WIDTH = sum(IN_GROUPS)

kernel_name = 'hybrid_gdn_mlstm_rwkv7_moe_deepnorm'


def _split(z, sizes):
    return jnp.split(z, np.cumsum(sizes)[:-1].tolist(), axis=-1)


def _layer_norm(x, g, b):
    xf = x.astype(jnp.float32)
    mu = jnp.mean(xf, -1, keepdims=True)
    var = jnp.mean(jnp.square(xf - mu), -1, keepdims=True)
    return ((xf - mu) * lax.rsqrt(var + LN_EPS)).astype(x.dtype) * g + b


def _head_split(z, n_heads):
    return z.reshape(z.shape[:-1] + (n_heads, z.shape[-1] // n_heads))


def _head_rms(z, n_heads, eps=1e-6):
    zh = _head_split(z, n_heads)
    return zh * lax.rsqrt(jnp.mean(zh * zh, -1, keepdims=True) + eps)


def _l2norm(z, eps=1e-6):
    return z * lax.rsqrt(jnp.sum(z * z, -1, keepdims=True) + eps)


def _to_chunks(z, n_heads):
    b, t, hd = z.shape
    return z.reshape(b, t // CHUNK, CHUNK, n_heads, hd // n_heads).transpose(0, 3, 1, 2, 4)


def _scalar_chunks(s):
    b, t, h = s.shape
    return s.reshape(b, t // CHUNK, CHUNK, h).transpose(0, 3, 1, 2)


def _from_chunks(z):
    b, h, nc, c, d = z.shape
    return z.transpose(0, 2, 3, 1, 4).reshape(b, nc * c, h * d)


def _causal_masks():
    incl = jnp.tril(jnp.ones((CHUNK, CHUNK), bool))
    return incl, jnp.tril(incl, -1)


def _unit_lower_inverse(a):
    eye = jnp.broadcast_to(jnp.eye(CHUNK, dtype=a.dtype), a.shape)
    return lax.linalg.triangular_solve(eye + a, eye, left_side=True, lower=True, unit_diagonal=True)


def _chunk_scan(step, init, xs):
    _, ys = lax.scan(step, init, tuple(jnp.moveaxis(t, 2, 0) for t in xs))
    return jnp.moveaxis(ys, 0, 2)


def _causal_conv(z, w):
    return lax.conv_general_dilated(z, w[:, None, :].astype(z.dtype), window_strides=(1,), padding=((CONV_K - 1, 0),),
                                    dimension_numbers=('NWC', 'WIO', 'NWC'), feature_group_count=z.shape[-1])


def _token_shift(z, mu):
    prev = jnp.pad(z, ((0, 0), (1, 0), (0, 0)))[:, :-1]
    return z + mu * (prev - z)


def _swiglu(h, w_gate, w_up, w_down):
    return (jax.nn.silu(h @ w_gate) * (h @ w_up)) @ w_down


def _gated_deltanet(q, k, v, z, a, b, conv_w, a_log, dt_bias, norm_g):
    f32 = jnp.float32
    hh = GDN_HEADS
    qkv = jax.nn.silu(_causal_conv(jnp.concatenate([q, k, v], -1), conv_w)).astype(f32)
    q, k, v = _split(qkv, GDN_SIZES[:3])
    q = _l2norm(_to_chunks(q, hh)) * GDN_DK ** -0.5
    k = _l2norm(_to_chunks(k, hh))
    v = _to_chunks(v, hh)
    g = _scalar_chunks(-jnp.exp(a_log.astype(f32)) * jax.nn.softplus(a.astype(f32) + dt_bias.astype(f32)))
    beta = _scalar_chunks(jax.nn.sigmoid(b.astype(f32)))
    g = jnp.cumsum(g, -1)
    incl, strict = _causal_masks()
    decay = jnp.exp(jnp.where(incl, g[..., :, None] - g[..., None, :], -jnp.inf))
    kb = k * beta[..., None]
    a_kk = jnp.where(strict, jnp.einsum('bhnck,bhnsk->bhncs', kb, k) * decay, 0.0)
    t_inv = _unit_lower_inverse(a_kk)
    u = jnp.einsum('bhncs,bhnsv->bhncv', t_inv, v * beta[..., None])
    w = jnp.einsum('bhncs,bhnsk->bhnck', t_inv, kb * jnp.exp(g)[..., None])
    qk = jnp.einsum('bhnck,bhnsk->bhncs', q, k) * decay
    q_dec = q * jnp.exp(g)[..., None]
    k_dec = k * jnp.exp(g[..., -1:] - g)[..., None]
    g_last = jnp.exp(g[..., -1])

    def step(s, inp):
        qd, wc, uc, qkc, kd, gl = inp
        v_new = uc - jnp.einsum('bhck,bhkv->bhcv', wc, s)
        o = jnp.einsum('bhck,bhkv->bhcv', qd, s) + jnp.einsum('bhcs,bhsv->bhcv', qkc, v_new)
        s = s * gl[..., None, None] + jnp.einsum('bhck,bhcv->bhkv', kd, v_new)
        return s, o

    s0 = jnp.zeros(q.shape[:2] + (GDN_DK, GDN_DV), f32)
    o = _chunk_scan(step, s0, (q_dec, w, u, qk, k_dec, g_last))
    o = _head_rms(_from_chunks(o), hh) * norm_g.astype(f32)
    return (o.reshape(o.shape[:2] + (-1,)) * jax.nn.silu(z.astype(f32))).astype(z.dtype)


def _mlstm(q, k, v, o_pre, i_pre, f_pre, b_i, b_f, norm_g):
    f32 = jnp.float32
    hh = MLSTM_HEADS
    q = _to_chunks(q.astype(f32), hh)
    k = _to_chunks(k.astype(f32), hh) * MLSTM_DQK ** -0.5
    v = _to_chunks(v.astype(f32), hh)
    cap = lambda t: MLSTM_SOFTCAP * jnp.tanh(t / MLSTM_SOFTCAP)
    log_i = _scalar_chunks(cap(i_pre.astype(f32) + b_i.astype(f32)))
    log_f = _scalar_chunks(jax.nn.log_sigmoid(cap(f_pre.astype(f32) + b_f.astype(f32))))
    bcum = jnp.cumsum(log_f, -1)
    incl, _ = _causal_masks()
    log_d = jnp.where(incl, bcum[..., :, None] - bcum[..., None, :] + log_i[..., None, :], -jnp.inf)
    m_intra = jnp.max(log_d, -1)
    p = jnp.exp(log_d - m_intra[..., None]) * jnp.einsum('bhnck,bhnsk->bhncs', q, k)
    num_intra = jnp.einsum('bhncs,bhnsv->bhncv', p, v)
    den_intra = jnp.sum(p, -1)
    log_e = bcum[..., -1:] - bcum + log_i
    m_end = jnp.max(log_e, -1)
    k_w = k * jnp.exp(log_e - m_end[..., None])[..., None]
    b_last = bcum[..., -1]

    def step(carry, inp):
        cs, ns, m = carry
        qc, bc, mi, numi, deni, kw, vc, me, bl = inp
        m_t = jnp.maximum(bc + m[..., None], mi)
        s_inter = jnp.exp(bc + m[..., None] - m_t)
        s_intra = jnp.exp(mi - m_t)
        num = s_inter[..., None] * jnp.einsum('bhck,bhkv->bhcv', qc, cs) + s_intra[..., None] * numi
        den = s_inter * jnp.einsum('bhck,bhk->bhc', qc, ns) + s_intra * deni
        hc = num / jnp.maximum(jnp.abs(den), jnp.exp(-m_t))[..., None]
        m_new = jnp.maximum(bl + m, me)
        s_old = jnp.exp(bl + m - m_new)
        s_new = jnp.exp(me - m_new)
        cs = s_old[..., None, None] * cs + s_new[..., None, None] * jnp.einsum('bhck,bhcv->bhkv', kw, vc)
        ns = s_old[..., None] * ns + s_new[..., None] * jnp.sum(kw, -2)
        return (cs, ns, m_new), hc

    bh = q.shape[:2]
    init = (jnp.zeros(bh + (MLSTM_DQK, MLSTM_DV), f32), jnp.zeros(bh + (MLSTM_DQK,), f32), jnp.zeros(bh, f32))
    hs = _chunk_scan(step, init, (q, bcum, m_intra, num_intra, den_intra, k_w, v, m_end, b_last))
    hs = _head_rms(_from_chunks(hs), hh) * norm_g.astype(f32).reshape(hh, MLSTM_DV)
    return (hs.reshape(hs.shape[:2] + (-1,)) * jax.nn.sigmoid(o_pre.astype(f32))).astype(o_pre.dtype)


def _rwkv7(r, k, v, x_w, x_a, x_g, w0, w2, a0, a2, g2, k_k, k_a, r_k, lnx_g, lnx_b, v_first, v_mix):
    f32 = jnp.float32
    hh = RWKV_HEADS
    r, k, v = r.astype(f32), k.astype(f32), v.astype(f32)
    log_w = -jnp.exp(-jax.nn.softplus(-(w0.astype(f32) + jnp.tanh(x_w.astype(f32)) @ w2.astype(f32))) - 0.5)
    a = jax.nn.sigmoid(a0.astype(f32) + x_a.astype(f32) @ a2.astype(f32))
    if v_mix is None:
        v_first = v
    else:
        x_v, v0, v2 = v_mix
        v = v + (v_first - v) * jax.nn.sigmoid(v0.astype(f32) + x_v.astype(f32) @ v2.astype(f32))
    g = jax.nn.sigmoid(x_g.astype(f32)) @ g2.astype(f32)
    kk = _l2norm(_head_split(k * k_k.astype(f32), hh)).reshape(k.shape)
    k = k * (1.0 + (a - 1.0) * k_a.astype(f32))
    rc, kc, vc, kkc, ac, lwc = (_to_chunks(t, hh) for t in (r, k, v, kk, a, log_w))
    alpha, beta = -kkc, kkc * ac
    lw = jnp.cumsum(lwc, 3)
    lw_ex = lw - lwc
    lw_last = lw[..., -1:, :]
    inv = jnp.exp(-lw)
    al_bar = alpha * jnp.exp(lw_ex)
    be_hat, k_hat = beta * inv, kc * inv
    r_bar = rc * jnp.exp(lw)
    incl, strict = _causal_masks()
    dots = lambda p, q: jnp.einsum('bhnck,bhnsk->bhncs', p, q)
    mix = lambda m, z: jnp.einsum('bhncs,bhnsd->bhncd', m, z)
    l_ab = jnp.where(strict, dots(al_bar, be_hat), 0.0)
    l_ak = jnp.where(strict, dots(al_bar, k_hat), 0.0)
    q_rb = jnp.where(incl, dots(r_bar, be_hat), 0.0)
    q_rk = jnp.where(incl, dots(r_bar, k_hat), 0.0)
    t_inv = _unit_lower_inverse(-l_ab)
    w_u = mix(t_inv, al_bar)
    u0 = mix(t_inv, mix(l_ak, vc))
    y_k = mix(q_rk, vc)
    to_end = jnp.exp(lw_last - lw)
    be_end, k_end = beta * to_end, kc * to_end
    g_chunk = jnp.exp(lw_last[..., 0, :])

    def step(s, inp):
        wu, u0c, rb, qrb, ykc, bec, kec, vcc, gc = inp
        u = jnp.einsum('bhck,bhkv->bhcv', wu, s) + u0c
        y = jnp.einsum('bhck,bhkv->bhcv', rb, s) + jnp.einsum('bhcs,bhsv->bhcv', qrb, u) + ykc
        s = gc[..., :, None] * s + jnp.einsum('bhck,bhcv->bhkv', bec, u) + jnp.einsum('bhck,bhcv->bhkv', kec, vcc)
        return s, y

    s0 = jnp.zeros(rc.shape[:2] + (RWKV_DH, RWKV_DH), f32)
    y = _from_chunks(_chunk_scan(step, s0, (w_u, u0, r_bar, q_rb, y_k, be_end, k_end, vc, g_chunk)))
    yh = _head_split(y, hh)
    mu = jnp.mean(yh, -1, keepdims=True)
    var = jnp.mean(jnp.square(yh - mu), -1, keepdims=True)
    y = ((yh - mu) * lax.rsqrt(var + RWKV_GN_EPS)).reshape(y.shape) * lnx_g.astype(f32) + lnx_b.astype(f32)
    bonus = jnp.sum(_head_split(r * k * r_k.astype(f32).reshape(-1), hh), -1, keepdims=True) * _head_split(v, hh)
    y = (y + bonus.reshape(y.shape)) * g
    return y.astype(x_w.dtype), v_first


def _mixer_sublayer(h, w_in, gdn_conv, gdn_a_log, gdn_dt_bias, gdn_norm_g, mlstm_b_i, mlstm_b_f, mlstm_norm_g,
                    rwkv_mu, rwkv_w0, rwkv_w2, rwkv_a0, rwkv_a2, rwkv_g2, rwkv_k_k, rwkv_k_a, rwkv_r_k,
                    rwkv_lnx_g, rwkv_lnx_b, w_branch, w_o, v_first, v_res):
    w = w_in if v_res is None else jnp.concatenate([w_in, v_res[0]], axis=1)
    z_all = h @ w
    z, z_v = z_all[..., :IN_WIDTH], z_all[..., IN_WIDTH:]
    z_gdn, z_mlstm, z_rwkv, z_gate = _split(z, IN_GROUPS)
    gq, gk, gv, gz, ga, gb = _split(z_gdn, GDN_SIZES)
    y_a = _gated_deltanet(gq, gk, gv, gz, ga, gb, gdn_conv, gdn_a_log, gdn_dt_bias, gdn_norm_g)
    mq, mk, mv, mo, mi, mf = _split(z_mlstm, MLSTM_SIZES)
    y_b = _mlstm(mq, mk, mv, mo, mi, mf, mlstm_b_i, mlstm_b_f, mlstm_norm_g)
    rr, rk, rv, rw, ra, rg = _split(_token_shift(z_rwkv, rwkv_mu), RWKV_SIZES)
    v_mix = None if v_res is None else (_token_shift(z_v, v_res[1]), v_res[2], v_res[3])
    y_c, v_first = _rwkv7(rr, rk, rv, rw, ra, rg, rwkv_w0, rwkv_w2, rwkv_a0, rwkv_a2, rwkv_g2, rwkv_k_k, rwkv_k_a,
                          rwkv_r_k, rwkv_lnx_g, rwkv_lnx_b, v_first, v_mix)
    gate_a, gate_b, gate_c = _split(jax.nn.sigmoid(z_gate), GATE_SIZES)
    merged = gate_a * (y_a @ w_branch[0]) + gate_b * (y_b @ w_branch[1]) + gate_c * (y_c @ w_branch[2])
    return merged @ w_o, v_first


def _moe_swiglu(h, router_w, router_b, w_gate, w_up, w_down):
    b, t, d = h.shape
    n = b * t
    xf = h.reshape(n, d)
    logits = xf.astype(jnp.float32) @ router_w.astype(jnp.float32) + router_b.astype(jnp.float32)
    top_logit, top_e = lax.top_k(logits, TOP_K)
    gate = jax.nn.softmax(top_logit, axis=-1)
    n_assign = n * TOP_K
    e_flat = top_e.reshape(-1)
    tok_flat = jnp.arange(n_assign, dtype=jnp.int32) // TOP_K
    order = jnp.argsort(e_flat)
    e_sorted = e_flat[order]
    counts = jnp.zeros((N_EXPERTS,), jnp.int32).at[e_flat].add(1)
    padded = (counts + MOE_BLOCK - 1) // MOE_BLOCK * MOE_BLOCK
    pad_end = jnp.cumsum(padded)
    pad_start = pad_end - padded
    start = jnp.cumsum(counts) - counts
    dest = pad_start[e_sorted] + jnp.arange(n_assign, dtype=jnp.int32) - start[e_sorted]
    n_blocks = -(-n_assign // MOE_BLOCK) + N_EXPERTS
    rows = n_blocks * MOE_BLOCK
    row_tok = jnp.full((rows,), n, jnp.int32).at[dest].set(tok_flat[order])
    row_gate = jnp.zeros((rows,), h.dtype).at[dest].set(gate.reshape(-1)[order].astype(h.dtype))
    block_e = jnp.minimum(jnp.searchsorted(pad_end, jnp.arange(n_blocks, dtype=jnp.int32) * MOE_BLOCK, side='right'), N_EXPERTS - 1)
    x_pad = jnp.concatenate([xf, jnp.zeros((1, d), xf.dtype)], 0)
    xb = x_pad[row_tok].reshape(n_blocks, MOE_BLOCK, d)

    def expert_block(args):
        xblk, e = args
        return _swiglu(xblk, w_gate[e], w_up[e], w_down[e])

    yb = lax.map(expert_block, (xb, block_e)).reshape(rows, d)
    y = jnp.zeros((n + 1, d), h.dtype).at[row_tok].add(yb * row_gate[:, None])
    return y[:n].reshape(b, t, d)


def setup_inputs(seed: int = 0) -> dict:
    key = jax.random.key(seed)
    keys = iter(jax.random.split(key, 64))
    f32 = jnp.float32

    def normal(shape, scale):
        return jax.random.normal(next(keys), shape, f32) * scale

    def uniform(shape, lo, hi):
        return jax.random.uniform(next(keys), shape, f32, lo, hi)

    d = D_MODEL
    n_even, n_odd, n_res = (DEPTH + 1) // 2, DEPTH // 2, DEPTH - 1
    dt = jnp.exp(uniform((DEPTH, GDN_HEADS), math.log(1e-3), math.log(1e-1)))
    return {
        'x': normal((BATCH, SEQ, d), 1.0),
        'c': normal((BATCH, d), 1.0),
        'ln_in_g': 1.0 + normal((d,), 0.02),
        'ln_in_b': normal((d,), 0.02),
        'ada_w': normal((DEPTH, d, 6 * d), 0.3 * d ** -0.5),
        'ada_b': normal((DEPTH, 6 * d), 0.02),
        'w_in': normal((DEPTH, d, IN_WIDTH), d ** -0.5),
        'gdn_conv': normal((DEPTH, CONV_K, sum(GDN_SIZES[:3])), CONV_K ** -0.5),
        'gdn_a_log': jnp.log(uniform((DEPTH, GDN_HEADS), 1.0, 16.0)),
        'gdn_dt_bias': dt + jnp.log(-jnp.expm1(-dt)),
        'gdn_norm_g': 1.0 + normal((DEPTH, GDN_DV), 0.02),
        'mlstm_b_i': normal((DEPTH, MLSTM_HEADS), 0.1),
        'mlstm_b_f': jnp.linspace(3.0, 6.0, MLSTM_HEADS, dtype=f32) + normal((DEPTH, MLSTM_HEADS), 0.1),
        'mlstm_norm_g': 1.0 + normal((DEPTH, MLSTM_HEADS * MLSTM_DV), 0.02),
        'rwkv_mu': uniform((DEPTH, sum(RWKV_SIZES)), 0.0, 1.0),
        'rwkv_w0': uniform((DEPTH, RWKV_WIDTH), -6.0, -1.0),
        'rwkv_w2': normal((DEPTH, LORA_W, RWKV_WIDTH), 0.1 * LORA_W ** -0.5),
        'rwkv_a0': normal((DEPTH, RWKV_WIDTH), 0.1),
        'rwkv_a2': normal((DEPTH, LORA_A, RWKV_WIDTH), 0.1 * LORA_A ** -0.5),
        'rwkv_g2': normal((DEPTH, LORA_G, RWKV_WIDTH), LORA_G ** -0.5),
        'rwkv_k_k': 0.85 + normal((DEPTH, RWKV_WIDTH), 0.05),
        'rwkv_k_a': 1.0 + normal((DEPTH, RWKV_WIDTH), 0.05),
        'rwkv_r_k': normal((DEPTH, RWKV_HEADS, RWKV_DH), 0.1),
        'rwkv_lnx_g': 1.0 + normal((DEPTH, RWKV_WIDTH), 0.02),
        'rwkv_lnx_b': normal((DEPTH, RWKV_WIDTH), 0.02),
        'rwkv_v1': normal((n_res, d, LORA_V), d ** -0.5),
        'rwkv_mu_v1': uniform((n_res, LORA_V), 0.0, 1.0),
        'rwkv_v0': 1.0 + normal((n_res, RWKV_WIDTH), 0.1),
        'rwkv_v2': normal((n_res, LORA_V, RWKV_WIDTH), 0.1 * LORA_V ** -0.5),
        'w_branch': normal((DEPTH, N_BRANCH, BRANCH_WIDTH, d), DEEPNORM_BETA * BRANCH_WIDTH ** -0.5),
        'w_o': normal((DEPTH, d, d), DEEPNORM_BETA * d ** -0.5),
        'ln1_g': 1.0 + normal((DEPTH, d), 0.02),
        'ln1_b': normal((DEPTH, d), 0.02),
        'ln2_g': 1.0 + normal((DEPTH, d), 0.02),
        'ln2_b': normal((DEPTH, d), 0.02),
        'ffn_w_gate': normal((n_even, d, D_FF), d ** -0.5),
        'ffn_w_up': normal((n_even, d, D_FF), d ** -0.5),
        'ffn_w_down': normal((n_even, D_FF, d), DEEPNORM_BETA * D_FF ** -0.5),
        'moe_router': normal((n_odd, d, N_EXPERTS), d ** -0.5),
        'moe_router_b': normal((n_odd, N_EXPERTS), 0.01),
        'moe_w_gate': normal((n_odd, N_EXPERTS, d, D_FF_EXPERT), d ** -0.5),
        'moe_w_up': normal((n_odd, N_EXPERTS, d, D_FF_EXPERT), d ** -0.5),
        'moe_w_down': normal((n_odd, N_EXPERTS, D_FF_EXPERT, d), DEEPNORM_BETA * D_FF_EXPERT ** -0.5),
    }


def reference(x, c, ln_in_g, ln_in_b, ada_w, ada_b, w_in, gdn_conv, gdn_a_log, gdn_dt_bias, gdn_norm_g,
              mlstm_b_i, mlstm_b_f, mlstm_norm_g, rwkv_mu, rwkv_w0, rwkv_w2, rwkv_a0, rwkv_a2, rwkv_g2,
              rwkv_k_k, rwkv_k_a, rwkv_r_k, rwkv_lnx_g, rwkv_lnx_b, rwkv_v1, rwkv_mu_v1, rwkv_v0, rwkv_v2,
              w_branch, w_o, ln1_g, ln1_b, ln2_g, ln2_b, ffn_w_gate, ffn_w_up, ffn_w_down,
              moe_router, moe_router_b, moe_w_gate, moe_w_up, moe_w_down):
    x = _layer_norm(x, ln_in_g, ln_in_b)
    cond = jax.nn.silu(c)
    v_first = None
    for layer in range(DEPTH):
        mod = cond @ ada_w[layer] + ada_b[layer]
        sh1, sc1, gt1, sh2, sc2, gt2 = jnp.split(mod[:, None, :], 6, axis=-1)
        v_res = None if layer == 0 else (rwkv_v1[layer - 1], rwkv_mu_v1[layer - 1], rwkv_v0[layer - 1], rwkv_v2[layer - 1])
        y, v_first = _mixer_sublayer(x * (1.0 + sc1) + sh1, w_in[layer], gdn_conv[layer], gdn_a_log[layer],
                                     gdn_dt_bias[layer], gdn_norm_g[layer], mlstm_b_i[layer], mlstm_b_f[layer],
                                     mlstm_norm_g[layer], rwkv_mu[layer], rwkv_w0[layer], rwkv_w2[layer],
                                     rwkv_a0[layer], rwkv_a2[layer], rwkv_g2[layer], rwkv_k_k[layer],
                                     rwkv_k_a[layer], rwkv_r_k[layer], rwkv_lnx_g[layer], rwkv_lnx_b[layer],
                                     w_branch[layer], w_o[layer], v_first, v_res)
        x = _layer_norm(DEEPNORM_ALPHA * x + (1.0 + gt1) * y, ln1_g[layer], ln1_b[layer])
        h = x * (1.0 + sc2) + sh2
        if layer % 2 == 0:
            i = layer // 2
            y = _swiglu(h, ffn_w_gate[i], ffn_w_up[i], ffn_w_down[i])
        else:
            i = layer // 2
            y = _moe_swiglu(h, moe_router[i], moe_router_b[i], moe_w_gate[i], moe_w_up[i], moe_w_down[i])
        x = _layer_norm(DEEPNORM_ALPHA * x + (1.0 + gt2) * y, ln2_g[layer], ln2_b[layer])
    return x
```

```cpp
#include <hip/hip_runtime.h>
#include <hip/hip_cooperative_groups.h>
#include <cstdio>
#include <cstdint>
namespace cg = cooperative_groups;

#ifndef ONE_LAUNCH
#define ONE_LAUNCH 1
#endif

#define LAS __attribute__((address_space(3)))
typedef unsigned short bf16_t;
typedef short bf16x8 __attribute__((ext_vector_type(8)));
typedef float f32x4 __attribute__((ext_vector_type(4)));
typedef float f32x2 __attribute__((ext_vector_type(2)));
typedef unsigned u32x4 __attribute__((ext_vector_type(4)));
typedef unsigned u32x2 __attribute__((ext_vector_type(2)));

constexpr int NTOK = 16384, D = 1024, SEQ = 8192, NB = 2;
constexpr int IN_W = 8464;
constexpr int ZW = 8704;
constexpr int ZC_GQ = 0, ZC_GK = 512, ZC_GV = 1024, ZC_GZ = 1536, ZC_MQ = 2048, ZC_MK = 2304, ZC_MV = 2560, ZC_MO = 3072,
              ZC_RR = 3584, ZC_RK = 4096, ZC_RV = 4608, ZC_RW = 5120, ZC_RA = 5184, ZC_RG = 5248, ZC_GA = 5376, ZC_GB = 5380,
              ZC_MI = 5384, ZC_MF = 5388, ZC_XV = 5392, ZC_GATE = 5632;
constexpr int DFF = 2816, DFFE = 3584, NEXP = 8;
constexpr int MOE_ROWS_MAX = 32768 + NEXP * 256;
constexpr int MOE_RT_MAX = MOE_ROWS_MAX / 256;
constexpr float DN_ALPHA = 1.4142135623730951f;
constexpr float LN_EPS = 1e-5f;

constexpr size_t MB = 1ull << 20;
constexpr size_t WS_CTL = 0;
constexpr size_t WS_MOD = 64 * 1024;
constexpr size_t WS_TOPE = 256 * 1024;
constexpr size_t WS_TOPG = 384 * 1024;
constexpr size_t WS_TOPP = 512 * 1024;
constexpr size_t WS_WIN = 1 * MB;
constexpr size_t WS_WBR = 35 * MB;
constexpr size_t WS_WO = 41 * MB;
constexpr size_t WS_WGU = 45 * MB;
constexpr size_t WS_WD = 56 * MB;
constexpr size_t WS_H = 62 * MB;
constexpr size_t WS_VF = 94 * MB;
constexpr size_t WS_Y = 126 * MB;
constexpr size_t WS_Z = 174 * MB;
constexpr size_t WS_S = 446 * MB;
constexpr size_t WS_YF = WS_S;
constexpr size_t WS_S0 = WS_S, WS_S1 = WS_S + 32 * MB, WS_S2 = WS_S + 64 * MB, WS_S3 = WS_S + 96 * MB, WS_S4 = WS_H;
constexpr size_t WS_ACT0 = WS_Z;
constexpr size_t WS_MACT = 1 * MB;
constexpr size_t WS_MW = 240 * MB;
constexpr size_t WS_MA = 408 * MB;
constexpr size_t WS_MY = 476 * MB;
constexpr size_t WS_END = 544 * MB;
constexpr size_t MW_EXP_BYTES = (size_t)(7168 + 3584) * 1024 * 2;

constexpr int CW_CNT = 0;

__device__ __forceinline__ float bf2f(bf16_t b) { return __uint_as_float(((unsigned)b) << 16); }
__device__ __forceinline__ bf16_t f2bf(float f) { unsigned u = __float_as_uint(f); u += 0x7FFFu + ((u >> 16) & 1u); return (bf16_t)(u >> 16); }
__device__ __forceinline__ unsigned pk2(float lo, float hi) { return (unsigned)f2bf(lo) | ((unsigned)f2bf(hi) << 16); }
__device__ __forceinline__ unsigned cvt_pk_bf16(float lo, float hi) { unsigned r; asm volatile("v_cvt_pk_bf16_f32 %0, %1, %2" : "=v"(r) : "v"(lo), "v"(hi)); return r; }
__device__ __forceinline__ float sigmoidf_(float x) { return 1.f / (1.f + __expf(-x)); }
__device__ __forceinline__ float siluf_(float x) { return x / (1.f + __expf(-x)); }
__device__ __forceinline__ float softplusf_(float x) { return x > 20.f ? x : log1pf(__expf(x)); }
__device__ __forceinline__ float wave_sum(float v) {
#pragma unroll
    for (int o = 1; o < 64; o <<= 1) v += __shfl_xor(v, o);
    return v;
}

struct Job { const float* src; bf16_t* dst; long long src_bs, dst_bs; int K, ld_src, col0, ncols, ld_dst, r0, mode, batch, item0, nitems, pad0, pad1; };
constexpr int NJOBS0 = 20, NJOBS1 = 3, NJOBS = NJOBS0 + NJOBS1;
struct Args {
    const float* in[43];
    float* out;
    unsigned char* ws;
    Job jobs[NJOBS];
    int items0, items1;
    int ph_lo, ph_hi;
};
enum { I_X = 0, I_C, I_LNIN_G, I_LNIN_B, I_ADA_W, I_ADA_B, I_W_IN, I_GDN_CONV, I_GDN_ALOG, I_GDN_DTB, I_GDN_NG, I_ML_BI, I_ML_BF, I_ML_NG,
       I_RW_MU, I_RW_W0, I_RW_W2, I_RW_A0, I_RW_A2, I_RW_G2, I_RW_KK, I_RW_KA, I_RW_RK, I_RW_LNG, I_RW_LNB, I_RW_V1, I_RW_MUV1, I_RW_V0, I_RW_V2,
       I_W_BR, I_W_O, I_LN1_G, I_LN1_B, I_LN2_G, I_LN2_B, I_FFN_G, I_FFN_U, I_FFN_D, I_MOE_R, I_MOE_RB, I_MOE_G, I_MOE_U, I_MOE_D };

namespace pg8 {
constexpr int BM = 256, BK = 64, HALF = 128, HTB = HALF * BK * 2, STAGE_BYTES = 8 * HTB, NXCD = 8, WGM = 8;
__host__ __device__ __forceinline__ int lds_byte(int r, int c) { const int st = (r >> 4) * 2 + (c >> 5), rr = r & 15, cc = c & 31, ob = rr * 64 + cc * 2; return st * 1024 + (ob ^ (((ob >> 9) & 1) << 5)); }
__host__ __device__ __forceinline__ void stage_rc(int b, int& R, int& C) { const int st = b / 1024, sb = b % 1024, swz = sb ^ (((sb >> 9) & 1) << 5); R = (st >> 1) * 16 + swz / 64; C = (st & 1) * 32 + (swz % 64) / 2; }
__host__ __device__ __forceinline__ int perm32(int rho) { const int n = rho >> 4, i = rho & 15; return 8 * (i >> 2) + 4 * n + (i & 3); }

struct Unit { const char* a; const char* b; int pm, pn; };

__device__ __forceinline__ bool static_tile(int i, int G, int c, int nM, int nN, int& pm, int& pn) {
    const int nwg = nM * nN; const long L = (long)i * G + c; if (L >= nwg) return false;
    int wgid = (int)L; { const int q = nwg / NXCD, r = nwg % NXCD, xcd = wgid % NXCD, off = wgid / NXCD; wgid = (xcd < r ? xcd * (q + 1) : r * (q + 1) + (xcd - r) * q) + off; }
    const int nig = WGM * nN, gid = wgid / nig, fm = gid * WGM, gsz = (nM - fm) < WGM ? (nM - fm) : WGM;
    pm = fm + ((wgid % nig) % gsz); pn = (wgid % nig) / gsz; return true;
}
struct StaticOrder {
    const char* A; const char* Bt; int nM, nN, K, G, c;
    __device__ __forceinline__ bool next(int i, Unit& u) const {
        int pm, pn; if (!static_tile(i, G, c, nM, nN, pm, pn)) return false;
        u.pm = pm; u.pn = pn; u.a = A + (size_t)pm * BM * K * 2; u.b = Bt + (size_t)pn * BM * K * 2; return true;
    }
};
struct MoeOrder {
    const char* A; const char* W; const int* tile_exp; size_t wexp_bytes; int nM, nN, K, G, c;
    __device__ __forceinline__ bool next(int i, Unit& u) const {
        int pm, pn; if (!static_tile(i, G, c, nM, nN, pm, pn)) return false;
        const int e = tile_exp[pm];
        u.pm = pm; u.pn = pn; u.a = A + (size_t)pm * BM * K * 2; u.b = W + (size_t)e * wexp_bytes + (size_t)pn * BM * K * 2; return true;
    }
};

struct EpiBf16 {
    static constexpr bool PERM = true, HAS_MID = false;
    bf16_t* O; int ldc;
    __device__ __forceinline__ void mid(f32x4 (&)[2][2][4][2], const Unit&, int, int, int, int, int) const {}
    __device__ __forceinline__ void operator()(const f32x4 (&acc)[2][2][4][2], const Unit& u, int wr, int wc, int fr, int fq) const {
        const int row0 = u.pm * BM + wr * 64 + fr, col0 = u.pn * BM + wc * 32 + 8 * fq;
#pragma unroll
        for (int ai = 0; ai < 2; ++ai)
#pragma unroll
            for (int m = 0; m < 4; ++m) { bf16_t* rowp = O + (size_t)(row0 + ai * HALF + m * 16) * ldc + col0;
#pragma unroll
                for (int bj = 0; bj < 2; ++bj) { const f32x4 v0 = acc[ai][bj][m][0], v1 = acc[ai][bj][m][1];
                    u32x4 w; w.x = cvt_pk_bf16(v0[0], v0[1]); w.y = cvt_pk_bf16(v0[2], v0[3]); w.z = cvt_pk_bf16(v1[0], v1[1]); w.w = cvt_pk_bf16(v1[2], v1[3]);
                    *(u32x4*)(rowp + bj * HALF) = w; } }
    }
};
struct EpiSwiglu {
    static constexpr bool PERM = true, HAS_MID = false;
    bf16_t* O; int ldc;
    __device__ __forceinline__ void mid(f32x4 (&)[2][2][4][2], const Unit&, int, int, int, int, int) const {}
    __device__ __forceinline__ void operator()(const f32x4 (&acc)[2][2][4][2], const Unit& u, int wr, int wc, int fr, int fq) const {
        const int row0 = u.pm * BM + wr * 64 + fr, col0 = u.pn * HALF + wc * 32 + 8 * fq;
#pragma unroll
        for (int ai = 0; ai < 2; ++ai)
#pragma unroll
            for (int m = 0; m < 4; ++m) { bf16_t* rowp = O + (size_t)(row0 + ai * HALF + m * 16) * ldc + col0;
                float r[8];
#pragma unroll
                for (int n = 0; n < 2; ++n)
#pragma unroll
                    for (int j = 0; j < 4; ++j) { const float g = acc[ai][0][m][n][j], uu = acc[ai][1][m][n][j]; r[n * 4 + j] = g * uu * __builtin_amdgcn_rcpf(1.f + __expf(-g)); }
                u32x4 w; w.x = cvt_pk_bf16(r[0], r[1]); w.y = cvt_pk_bf16(r[2], r[3]); w.z = cvt_pk_bf16(r[4], r[5]); w.w = cvt_pk_bf16(r[6], r[7]);
                *(u32x4*)rowp = w; }
    }
};
struct EpiF32 {
    static constexpr bool PERM = false, HAS_MID = false;
    float* C; int ldc;
    __device__ __forceinline__ void mid(f32x4 (&)[2][2][4][2], const Unit&, int, int, int, int, int) const {}
    __device__ __forceinline__ void operator()(const f32x4 (&acc)[2][2][4][2], const Unit& u, int wr, int wc, int fr, int fq) const {
        const int row0 = u.pm * BM + wr * 64 + fr, col0 = u.pn * BM + wc * 32 + 4 * fq;
#pragma unroll
        for (int ai = 0; ai < 2; ++ai)
#pragma unroll
            for (int m = 0; m < 4; ++m) { float* rowp = C + (size_t)(row0 + ai * HALF + m * 16) * ldc + col0;
#pragma unroll
                for (int bj = 0; bj < 2; ++bj)
#pragma unroll
                    for (int n = 0; n < 2; ++n) *(f32x4*)(rowp + bj * HALF + n * 16) = acc[ai][bj][m][n]; }
    }
};
struct EpiMerge {
    static constexpr bool PERM = false, HAS_MID = true;
    const bf16_t* Z; bf16_t* O;
    __device__ __forceinline__ static float ez(bf16_t zb) { float z = bf2f(zb); z = fminf(fmaxf(z, -30.f), 30.f); return __expf(-z); }
    __device__ __forceinline__ void mid(f32x4 (&acc)[2][2][4][2], const Unit& u, int t, int wr, int wc, int fr, int fq) const {
        if (t != 8 && t != 16) return;
        const int gi = (t >> 3);
        const int row0 = u.pm * BM + wr * 64 + fr, col0 = u.pn * BM + wc * 32 + 4 * fq;
#pragma unroll
        for (int ai = 0; ai < 2; ++ai)
#pragma unroll
            for (int m = 0; m < 4; ++m) { const bf16_t* zr = Z + (size_t)(row0 + ai * HALF + m * 16) * ZW + ZC_GATE + col0;
#pragma unroll
                for (int bj = 0; bj < 2; ++bj)
#pragma unroll
                    for (int n = 0; n < 2; ++n) { const unsigned short* p0 = zr + (gi - 1) * 1024 + bj * HALF + n * 16; const unsigned short* p1 = zr + gi * 1024 + bj * HALF + n * 16;
                        const u32x2 a = *(const u32x2*)p0, b = *(const u32x2*)p1;
                        const bf16_t za[4] = {(bf16_t)(a.x & 0xffff), (bf16_t)(a.x >> 16), (bf16_t)(a.y & 0xffff), (bf16_t)(a.y >> 16)};
                        const bf16_t zb[4] = {(bf16_t)(b.x & 0xffff), (bf16_t)(b.x >> 16), (bf16_t)(b.y & 0xffff), (bf16_t)(b.y >> 16)};
#pragma unroll
                        for (int j = 0; j < 4; ++j) acc[ai][bj][m][n][j] *= (1.f + ez(zb[j])) * __builtin_amdgcn_rcpf(1.f + ez(za[j])); }
                asm volatile("" ::: "memory"); }
    }
    __device__ __forceinline__ void operator()(const f32x4 (&acc)[2][2][4][2], const Unit& u, int wr, int wc, int fr, int fq) const {
        const int row0 = u.pm * BM + wr * 64 + fr, col0 = u.pn * BM + wc * 32 + 4 * fq;
#pragma unroll
        for (int ai = 0; ai < 2; ++ai)
#pragma unroll
            for (int m = 0; m < 4; ++m) { const size_t r = (size_t)(row0 + ai * HALF + m * 16); const bf16_t* zr = Z + r * ZW + ZC_GATE + 2048 + col0; bf16_t* orow = O + r * 1024 + col0;
#pragma unroll
                for (int bj = 0; bj < 2; ++bj)
#pragma unroll
                    for (int n = 0; n < 2; ++n) { const u32x2 b = *(const u32x2*)(zr + bj * HALF + n * 16);
                        const bf16_t zb[4] = {(bf16_t)(b.x & 0xffff), (bf16_t)(b.x >> 16), (bf16_t)(b.y & 0xffff), (bf16_t)(b.y >> 16)};
                        float v[4];
#pragma unroll
                        for (int j = 0; j < 4; ++j) v[j] = acc[ai][bj][m][n][j] * __builtin_amdgcn_rcpf(1.f + ez(zb[j]));
                        u32x2 w; w.x = cvt_pk_bf16(v[0], v[1]); w.y = cvt_pk_bf16(v[2], v[3]); *(u32x2*)(orow + bj * HALF + n * 16) = w; }
                asm volatile("" ::: "memory"); }
    }
};

template <class Epi, class Sched>
__device__ __forceinline__ void gemm_phase(LAS unsigned char* lds, const int K, const Sched& S, const Epi& E) {
    int tid_ = threadIdx.x; asm volatile("" : "+v"(tid_));
    const int tid = tid_, wid = __builtin_amdgcn_readfirstlane(tid >> 6), lane = tid & 63, wr = wid >> 2, wc = wid & 3, fr = lane & 15, fq = lane >> 4;
    const int nt = K / BK;
    unsigned voffA[2], voffB[2];
#pragma unroll
    for (int i = 0; i < 2; ++i) { int R, C; stage_rc(tid * 16 + i * 8192, R, C); const int Rb = Epi::PERM ? ((R & ~31) + perm32(R & 31)) : R;
        voffA[i] = (unsigned)(R * K + C) * 2u; voffB[i] = (unsigned)(Rb * K + C) * 2u; }
    const size_t kstep = (size_t)(BK * 2);
    const size_t hstep = (size_t)HALF * K * 2;
    const unsigned ldsw = (unsigned)wid * 1024u;
    const int aoff = lds_byte(wr * 64 + fr, fq * 8), boff = lds_byte(wc * 32 + fr, fq * 8);
#define PG8_SA(b, h) (((b) * 2 + (h)) * HTB)
#define PG8_SB(b, h) ((4 + (b) * 2 + (h)) * HTB)
#define PG8_STAGE(bufoff, gbase, voff) do { _Pragma("unroll") for (int _i = 0; _i < 2; ++_i) \
        __builtin_amdgcn_global_load_lds((const unsigned*)((const char*)(gbase) + (voff)[_i]), (LAS unsigned*)(lds + (bufoff) + ldsw + _i * 8192), 16, 0, 0); } while (0)
#define PG8_LDA(dst, b, h) do { _Pragma("unroll") for (int m = 0; m < 4; ++m) _Pragma("unroll") for (int k = 0; k < 2; ++k) dst[m][k] = *(const LAS bf16x8*)(lds + PG8_SA(b, h) + aoff + m * 2048 + k * 1024); } while (0)
#define PG8_LDB(dst, b, h) do { _Pragma("unroll") for (int n = 0; n < 2; ++n) _Pragma("unroll") for (int k = 0; k < 2; ++k) dst[n][k] = *(const LAS bf16x8*)(lds + PG8_SB(b, h) + boff + n * 2048 + k * 1024); } while (0)
#define PG8_MMA(ai, bj, At, Bt) do { __builtin_amdgcn_s_setprio(1); _Pragma("unroll") for (int m = 0; m < 4; ++m) _Pragma("unroll") for (int n = 0; n < 2; ++n) _Pragma("unroll") for (int k = 0; k < 2; ++k) \
        acc[ai][bj][m][n] = __builtin_amdgcn_mfma_f32_16x16x32_bf16(Bt[n][k], At[m][k], acc[ai][bj][m][n], 0, 0, 0); __builtin_amdgcn_s_setprio(0); } while (0)
#define PG8_WAIT_V(n) asm volatile("s_waitcnt vmcnt(" #n ")" ::: "memory")
#define PG8_WAIT_L(n) asm volatile("s_waitcnt lgkmcnt(" #n ")" ::: "memory")
#define PG8_BAR __builtin_amdgcn_s_barrier()
#define PG8_SCHED __builtin_amdgcn_sched_barrier(0)
    Unit cur, nxt; int ui = 0;
    if (!S.next(0, cur)) return;
    f32x4 acc[2][2][4][2];
#pragma unroll
    for (int a = 0; a < 2; ++a)
#pragma unroll
        for (int b = 0; b < 2; ++b)
#pragma unroll
            for (int m = 0; m < 4; ++m)
#pragma unroll
                for (int n = 0; n < 2; ++n) acc[a][b][m][n] = (f32x4){0.f, 0.f, 0.f, 0.f};
    bf16x8 At[4][2], B0[2][2], B1[2][2];
    const char* cA = cur.a; const char* cB = cur.b;
    PG8_STAGE(PG8_SB(0, 0), cB, voffB); PG8_STAGE(PG8_SA(0, 0), cA, voffA); PG8_STAGE(PG8_SB(0, 1), cB + hstep, voffB); PG8_STAGE(PG8_SA(0, 1), cA + hstep, voffA);
    if (wr == 1) PG8_BAR;
    PG8_WAIT_V(4); PG8_BAR;
    PG8_STAGE(PG8_SB(1, 0), cB + kstep, voffB); PG8_STAGE(PG8_SA(1, 0), cA + kstep, voffA); PG8_STAGE(PG8_SB(1, 1), cB + hstep + kstep, voffB);
    PG8_WAIT_V(6); PG8_BAR;
    for (;;) {
        const bool has_next = S.next(ui + 1, nxt);
        const char* nA = has_next ? nxt.a : cA; const char* nB = has_next ? nxt.b : cB;
        for (int t = 0; t < nt; t += 2) {
            const bool last = (t == nt - 2);
            const char* a1 = cA + (size_t)(t + 1) * kstep;
            const char* a2 = last ? nA : cA + (size_t)(t + 2) * kstep; const char* b2 = last ? nB : cB + (size_t)(t + 2) * kstep;
            const char* a3 = a2 + kstep; const char* b3 = b2 + kstep;
            if constexpr (Epi::HAS_MID) E.mid(acc, cur, t, wr, wc, fr, fq);
            PG8_LDB(B0, 0, 0); PG8_SCHED; PG8_LDA(At, 0, 0); PG8_STAGE(PG8_SA(1, 1), a1 + hstep, voffA);
            PG8_WAIT_L(8); PG8_BAR; PG8_WAIT_L(0); PG8_MMA(0, 0, At, B0); PG8_BAR; PG8_SCHED;
            PG8_LDB(B1, 0, 1); PG8_STAGE(PG8_SB(0, 0), b2, voffB);
            PG8_BAR; PG8_WAIT_L(0); PG8_MMA(0, 1, At, B1); PG8_BAR;
            PG8_LDA(At, 0, 1); PG8_STAGE(PG8_SA(0, 0), a2, voffA);
            PG8_BAR; PG8_WAIT_L(0); PG8_MMA(1, 0, At, B0); PG8_BAR; PG8_SCHED;
            PG8_STAGE(PG8_SB(0, 1), b2 + hstep, voffB);
            PG8_WAIT_V(6); PG8_BAR; PG8_MMA(1, 1, At, B1); PG8_BAR;
            PG8_LDB(B0, 1, 0); PG8_SCHED; PG8_LDA(At, 1, 0); PG8_STAGE(PG8_SA(0, 1), a2 + hstep, voffA);
            PG8_WAIT_L(8); PG8_BAR; PG8_WAIT_L(0); PG8_MMA(0, 0, At, B0); PG8_BAR; PG8_SCHED;
            PG8_LDB(B1, 1, 1); PG8_STAGE(PG8_SB(1, 0), b3, voffB);
            PG8_BAR; PG8_WAIT_L(0); PG8_MMA(0, 1, At, B1); PG8_BAR;
            PG8_LDA(At, 1, 1); PG8_STAGE(PG8_SA(1, 0), a3, voffA);
            PG8_BAR; PG8_WAIT_L(0); PG8_MMA(1, 0, At, B0); PG8_BAR; PG8_SCHED;
            PG8_STAGE(PG8_SB(1, 1), b3 + hstep, voffB);
            PG8_WAIT_V(6); PG8_BAR; PG8_MMA(1, 1, At, B1); PG8_BAR;
        }
        E(acc, cur, wr, wc, fr, fq);
        if (!has_next) break;
#pragma unroll
        for (int a = 0; a < 2; ++a)
#pragma unroll
            for (int b = 0; b < 2; ++b)
#pragma unroll
                for (int m = 0; m < 4; ++m)
#pragma unroll
                    for (int n = 0; n < 2; ++n) acc[a][b][m][n] = (f32x4){0.f, 0.f, 0.f, 0.f};
        cur = nxt; cA = nA; cB = nB; ++ui;
    }
    PG8_WAIT_V(0);
    if (wr == 0) PG8_BAR;
    PG8_BAR;
#undef PG8_SA
#undef PG8_SB
#undef PG8_STAGE
#undef PG8_LDA
#undef PG8_LDB
#undef PG8_MMA
#undef PG8_WAIT_V
#undef PG8_WAIT_L
#undef PG8_BAR
#undef PG8_SCHED
}
}

constexpr int NWAVES = 8, NTHREADS = NWAVES * 64;
constexpr int LDS_BYTES = pg8::STAGE_BYTES;
struct Frame {
    LAS unsigned char* lds;
    int tid, lane, wave, G, bid;
    const Args* a;
    unsigned char* ws;
};
__device__ __forceinline__ const float* lp_(const float* p) { asm volatile("" : "+s"(p)); return p; }
#define INP(i) lp_(F.a->in[i])
#define LAUNDER(F) asm volatile("" : "+v"((F).lane), "+v"((F).tid))

__device__ __forceinline__ void conv_item(const Job& J, int local, LAS float* scr, int lane) {
    const int nkb = J.K / 64, nnb = (J.ncols + 31) / 32, per = nkb * nnb;
    const int bi = local / per, rem = local % per, kb = rem / nnb, nb = rem % nnb, k0 = 64 * kb, n0 = 32 * nb;
    const float* W = J.src + (size_t)bi * J.src_bs; bf16_t* WT = J.dst + (size_t)bi * J.dst_bs;
    const int cl = n0 + (lane & 31); const bool okc = cl < J.ncols;
#pragma unroll 8
    for (int i = 0; i < 32; ++i) { const int kk = 2 * i + (lane >> 5); scr[kk * 33 + (lane & 31)] = okc ? W[(size_t)(k0 + kk) * J.ld_src + J.col0 + cl] : 0.f; }
    asm volatile("s_waitcnt lgkmcnt(0)" ::: "memory");
    const int c = lane & 7;
#pragma unroll
    for (int j = 0; j < 4; ++j) { const int n = (lane >> 3) + 8 * j; const LAS float* s = scr + (8 * c) * 33 + n; const int cc = n0 + n;
        if (cc < J.ncols) { const int drow = J.r0 + (J.mode ? ((cc >> 7) * 256 + (cc & 127)) : cc);
            u32x4 o; o.x = pk2(s[0 * 33], s[1 * 33]); o.y = pk2(s[2 * 33], s[3 * 33]); o.z = pk2(s[4 * 33], s[5 * 33]); o.w = pk2(s[6 * 33], s[7 * 33]);
            *(u32x4*)(WT + (size_t)drow * J.ld_dst + k0 + 8 * c) = o; } }
    asm volatile("s_waitcnt lgkmcnt(0)" ::: "memory");
}
__device__ __forceinline__ void phase_convert(Frame& F, int j0, int j1, int it0, int nitems) {
    LAUNDER(F);
    LAS float* scr = (LAS float*)(F.lds + F.wave * 8704);
    const int gw = F.bid * NWAVES + F.wave, NGW = F.G * NWAVES;
    for (int it = it0 + gw; it < nitems; it += NGW) {
        int j = j0;
        while (j + 1 < j1 && it >= F.a->jobs[j + 1].item0) ++j;
        conv_item(F.a->jobs[j], it - F.a->jobs[j].item0, scr, F.lane);
    }
}

__device__ __forceinline__ void phase_mod(Frame& F) {
    LAUNDER(F);
    float* mod = (float*)(F.ws + WS_MOD);
    LAS float* red = (LAS float*)(F.lds + 72 * 1024);
    const float* cvec = INP(I_C);
    for (int item = F.bid; item < 2 * 96; item += F.G) {
        const int l = item / 96, n0 = (item % 96) * 64;
        const float* W = INP(I_ADA_W) + (size_t)l * 1024 * 6144 + n0 + F.lane;
        float a0 = 0.f, a1 = 0.f;
        const int kbeg = F.wave * 128;
#pragma unroll 8
        for (int k = kbeg; k < kbeg + 128; ++k) { const float w = W[(size_t)k * 6144]; a0 += siluf_(cvec[k]) * w; a1 += siluf_(cvec[1024 + k]) * w; }
        red[(F.wave * 2 + 0) * 64 + F.lane] = a0; red[(F.wave * 2 + 1) * 64 + F.lane] = a1;
        __syncthreads();
        if (F.tid < 128) { const int b = F.tid >> 6, ln = F.tid & 63; float s = 0.f;
#pragma unroll
            for (int w = 0; w < 8; ++w) s += red[(w * 2 + b) * 64 + ln];
            mod[(size_t)(l * 2 + b) * 6144 + n0 + ln] = s + INP(I_ADA_B)[l * 6144 + n0 + ln]; }
        __syncthreads();
    }
}

__device__ __forceinline__ void phase_ln(Frame& F, int kind, const float* lg, const float* lb, int gt_layer, int gt_off, int h_layer, int sh_off, int sc_off, bool route, bool last) {
    LAUNDER(F);
    const float* mod = (const float*)(F.ws + WS_MOD);
    float* X = F.a->out;
    const float* YF = (const float*)(F.ws + WS_YF);
    bf16_t* H = (bf16_t*)(F.ws + WS_H);
    const int gw = F.bid * NWAVES + F.wave, NGW = F.G * NWAVES;
    for (int row = gw; row < NTOK; row += NGW) {
        const int b = row / SEQ;
        f32x4 v[4];
        if (kind == 0) {
            const f32x4* xr = (const f32x4*)(INP(I_X) + (size_t)row * D) + F.lane;
#pragma unroll
            for (int j = 0; j < 4; ++j) v[j] = xr[64 * j];
        } else {
            const f32x4* xr = (const f32x4*)(X + (size_t)row * D) + F.lane;
            const f32x4* gt = (const f32x4*)(mod + (size_t)(gt_layer * 2 + b) * 6144 + gt_off) + F.lane;
            if (kind == 1) {
                const f32x4* yr = (const f32x4*)(YF + (size_t)row * D) + F.lane;
#pragma unroll
                for (int j = 0; j < 4; ++j) v[j] = DN_ALPHA * xr[64 * j] + (1.f + gt[64 * j]) * yr[64 * j];
            } else {
                const int2 rr = ((const int2*)(F.ws + WS_TOPP))[row];
                const float2 gg = ((const float2*)(F.ws + WS_TOPG))[row];
                const bf16_t* ym = (const bf16_t*)(F.ws + WS_MY);
                const u32x2* y0 = (const u32x2*)(ym + (size_t)rr.x * D) + F.lane; const u32x2* y1 = (const u32x2*)(ym + (size_t)rr.y * D) + F.lane;
#pragma unroll
                for (int j = 0; j < 4; ++j) { const u32x2 p = y0[64 * j], q = y1[64 * j];
                    f32x4 y; y[0] = gg.x * __uint_as_float(p.x << 16) + gg.y * __uint_as_float(q.x << 16); y[1] = gg.x * __uint_as_float(p.x & 0xffff0000u) + gg.y * __uint_as_float(q.x & 0xffff0000u);
                    y[2] = gg.x * __uint_as_float(p.y << 16) + gg.y * __uint_as_float(q.y << 16); y[3] = gg.x * __uint_as_float(p.y & 0xffff0000u) + gg.y * __uint_as_float(q.y & 0xffff0000u);
                    v[j] = DN_ALPHA * xr[64 * j] + (1.f + gt[64 * j]) * y; }
            }
        }
        float s = 0.f;
#pragma unroll
        for (int j = 0; j < 4; ++j) s += (v[j][0] + v[j][1]) + (v[j][2] + v[j][3]);
        const float mean = wave_sum(s) * (1.f / D); float s2 = 0.f;
#pragma unroll
        for (int j = 0; j < 4; ++j) { v[j] = v[j] - mean; s2 += (v[j][0] * v[j][0] + v[j][1] * v[j][1]) + (v[j][2] * v[j][2] + v[j][3] * v[j][3]); }
        const float rstd = 1.f / sqrtf(wave_sum(s2) * (1.f / D) + LN_EPS);
        const f32x4* g4 = (const f32x4*)lg + F.lane; const f32x4* b4 = (const f32x4*)lb + F.lane;
        f32x4* xo = (f32x4*)(X + (size_t)row * D) + F.lane;
#pragma unroll
        for (int j = 0; j < 4; ++j) { v[j] = v[j] * rstd * g4[64 * j] + b4[64 * j]; xo[64 * j] = v[j]; }
        if (!last) {
            const f32x4* sh = (const f32x4*)(mod + (size_t)(h_layer * 2 + b) * 6144 + sh_off) + F.lane; const f32x4* sc = (const f32x4*)(mod + (size_t)(h_layer * 2 + b) * 6144 + sc_off) + F.lane;
            u32x2* ho = (u32x2*)(H + (size_t)row * D) + F.lane;
#pragma unroll
            for (int j = 0; j < 4; ++j) { v[j] = v[j] * (1.f + sc[64 * j]) + sh[64 * j]; u32x2 w; w.x = pk2(v[j][0], v[j][1]); w.y = pk2(v[j][2], v[j][3]); ho[64 * j] = w; }
            if (route) {
                const float* rw = INP(I_MOE_R); float lg8[8];
#pragma unroll
                for (int e = 0; e < 8; ++e) lg8[e] = 0.f;
#pragma unroll
                for (int j = 0; j < 4; ++j)
#pragma unroll
                    for (int q = 0; q < 4; ++q) { const int c = 4 * F.lane + 256 * j + q; const f32x4 w0 = *(const f32x4*)(rw + c * 8), w1 = *(const f32x4*)(rw + c * 8 + 4); const float hv = v[j][q];
                        lg8[0] += hv * w0[0]; lg8[1] += hv * w0[1]; lg8[2] += hv * w0[2]; lg8[3] += hv * w0[3]; lg8[4] += hv * w1[0]; lg8[5] += hv * w1[1]; lg8[6] += hv * w1[2]; lg8[7] += hv * w1[3]; asm volatile("" ::: "memory"); }
#pragma unroll
                for (int e = 0; e < 8; ++e) lg8[e] = wave_sum(lg8[e]) + INP(I_MOE_RB)[e];
                int e0 = 0; float l0 = lg8[0];
#pragma unroll
                for (int e = 1; e < 8; ++e) if (lg8[e] > l0) { l0 = lg8[e]; e0 = e; }
                int e1 = -1; float l1 = -3.0e38f;
#pragma unroll
                for (int e = 0; e < 8; ++e) if (e != e0 && lg8[e] > l1) { l1 = lg8[e]; e1 = e; }
                if (F.lane == 0) {
                    const float g0 = 1.f / (1.f + __expf(l1 - l0));
                    unsigned* cnt = (unsigned*)(F.ws + WS_CTL) + CW_CNT;
                    const int p0 = (int)atomicAdd(cnt + e0, 1u), p1 = (int)atomicAdd(cnt + e1, 1u);
                    ((int2*)(F.ws + WS_TOPE))[row] = make_int2(e0, e1); ((float2*)(F.ws + WS_TOPG))[row] = make_float2(g0, 1.f - g0); ((int2*)(F.ws + WS_TOPP))[row] = make_int2(p0, p1);
                }
            }
        }
    }
}

constexpr size_t WS_TEXP = 640 * 1024;
__device__ __forceinline__ void phase_moe_setup(Frame& F) {
    LAUNDER(F);
    const unsigned* cnt = (const unsigned*)(F.ws + WS_CTL) + CW_CNT;
    int pstart[8]; int tot = 0;
#pragma unroll
    for (int e = 0; e < 8; ++e) { pstart[e] = tot; tot += ((int)cnt[e] + 255) / 256 * 256; }
    int* texp = (int*)(F.ws + WS_TEXP);
    if (F.bid == 0 && F.tid < MOE_RT_MAX + 1) {
        if (F.tid == MOE_RT_MAX) texp[MOE_RT_MAX] = tot / 256;
        else { int e = 0;
#pragma unroll
            for (int q = 1; q < 8; ++q) if (F.tid * 256 >= pstart[q]) e = q;
            texp[F.tid] = e; }
    }
    const bf16_t* H = (const bf16_t*)(F.ws + WS_H); bf16_t* MA = (bf16_t*)(F.ws + WS_MA);
    const int gw = F.bid * NWAVES + F.wave, NGW = F.G * NWAVES;
    for (int row = gw; row < NTOK; row += NGW) {
        const int2 ee = ((const int2*)(F.ws + WS_TOPE))[row]; int2 pp = ((const int2*)(F.ws + WS_TOPP))[row];
        int r0 = pp.x, r1 = pp.y;
#pragma unroll
        for (int e = 0; e < 8; ++e) { if (ee.x == e) r0 += pstart[e]; if (ee.y == e) r1 += pstart[e]; }
        const u32x4* src = (const u32x4*)(H + (size_t)row * D) + F.lane;
        const u32x4 a = src[0], b = src[64];
        u32x4* d0 = (u32x4*)(MA + (size_t)r0 * D) + F.lane; u32x4* d1 = (u32x4*)(MA + (size_t)r1 * D) + F.lane;
        d0[0] = a; d0[64] = b; d1[0] = a; d1[64] = b;
        if (F.lane == 0) ((int2*)(F.ws + WS_TOPP))[row] = make_int2(r0, r1);
    }
}

__device__ __forceinline__ void phase_gdn_prep(Frame& F, int l) {
    LAUNDER(F);
    const bf16_t* Z = (const bf16_t*)(F.ws + WS_Z);
    float* Q = (float*)(F.ws + WS_S0); float* Kk = (float*)(F.ws + WS_S1); float* V = (float*)(F.ws + WS_S2); float* AB = (float*)(F.ws + WS_S3);
    const float* cw = INP(I_GDN_CONV) + (size_t)l * 4 * 1536;
    const int gw = F.bid * NWAVES + F.wave, NGW = F.G * NWAVES;
    for (int it = gw; it < NTOK * 4; it += NGW) {
        const int row = it >> 2, h = it & 3, t = row % SEQ;
        float o[3][2];
#pragma unroll
        for (int g = 0; g < 3; ++g)
#pragma unroll
            for (int p = 0; p < 2; ++p) { const int c = g * 512 + h * 128 + F.lane + 64 * p; float s = 0.f;
#pragma unroll
                for (int j = 0; j < 4; ++j) { const int tt = t - 3 + j; if (tt >= 0) s += cw[j * 1536 + c] * bf2f(Z[(size_t)(row - 3 + j) * ZW + c]); }
                o[g][p] = siluf_(s); }
        const float nq = wave_sum(o[0][0] * o[0][0] + o[0][1] * o[0][1]), nk = wave_sum(o[1][0] * o[1][0] + o[1][1] * o[1][1]);
        const float rq = rsqrtf(nq + 1e-6f) * 0.08838834764831845f, rk = rsqrtf(nk + 1e-6f);
#pragma unroll
        for (int p = 0; p < 2; ++p) { const size_t idx = (size_t)row * 512 + h * 128 + F.lane + 64 * p; Q[idx] = o[0][p] * rq; Kk[idx] = o[1][p] * rk; V[idx] = o[2][p]; }
        if (F.lane == 0) {
            const float a = bf2f(Z[(size_t)row * ZW + ZC_GA + h]), bb = bf2f(Z[(size_t)row * ZW + ZC_GB + h]);
            const float g = -__expf(INP(I_GDN_ALOG)[l * 4 + h]) * softplusf_(a + INP(I_GDN_DTB)[l * 4 + h]);
            AB[(size_t)row * 8 + h * 2] = __expf(g); AB[(size_t)row * 8 + h * 2 + 1] = sigmoidf_(bb);
        }
    }
}
__device__ __forceinline__ void phase_gdn_core(Frame& F) {
    LAUNDER(F);
    if (F.bid >= 8) return;
    const int b = F.bid >> 2, h = F.bid & 3;
    float* Q = (float*)(F.ws + WS_S0); float* Kk = (float*)(F.ws + WS_S1); float* V = (float*)(F.ws + WS_S2); const float* AB = (const float*)(F.ws + WS_S3);
    LAS float* sq = (LAS float*)F.lds; LAS float* sk = sq + 16 * 128; LAS float* sv = sk + 16 * 128; LAS float* sab = sv + 16 * 128;
    float s[32];
#pragma unroll
    for (int i = 0; i < 32; ++i) s[i] = 0.f;
    const int j = F.tid >> 2, p = F.tid & 3;
    for (int t0 = 0; t0 < SEQ; t0 += 16) {
        const size_t rbase = (size_t)b * SEQ + t0;
        for (int e = F.tid; e < 16 * 128; e += NTHREADS) { const int tt = e >> 7, c = e & 127; const size_t idx = (rbase + tt) * 512 + h * 128 + c; sq[e] = Q[idx]; sk[e] = Kk[idx]; sv[e] = V[idx]; }
        if (F.tid < 32) sab[F.tid] = AB[(rbase + (F.tid >> 1)) * 8 + h * 2 + (F.tid & 1)];
        __syncthreads();
        for (int tt = 0; tt < 16; ++tt) {
            const float al = sab[tt * 2], be = sab[tt * 2 + 1];
            float k0 = 0.f, k1 = 0.f;
#pragma unroll
            for (int i = 0; i < 32; i += 4) { const f32x4 kk = *(const LAS f32x4*)(sk + tt * 128 + 32 * p + i); k0 += kk[0] * s[i] + kk[2] * s[i + 2]; k1 += kk[1] * s[i + 1] + kk[3] * s[i + 3]; }
            float kS = k0 + k1; kS += __shfl_xor(kS, 1); kS += __shfl_xor(kS, 2);
            const float c = be * (sv[tt * 128 + j] - al * kS);
            float o0 = 0.f, o1 = 0.f;
#pragma unroll
            for (int i = 0; i < 32; i += 4) { const f32x4 kk = *(const LAS f32x4*)(sk + tt * 128 + 32 * p + i); const f32x4 qq = *(const LAS f32x4*)(sq + tt * 128 + 32 * p + i);
                s[i] = al * s[i] + c * kk[0]; s[i + 1] = al * s[i + 1] + c * kk[1]; s[i + 2] = al * s[i + 2] + c * kk[2]; s[i + 3] = al * s[i + 3] + c * kk[3];
                o0 += qq[0] * s[i] + qq[2] * s[i + 2]; o1 += qq[1] * s[i + 1] + qq[3] * s[i + 3]; }
            float o = o0 + o1; o += __shfl_xor(o, 1); o += __shfl_xor(o, 2);
            if (p == 0) V[(rbase + tt) * 512 + h * 128 + j] = o;
        }
        __syncthreads();
    }
}
__device__ __forceinline__ void phase_gdn_post(Frame& F, int l) {
    LAUNDER(F);
    const bf16_t* Z = (const bf16_t*)(F.ws + WS_Z); const float* O = (const float*)(F.ws + WS_S2); bf16_t* Y = (bf16_t*)(F.ws + WS_Y);
    const float* ng = INP(I_GDN_NG) + l * 128;
    const int gw = F.bid * NWAVES + F.wave, NGW = F.G * NWAVES;
    for (int it = gw; it < NTOK * 4; it += NGW) {
        const int row = it >> 2, h = it & 3;
        const float a = O[(size_t)row * 512 + h * 128 + F.lane], b = O[(size_t)row * 512 + h * 128 + 64 + F.lane];
        const float r = rsqrtf(wave_sum(a * a + b * b) * (1.f / 128.f) + 1e-6f);
        const float z0 = bf2f(Z[(size_t)row * ZW + ZC_GZ + h * 128 + F.lane]), z1 = bf2f(Z[(size_t)row * ZW + ZC_GZ + h * 128 + 64 + F.lane]);
        Y[(size_t)row * 1536 + h * 128 + F.lane] = f2bf(a * r * ng[F.lane] * siluf_(z0));
        Y[(size_t)row * 1536 + h * 128 + 64 + F.lane] = f2bf(b * r * ng[64 + F.lane] * siluf_(z1));
    }
}

__device__ __forceinline__ float capf_(float t) { return 15.f * tanhf(t * (1.f / 15.f)); }
__device__ __forceinline__ void phase_ml_prep(Frame& F, int l) {
    LAUNDER(F);
    const bf16_t* Z = (const bf16_t*)(F.ws + WS_Z); float* IFg = (float*)(F.ws + WS_S3);
    const int gt = F.bid * NTHREADS + F.tid, NGT = F.G * NTHREADS;
    for (int it = gt; it < NTOK * 4; it += NGT) {
        const int row = it >> 2, h = it & 3;
        const float ip = bf2f(Z[(size_t)row * ZW + ZC_MI + h]) + INP(I_ML_BI)[l * 4 + h], fp = bf2f(Z[(size_t)row * ZW + ZC_MF + h]) + INP(I_ML_BF)[l * 4 + h];
        IFg[(size_t)row * 8 + h * 2] = __expf(capf_(ip)); IFg[(size_t)row * 8 + h * 2 + 1] = sigmoidf_(capf_(fp));
    }
}
__device__ __forceinline__ void phase_ml_core(Frame& F) {
    LAUNDER(F);
    if (F.bid >= 8) return;
    const int b = F.bid >> 2, h = F.bid & 3;
    const bf16_t* Z = (const bf16_t*)(F.ws + WS_Z); const float* IFg = (const float*)(F.ws + WS_S3); float* Hh = (float*)(F.ws + WS_S2);
    LAS float* sq = (LAS float*)F.lds; LAS float* sk = sq + 16 * 64; LAS float* sv = sk + 16 * 64; LAS float* sif = sv + 16 * 128;
    float c[16], n[16];
#pragma unroll
    for (int i = 0; i < 16; ++i) { c[i] = 0.f; n[i] = 0.f; }
    const int j = F.tid >> 2, p = F.tid & 3;
    for (int t0 = 0; t0 < SEQ; t0 += 16) {
        const size_t rbase = (size_t)b * SEQ + t0;
        for (int e = F.tid; e < 16 * 64; e += NTHREADS) { const int tt = e >> 6, cc = e & 63; const bf16_t* zr = Z + (rbase + tt) * ZW; sq[e] = bf2f(zr[ZC_MQ + h * 64 + cc]); sk[e] = bf2f(zr[ZC_MK + h * 64 + cc]) * 0.125f; }
        for (int e = F.tid; e < 16 * 128; e += NTHREADS) { const int tt = e >> 7, cc = e & 127; sv[e] = bf2f(Z[(rbase + tt) * ZW + ZC_MV + h * 128 + cc]); }
        if (F.tid < 32) sif[F.tid] = IFg[(rbase + (F.tid >> 1)) * 8 + h * 2 + (F.tid & 1)];
        __syncthreads();
        for (int tt = 0; tt < 16; ++tt) {
            const float ig = sif[tt * 2], fg = sif[tt * 2 + 1]; const float iv = ig * sv[tt * 128 + j];
            float a0 = 0.f, d0 = 0.f;
#pragma unroll
            for (int i = 0; i < 16; i += 4) { const f32x4 kk = *(const LAS f32x4*)(sk + tt * 64 + 16 * p + i); const f32x4 qq = *(const LAS f32x4*)(sq + tt * 64 + 16 * p + i);
#pragma unroll
                for (int u = 0; u < 4; ++u) { c[i + u] = fg * c[i + u] + iv * kk[u]; n[i + u] = fg * n[i + u] + ig * kk[u]; a0 += qq[u] * c[i + u]; d0 += qq[u] * n[i + u]; } }
            a0 += __shfl_xor(a0, 1); a0 += __shfl_xor(a0, 2); d0 += __shfl_xor(d0, 1); d0 += __shfl_xor(d0, 2);
            if (p == 0) Hh[(rbase + tt) * 512 + h * 128 + j] = a0 / fmaxf(fabsf(d0), 1.f);
        }
        __syncthreads();
    }
}
__device__ __forceinline__ void phase_ml_post(Frame& F, int l) {
    LAUNDER(F);
    const bf16_t* Z = (const bf16_t*)(F.ws + WS_Z); const float* O = (const float*)(F.ws + WS_S2); bf16_t* Y = (bf16_t*)(F.ws + WS_Y);
    const float* ng = INP(I_ML_NG) + l * 512;
    const int gw = F.bid * NWAVES + F.wave, NGW = F.G * NWAVES;
    for (int it = gw; it < NTOK * 4; it += NGW) {
        const int row = it >> 2, h = it & 3;
        const float a = O[(size_t)row * 512 + h * 128 + F.lane], b = O[(size_t)row * 512 + h * 128 + 64 + F.lane];
        const float r = rsqrtf(wave_sum(a * a + b * b) * (1.f / 128.f) + 1e-6f);
        const float z0 = bf2f(Z[(size_t)row * ZW + ZC_MO + h * 128 + F.lane]), z1 = bf2f(Z[(size_t)row * ZW + ZC_MO + h * 128 + 64 + F.lane]);
        Y[(size_t)row * 1536 + 512 + h * 128 + F.lane] = f2bf(a * r * ng[h * 128 + F.lane] * sigmoidf_(z0));
        Y[(size_t)row * 1536 + 512 + h * 128 + 64 + F.lane] = f2bf(b * r * ng[h * 128 + 64 + F.lane] * sigmoidf_(z1));
    }
}

__device__ __forceinline__ float zshift(const bf16_t* Z, int row, int t, int col, float mu) {
    const float cur = bf2f(Z[(size_t)row * ZW + col]); const float prev = t > 0 ? bf2f(Z[(size_t)(row - 1) * ZW + col]) : 0.f; return cur + mu * (prev - cur);
}
__device__ __forceinline__ void phase_rw_prep(Frame& F, int l) {
    LAUNDER(F);
    const bf16_t* Z = (const bf16_t*)(F.ws + WS_Z);
    float* K1 = (float*)(F.ws + WS_S0); float* KK = (float*)(F.ws + WS_S1); float* AKK = (float*)(F.ws + WS_S2); float* Wd = (float*)(F.ws + WS_S4); float* VF = (float*)(F.ws + WS_VF);
    const float* mu = INP(I_RW_MU) + l * 1792;
    const float* w0 = INP(I_RW_W0) + l * 512; const float* w2 = INP(I_RW_W2) + (size_t)l * 64 * 512; const float* a0 = INP(I_RW_A0) + l * 512; const float* a2 = INP(I_RW_A2) + (size_t)l * 64 * 512;
    const float* k_k = INP(I_RW_KK) + l * 512; const float* k_a = INP(I_RW_KA) + l * 512;
    const int gw = F.bid * NWAVES + F.wave, NGW = F.G * NWAVES;
    for (int it = gw; it < NTOK * 8; it += NGW) {
        const int row = it >> 3, h = it & 7, t = row % SEQ, c = h * 64 + F.lane;
        const float k = zshift(Z, row, t, ZC_RK + c, mu[512 + c]); float v = zshift(Z, row, t, ZC_RV + c, mu[1024 + c]);
        const float xw = tanhf(zshift(Z, row, t, ZC_RW + F.lane, mu[1536 + F.lane])), xa = zshift(Z, row, t, ZC_RA + F.lane, mu[1600 + F.lane]);
        float sw = 0.f, sa = 0.f;
        for (int j = 0; j < 64; ++j) { const float xwj = __shfl(xw, j), xaj = __shfl(xa, j); sw += xwj * w2[j * 512 + c]; sa += xaj * a2[j * 512 + c]; }
        const float lw = -__expf(-softplusf_(-(w0[c] + sw)) - 0.5f);
        const float a = sigmoidf_(a0[c] + sa);
        if (l == 1) {
            const float* muv = INP(I_RW_MUV1); const float* v0 = INP(I_RW_V0); const float* v2 = INP(I_RW_V2);
            const float xv = F.lane < 32 ? zshift(Z, row, t, ZC_XV + F.lane, muv[F.lane]) : 0.f; float sv = 0.f;
            for (int j = 0; j < 32; ++j) sv += __shfl(xv, j) * v2[j * 512 + c];
            const float vf = VF[(size_t)row * 512 + c];
            v = v + (vf - v) * sigmoidf_(v0[c] + sv);
        }
        const float kkr = k * k_k[c]; const float kk = kkr * rsqrtf(wave_sum(kkr * kkr) + 1e-6f);
        const float kp = k * (1.f + (a - 1.f) * k_a[c]);
        const size_t idx = (size_t)row * 512 + c;
        K1[idx] = kp; KK[idx] = kk; AKK[idx] = a * kk; Wd[idx] = __expf(lw); VF[idx] = v;
    }
}
__device__ __forceinline__ void phase_rw_core(Frame& F, int l) {
    LAUNDER(F);
    if (F.bid >= 16) return;
    const int b = F.bid >> 3, h = F.bid & 7;
    const bf16_t* Z = (const bf16_t*)(F.ws + WS_Z); const float* mu = INP(I_RW_MU) + l * 1792;
    const float* K1 = (const float*)(F.ws + WS_S0); const float* KK = (const float*)(F.ws + WS_S1); float* AKK = (float*)(F.ws + WS_S2); const float* Wd = (const float*)(F.ws + WS_S4); const float* VF = (const float*)(F.ws + WS_VF);
    LAS float* sr = (LAS float*)F.lds; LAS float* sk = sr + 1024; LAS float* skk = sk + 1024; LAS float* sak = skk + 1024; LAS float* sw = sak + 1024; LAS float* sv = sw + 1024;
    float s[8];
#pragma unroll
    for (int i = 0; i < 8; ++i) s[i] = 0.f;
    const int i_ = F.tid >> 3, p = F.tid & 7;
    for (int t0 = 0; t0 < SEQ; t0 += 16) {
        const size_t rbase = (size_t)b * SEQ + t0;
        for (int e = F.tid; e < 16 * 64; e += NTHREADS) { const int tt = e >> 6, c = e & 63; const size_t idx = (rbase + tt) * 512 + h * 64 + c;
            sr[e] = zshift(Z, (int)(rbase + tt), t0 + tt, ZC_RR + h * 64 + c, mu[h * 64 + c]); sk[e] = K1[idx]; skk[e] = KK[idx]; sak[e] = AKK[idx]; sw[e] = Wd[idx]; sv[e] = VF[idx]; }
        __syncthreads();
        for (int tt = 0; tt < 16; ++tt) {
            const f32x4 ka = *(const LAS f32x4*)(skk + tt * 64 + 8 * p), kb = *(const LAS f32x4*)(skk + tt * 64 + 8 * p + 4);
            float sk_ = (s[0] * ka[0] + s[1] * ka[1]) + (s[2] * ka[2] + s[3] * ka[3]) + (s[4] * kb[0] + s[5] * kb[1]) + (s[6] * kb[2] + s[7] * kb[3]);
            sk_ += __shfl_xor(sk_, 1); sk_ += __shfl_xor(sk_, 2); sk_ += __shfl_xor(sk_, 4);
            const float vi = sv[tt * 64 + i_];
            float y = 0.f;
#pragma unroll
            for (int j = 0; j < 8; ++j) { const int o = tt * 64 + 8 * p + j; s[j] = s[j] * sw[o] - sk_ * sak[o] + vi * sk[o]; y += s[j] * sr[o]; }
            y += __shfl_xor(y, 1); y += __shfl_xor(y, 2); y += __shfl_xor(y, 4);
            if (p == 0) AKK[(rbase + tt) * 512 + h * 64 + i_] = y;
        }
        __syncthreads();
    }
}
__device__ __forceinline__ void phase_rw_post(Frame& F, int l) {
    LAUNDER(F);
    const bf16_t* Z = (const bf16_t*)(F.ws + WS_Z);
    const float* K1 = (const float*)(F.ws + WS_S0); const float* Yc = (const float*)(F.ws + WS_S2); const float* VF = (const float*)(F.ws + WS_VF);
    bf16_t* Y = (bf16_t*)(F.ws + WS_Y);
    const float* mu = INP(I_RW_MU) + l * 1792; const float* g2 = INP(I_RW_G2) + (size_t)l * 128 * 512; const float* r_k = INP(I_RW_RK) + l * 512;
    const float* lng = INP(I_RW_LNG) + l * 512; const float* lnb = INP(I_RW_LNB) + l * 512;
    const int gw = F.bid * NWAVES + F.wave, NGW = F.G * NWAVES;
    for (int it = gw; it < NTOK * 8; it += NGW) {
        const int row = it >> 3, h = it & 7, t = row % SEQ, c = h * 64 + F.lane; const size_t idx = (size_t)row * 512 + c;
        const float xg0 = sigmoidf_(zshift(Z, row, t, ZC_RG + F.lane, mu[1664 + F.lane])), xg1 = sigmoidf_(zshift(Z, row, t, ZC_RG + 64 + F.lane, mu[1664 + 64 + F.lane]));
        float g = 0.f;
        for (int j = 0; j < 64; ++j) g += __shfl(xg0, j) * g2[j * 512 + c] + __shfl(xg1, j) * g2[(64 + j) * 512 + c];
        const float y = Yc[idx]; const float m = wave_sum(y) * (1.f / 64.f); const float d = y - m; const float var = wave_sum(d * d) * (1.f / 64.f);
        float yn = d * rsqrtf(var + 64e-5f) * lng[c] + lnb[c];
        const float r = zshift(Z, row, t, ZC_RR + c, mu[c]);
        const float bonus = wave_sum(r * K1[idx] * r_k[c]) * VF[idx];
        Y[(size_t)row * 1536 + 1024 + c] = f2bf((yn + bonus) * g);
    }
}

#define SITE(N) int g_ = F.G, b_ = F.bid; unsigned char* w_ = ws; asm volatile("; gemm site " #N : "+s"(g_), "+s"(b_), "+s"(w_))
enum { PH_CONV0 = 0, PH_LNIN, PH_L0 = 2,
       LP_INPROJ = 0, LP_GDN_PREP, LP_GDN_CORE, LP_GDN_POST, LP_ML_PREP, LP_ML_CORE, LP_ML_POST, LP_RW_PREP, LP_RW_CORE, LP_RW_POST, LP_MERGE, LP_WO, LP_LN1, LP_F1, LP_F2, LP_F3, LP_LN2, LP_COUNT };
constexpr int PH_L1 = PH_L0 + LP_COUNT, PH_END = PH_L1 + LP_COUNT;


__device__ __forceinline__ void run_phase(Frame& F, const Args& args, const Args* ap, unsigned char* ws, const int ph) {
        if (ph == PH_CONV0) {
            if (F.bid == 0 && F.tid < 8) ((unsigned*)(ws + WS_CTL))[CW_CNT + F.tid] = 0u;
            phase_mod(F);
            phase_convert(F, 0, NJOBS0, 0, ap->items0);
        } else if (ph == PH_LNIN) {
            phase_ln(F, 0, INP(I_LNIN_G), INP(I_LNIN_B), 0, 0, 0, 0, 1024, false, false);
        } else {
            const int l = (ph - PH_L0) / LP_COUNT, k = (ph - PH_L0) % LP_COUNT;
            switch (k) {
            case LP_INPROJ: {
                SITE(1); pg8::StaticOrder S{(const char*)(w_ + WS_H), (const char*)(w_ + WS_WIN + (size_t)l * ZW * 1024 * 2), NTOK / 256, ZW / 256, 1024, g_, b_};
                pg8::EpiBf16 E{(bf16_t*)(w_ + WS_Z), ZW};
                pg8::gemm_phase(F.lds, 1024, S, E); } break;
            case LP_GDN_PREP: phase_gdn_prep(F, l); break;
            case LP_GDN_CORE: phase_gdn_core(F); break;
            case LP_GDN_POST: phase_gdn_post(F, l); break;
            case LP_ML_PREP: phase_ml_prep(F, l); break;
            case LP_ML_CORE: phase_ml_core(F); break;
            case LP_ML_POST: phase_ml_post(F, l); break;
            case LP_RW_PREP: phase_rw_prep(F, l); break;
            case LP_RW_CORE: phase_rw_core(F, l); break;
            case LP_RW_POST: phase_rw_post(F, l); break;
            case LP_MERGE: {
                SITE(2); pg8::StaticOrder S{(const char*)(w_ + WS_Y), (const char*)(w_ + WS_WBR + (size_t)l * 1024 * 1536 * 2), NTOK / 256, 4, 1536, g_, b_};
                pg8::EpiMerge E{(const bf16_t*)(w_ + WS_Z), (bf16_t*)(w_ + WS_H)};
                pg8::gemm_phase(F.lds, 1536, S, E); } break;
            case LP_WO: {
                SITE(3); pg8::StaticOrder S{(const char*)(w_ + WS_H), (const char*)(w_ + WS_WO + (size_t)l * 1024 * 1024 * 2), NTOK / 256, 4, 1024, g_, b_};
                pg8::EpiF32 E{(float*)(w_ + WS_YF), 1024};
                pg8::gemm_phase(F.lds, 1024, S, E); } break;
            case LP_LN1:
                if (l == 0) phase_ln(F, 1, INP(I_LN1_G), INP(I_LN1_B), 0, 2048, 0, 3072, 4096, false, false);
                else phase_ln(F, 1, INP(I_LN1_G) + 1024, INP(I_LN1_B) + 1024, 1, 2048, 1, 3072, 4096, true, false);
                break;
            case LP_F1:
                if (l == 1) { phase_moe_setup(F); phase_convert(F, NJOBS0, NJOBS, ap->items0, ap->items0 + ap->items1); }
                break;
            case LP_F2:
                if (l == 0) {
                    SITE(4); pg8::StaticOrder S{(const char*)(w_ + WS_H), (const char*)(w_ + WS_WGU), NTOK / 256, 2 * DFF / 256, 1024, g_, b_};
                    pg8::EpiSwiglu E{(bf16_t*)(w_ + WS_ACT0), DFF};
                    pg8::gemm_phase(F.lds, 1024, S, E);
                } else {
                    const int* texp = (const int*)(ws + WS_TEXP); const int nrt = texp[MOE_RT_MAX];
                    SITE(5); pg8::MoeOrder S{(const char*)(w_ + WS_MA), (const char*)(w_ + WS_MW), texp, MW_EXP_BYTES, nrt, 2 * DFFE / 256, 1024, g_, b_};
                    pg8::EpiSwiglu E{(bf16_t*)(w_ + WS_MACT), DFFE};
                    pg8::gemm_phase(F.lds, 1024, S, E);
                }
                break;
            case LP_F3:
                if (l == 0) {
                    SITE(6); pg8::StaticOrder S{(const char*)(w_ + WS_ACT0), (const char*)(w_ + WS_WD), NTOK / 256, 4, DFF, g_, b_};
                    pg8::EpiF32 E{(float*)(w_ + WS_YF), 1024};
                    pg8::gemm_phase(F.lds, DFF, S, E);
                } else {
                    const int* texp = (const int*)(ws + WS_TEXP); const int nrt = texp[MOE_RT_MAX];
                    SITE(7); pg8::MoeOrder S{(const char*)(w_ + WS_MACT), (const char*)(w_ + WS_MW + (size_t)7168 * 1024 * 2), texp, MW_EXP_BYTES, nrt, 4, DFFE, g_, b_};
                    pg8::EpiBf16 E{(bf16_t*)(w_ + WS_MY), 1024};
                    pg8::gemm_phase(F.lds, DFFE, S, E);
                }
                break;
            case LP_LN2:
                if (l == 0) phase_ln(F, 1, INP(I_LN2_G), INP(I_LN2_B), 0, 5120, 1, 0, 1024, false, false);
                else phase_ln(F, 3, INP(I_LN2_G) + 1024, INP(I_LN2_B) + 1024, 1, 5120, 0, 0, 0, false, true);
                break;
            default: break;
            }
        }
}
#define FRAME_SETUP() \
        const Args* ap = &args; \
        int tid_ = threadIdx.x; asm volatile("" : "+v"(tid_)); \
        Frame F; F.lds = (LAS unsigned char*)lds_raw; F.tid = tid_; F.lane = tid_ & 63; F.wave = __builtin_amdgcn_readfirstlane(tid_ >> 6); F.G = gridDim.x; F.bid = blockIdx.x; F.a = ap; \
        unsigned char* ws = args.ws; asm volatile("" : "+s"(ws)); F.ws = ws;

#if ONE_LAUNCH
#define PHASE(k) do { if (lo <= (k) && (k) < hi) { FRAME_SETUP(); run_phase(F, args, ap, ws, (k)); } if (lo <= (k) && (k) + 1 < hi) cg::this_grid().sync(); } while (0)
__global__ void __launch_bounds__(NTHREADS, 2) mk(Args args) {
    extern __shared__ __attribute__((aligned(16))) unsigned char lds_raw[];
    const int lo = args.ph_lo, hi = args.ph_hi;
    PHASE(0); PHASE(1); PHASE(2); PHASE(3); PHASE(4); PHASE(5); PHASE(6); PHASE(7); PHASE(8); PHASE(9); PHASE(10); PHASE(11); PHASE(12); PHASE(13); PHASE(14); PHASE(15); PHASE(16); PHASE(17); PHASE(18);
    PHASE(19); PHASE(20); PHASE(21); PHASE(22); PHASE(23); PHASE(24); PHASE(25); PHASE(26); PHASE(27); PHASE(28); PHASE(29); PHASE(30); PHASE(31); PHASE(32); PHASE(33); PHASE(34); PHASE(35);
    static_assert(PH_END == 36, "phase list");
}
#endif
template <int KIND> __global__ void __launch_bounds__(NTHREADS, 2) mk_one(Args args) {
    extern __shared__ __attribute__((aligned(16))) unsigned char lds_raw[];
    FRAME_SETUP();
    const int ph = (KIND < PH_L0) ? KIND : KIND + args.ph_lo * LP_COUNT;
    if (KIND < PH_L0) run_phase(F, args, ap, ws, KIND);
    else if (args.ph_lo == 0) run_phase(F, args, ap, ws, KIND);
    else run_phase(F, args, ap, ws, KIND + LP_COUNT);
    (void)ph;
}

static int fill_jobs(Args& a, void* const* d_in, unsigned char* ws) {
    int nj = 0, item = 0;
    auto add = [&](const float* src, bf16_t* dst, int K, int ld_src, int col0, int ncols, int ld_dst, int r0, int mode, int batch, long long sbs, long long dbs) {
        Job& J = a.jobs[nj++]; J.src = src; J.dst = dst; J.src_bs = sbs; J.dst_bs = dbs; J.K = K; J.ld_src = ld_src; J.col0 = col0; J.ncols = ncols; J.ld_dst = ld_dst; J.r0 = r0; J.mode = mode; J.batch = batch;
        J.item0 = item; J.nitems = batch * (K / 64) * ((ncols + 31) / 32); item += J.nitems; J.pad0 = 0; J.pad1 = 0; };
    for (int l = 0; l < 2; ++l) {
        const float* w = (const float*)d_in[I_W_IN] + (size_t)l * 1024 * IN_W; bf16_t* d = (bf16_t*)(ws + WS_WIN) + (size_t)l * ZW * 1024;
        add(w, d, 1024, IN_W, 0, 2048, 1024, 0, 0, 1, 0, 0);
        add(w, d, 1024, IN_W, 2056, 1536, 1024, 2048, 0, 1, 0, 0);
        add(w, d, 1024, IN_W, 3600, 1792, 1024, 3584, 0, 1, 0, 0);
        add(w, d, 1024, IN_W, 2048, 8, 1024, 5376, 0, 1, 0, 0);
        add(w, d, 1024, IN_W, 3592, 8, 1024, 5384, 0, 1, 0, 0);
        add(w, d, 1024, IN_W, 5392, 3072, 1024, 5632, 0, 1, 0, 0);
        if (l == 1) add((const float*)d_in[I_RW_V1], d, 1024, 32, 0, 32, 1024, 5392, 0, 1, 0, 0);
        add((const float*)d_in[I_W_BR] + (size_t)l * 3 * 512 * 1024, (bf16_t*)(ws + WS_WBR) + (size_t)l * 1024 * 1536, 512, 1024, 0, 1024, 1536, 0, 0, 3, 512ll * 1024, 512);
        add((const float*)d_in[I_W_O] + (size_t)l * 1024 * 1024, (bf16_t*)(ws + WS_WO) + (size_t)l * 1024 * 1024, 1024, 1024, 0, 1024, 1024, 0, 0, 1, 0, 0);
    }
    add((const float*)d_in[I_FFN_G], (bf16_t*)(ws + WS_WGU), 1024, DFF, 0, DFF, 1024, 0, 1, 1, 0, 0);
    add((const float*)d_in[I_FFN_U], (bf16_t*)(ws + WS_WGU), 1024, DFF, 0, DFF, 1024, 128, 1, 1, 0, 0);
    add((const float*)d_in[I_FFN_D], (bf16_t*)(ws + WS_WD), DFF, 1024, 0, 1024, DFF, 0, 0, 1, 0, 0);
    if (nj != NJOBS0) return -1;
    a.items0 = item;
    const long long eb = (long long)(MW_EXP_BYTES / 2);
    add((const float*)d_in[I_MOE_G], (bf16_t*)(ws + WS_MW), 1024, DFFE, 0, DFFE, 1024, 0, 1, 8, 1024ll * DFFE, eb);
    add((const float*)d_in[I_MOE_U], (bf16_t*)(ws + WS_MW), 1024, DFFE, 0, DFFE, 1024, 128, 1, 8, 1024ll * DFFE, eb);
    add((const float*)d_in[I_MOE_D], (bf16_t*)(ws + WS_MW) + (size_t)7168 * 1024, DFFE, 1024, 0, 1024, DFFE, 0, 0, 8, (long long)DFFE * 1024, eb);
    if (nj != NJOBS) return -1;
    a.items1 = item - a.items0;
    return 0;
}

template <int KIND> static void launch_kind(Args& a, int layer, int grid, hipStream_t stream) {
    static bool attr = false;
    if (!attr) { (void)hipFuncSetAttribute((const void*)mk_one<KIND>, hipFuncAttributeMaxDynamicSharedMemorySize, LDS_BYTES); attr = true; }
    a.ph_lo = layer; a.ph_hi = layer + 1;
    hipLaunchKernelGGL(mk_one<KIND>, dim3(grid), dim3(NTHREADS), LDS_BYTES, stream, a);
}
template <int K0, int K1> struct LaunchRange { static void run(Args& a, int layer, int grid, hipStream_t stream) {
    if (!(layer == 0 && K0 == PH_L0 + LP_F1)) launch_kind<K0>(a, layer, grid, stream);
    LaunchRange<K0 + 1, K1>::run(a, layer, grid, stream); } };
template <int K1> struct LaunchRange<K1, K1> { static void run(Args&, int, int, hipStream_t) {} };
static void launch_all_phases(Args& a, int grid, hipStream_t stream) {
    launch_kind<PH_CONV0>(a, 0, grid, stream);
    launch_kind<PH_LNIN>(a, 0, grid, stream);
    for (int l = 0; l < 2; ++l) LaunchRange<PH_L0, PH_L0 + LP_COUNT>::run(a, l, grid, stream);
}

extern "C" void kernel_launch(void* const* d_in, const int* in_sizes, int n_in, void* d_out, int out_size, void* d_ws, size_t ws_size, hipStream_t stream) {
    static int grid = 0;
    if (grid == 0) {
        if (n_in != 43 || out_size != NTOK * D || ws_size < WS_END) { fprintf(stderr, "kernel_launch: unexpected shapes n_in %d out %d ws %zu (need %zu)\n", n_in, out_size, ws_size, (size_t)WS_END); grid = -1; return; }
        int dev = 0, cus = 0, per_cu = 0;
        (void)hipGetDevice(&dev); (void)hipDeviceGetAttribute(&cus, hipDeviceAttributeMultiprocessorCount, dev); (void)per_cu;
#if ONE_LAUNCH
        if (hipFuncSetAttribute((const void*)mk, hipFuncAttributeMaxDynamicSharedMemorySize, LDS_BYTES) != hipSuccess) { fprintf(stderr, "hipFuncSetAttribute failed\n"); grid = -1; return; }
        (void)hipOccupancyMaxActiveBlocksPerMultiprocessor(&per_cu, (const void*)mk, NTHREADS, LDS_BYTES);
        if (per_cu < 1) { fprintf(stderr, "occupancy query says %d\n", per_cu); per_cu = 1; }
        (void)hipGetLastError();
#endif
        grid = cus;
    }
    if (grid < 0) return;
    Args a{};
    for (int i = 0; i < 43; ++i) a.in[i] = (const float*)d_in[i];
    a.out = (float*)d_out; a.ws = (unsigned char*)d_ws;
    if (fill_jobs(a, d_in, (unsigned char*)d_ws) != 0) { fprintf(stderr, "job table mismatch\n"); return; }
#if ONE_LAUNCH
    a.ph_lo = 0; a.ph_hi = PH_END;
    void* kargs[] = {&a};
    hipError_t e = hipLaunchCooperativeKernel((const void*)mk, dim3(grid), dim3(NTHREADS), kargs, LDS_BYTES, stream);
    if (e != hipSuccess) fprintf(stderr, "cooperative launch failed: %s\n", hipGetErrorString(e));
#else
    launch_all_phases(a, grid, stream);
#endif
}
```

```cpp
#include <hip/hip_runtime.h>
#include <hip/hip_cooperative_groups.h>
#include <cstdio>
#include <cstdint>
namespace cg = cooperative_groups;

#ifndef ONE_LAUNCH
#define ONE_LAUNCH 1
#endif

#define LAS __attribute__((address_space(3)))
typedef unsigned short bf16_t;
typedef short bf16x8 __attribute__((ext_vector_type(8)));
typedef float f32x4 __attribute__((ext_vector_type(4)));
typedef float f32x2 __attribute__((ext_vector_type(2)));
typedef unsigned u32x4 __attribute__((ext_vector_type(4)));
typedef unsigned u32x2 __attribute__((ext_vector_type(2)));

constexpr int NTOK = 16384, D = 1024, SEQ = 8192, NB = 2;
constexpr int IN_W = 8464;
constexpr int ZW = 8704;
constexpr int ZC_GQ = 0, ZC_GK = 512, ZC_GV = 1024, ZC_GZ = 1536, ZC_MQ = 2048, ZC_MK = 2304, ZC_MV = 2560, ZC_MO = 3072,
              ZC_RR = 3584, ZC_RK = 4096, ZC_RV = 4608, ZC_RW = 5120, ZC_RA = 5184, ZC_RG = 5248, ZC_GA = 5376, ZC_GB = 5380,
              ZC_MI = 5384, ZC_MF = 5388, ZC_XV = 5392, ZC_GATE = 5632;
constexpr int DFF = 2816, DFFE = 3584, NEXP = 8;
constexpr int MOE_ROWS_MAX = 32768 + NEXP * 256;
constexpr int MOE_RT_MAX = MOE_ROWS_MAX / 256;
constexpr float DN_ALPHA = 1.4142135623730951f;
constexpr float LN_EPS = 1e-5f;

constexpr size_t MB = 1ull << 20;
constexpr size_t WS_CTL = 0;
constexpr size_t WS_MOD = 64 * 1024;
constexpr size_t WS_TOPE = 256 * 1024;
constexpr size_t WS_TOPG = 384 * 1024;
constexpr size_t WS_TOPP = 512 * 1024;
constexpr size_t WS_WIN = 1 * MB;
constexpr size_t WS_WBR = 35 * MB;
constexpr size_t WS_WO = 41 * MB;
constexpr size_t WS_WGU = 45 * MB;
constexpr size_t WS_WD = 56 * MB;
constexpr size_t WS_H = 62 * MB;
constexpr size_t WS_VF = 94 * MB;
constexpr size_t WS_Y = 126 * MB;
constexpr size_t WS_Z = 174 * MB;
constexpr size_t WS_S = 446 * MB;
constexpr size_t WS_YF = WS_S;
constexpr size_t WS_S0 = WS_S, WS_S1 = WS_S + 32 * MB, WS_S2 = WS_S + 64 * MB, WS_S3 = WS_S + 96 * MB, WS_S4 = WS_H;
constexpr size_t WS_ACT0 = WS_Z;
constexpr size_t WS_MACT = 1 * MB;
constexpr size_t WS_MW = 240 * MB;
constexpr size_t WS_MA = 408 * MB;
constexpr size_t WS_MY = 476 * MB;
constexpr size_t WS_LORAT = WS_S + 115 * MB;
constexpr size_t LORAT_LAYER = 512 * (64 + 64 + 128 + 32);
constexpr size_t WS_END = 544 * MB;
constexpr size_t MW_EXP_BYTES = (size_t)(7168 + 3584) * 1024 * 2;

constexpr int CW_CNT = 0;

__device__ __forceinline__ float bf2f(bf16_t b) { return __uint_as_float(((unsigned)b) << 16); }
__device__ __forceinline__ bf16_t f2bf(float f) { unsigned u = __float_as_uint(f); u += 0x7FFFu + ((u >> 16) & 1u); return (bf16_t)(u >> 16); }
__device__ __forceinline__ unsigned pk2(float lo, float hi) { return (unsigned)f2bf(lo) | ((unsigned)f2bf(hi) << 16); }
__device__ __forceinline__ unsigned cvt_pk_bf16(float lo, float hi) { unsigned r; asm volatile("v_cvt_pk_bf16_f32 %0, %1, %2" : "=v"(r) : "v"(lo), "v"(hi)); return r; }
__device__ __forceinline__ float sigmoidf_(float x) { return 1.f / (1.f + __expf(-x)); }
__device__ __forceinline__ float siluf_(float x) { return x / (1.f + __expf(-x)); }
__device__ __forceinline__ float softplusf_(float x) { return x > 20.f ? x : log1pf(__expf(x)); }
__device__ __forceinline__ float wave_sum(float v) {
#pragma unroll
    for (int o = 1; o < 64; o <<= 1) v += __shfl_xor(v, o);
    return v;
}

struct Job { const float* src; bf16_t* dst; long long src_bs, dst_bs; int K, ld_src, col0, ncols, ld_dst, r0, mode, batch, item0, nitems, pad0, pad1; };
constexpr int NJOBS0 = 27, NJOBS1 = 3, NJOBS = NJOBS0 + NJOBS1;
struct Args {
    const float* in[43];
    float* out;
    unsigned char* ws;
    Job jobs[NJOBS];
    int items0, items1;
    int ph_lo, ph_hi;
};
enum { I_X = 0, I_C, I_LNIN_G, I_LNIN_B, I_ADA_W, I_ADA_B, I_W_IN, I_GDN_CONV, I_GDN_ALOG, I_GDN_DTB, I_GDN_NG, I_ML_BI, I_ML_BF, I_ML_NG,
       I_RW_MU, I_RW_W0, I_RW_W2, I_RW_A0, I_RW_A2, I_RW_G2, I_RW_KK, I_RW_KA, I_RW_RK, I_RW_LNG, I_RW_LNB, I_RW_V1, I_RW_MUV1, I_RW_V0, I_RW_V2,
       I_W_BR, I_W_O, I_LN1_G, I_LN1_B, I_LN2_G, I_LN2_B, I_FFN_G, I_FFN_U, I_FFN_D, I_MOE_R, I_MOE_RB, I_MOE_G, I_MOE_U, I_MOE_D };

namespace pg8 {
constexpr int BM = 256, BK = 64, HALF = 128, HTB = HALF * BK * 2, STAGE_BYTES = 8 * HTB, NXCD = 8, WGM = 8;
__host__ __device__ __forceinline__ int lds_byte(int r, int c) { const int st = (r >> 4) * 2 + (c >> 5), rr = r & 15, cc = c & 31, ob = rr * 64 + cc * 2; return st * 1024 + (ob ^ (((ob >> 9) & 1) << 5)); }
__host__ __device__ __forceinline__ void stage_rc(int b, int& R, int& C) { const int st = b / 1024, sb = b % 1024, swz = sb ^ (((sb >> 9) & 1) << 5); R = (st >> 1) * 16 + swz / 64; C = (st & 1) * 32 + (swz % 64) / 2; }
__host__ __device__ __forceinline__ int perm32(int rho) { const int n = rho >> 4, i = rho & 15; return 8 * (i >> 2) + 4 * n + (i & 3); }

struct Unit { const char* a; const char* b; int pm, pn; };

__device__ __forceinline__ bool static_tile(int i, int G, int c, int nM, int nN, int& pm, int& pn) {
    const int nwg = nM * nN; const long L = (long)i * G + c; if (L >= nwg) return false;
    int wgid = (int)L; { const int q = nwg / NXCD, r = nwg % NXCD, xcd = wgid % NXCD, off = wgid / NXCD; wgid = (xcd < r ? xcd * (q + 1) : r * (q + 1) + (xcd - r) * q) + off; }
    const int nig = WGM * nN, gid = wgid / nig, fm = gid * WGM, gsz = (nM - fm) < WGM ? (nM - fm) : WGM;
    pm = fm + ((wgid % nig) % gsz); pn = (wgid % nig) / gsz; return true;
}
struct StaticOrder {
    const char* A; const char* Bt; int nM, nN, K, G, c;
    __device__ __forceinline__ bool next(int i, Unit& u) const {
        int pm, pn; if (!static_tile(i, G, c, nM, nN, pm, pn)) return false;
        u.pm = pm; u.pn = pn; u.a = A + (size_t)pm * BM * K * 2; u.b = Bt + (size_t)pn * BM * K * 2; return true;
    }
};
struct MoeOrder {
    const char* A; const char* W; const int* tile_exp; size_t wexp_bytes; int nM, nN, K, G, c;
    __device__ __forceinline__ bool next(int i, Unit& u) const {
        int pm, pn; if (!static_tile(i, G, c, nM, nN, pm, pn)) return false;
        const int e = tile_exp[pm];
        u.pm = pm; u.pn = pn; u.a = A + (size_t)pm * BM * K * 2; u.b = W + (size_t)e * wexp_bytes + (size_t)pn * BM * K * 2; return true;
    }
};

struct EpiBf16 {
    static constexpr bool PERM = true, HAS_MID = false;
    bf16_t* O; int ldc;
    __device__ __forceinline__ void mid(f32x4 (&)[2][2][4][2], const Unit&, int, int, int, int, int) const {}
    __device__ __forceinline__ void operator()(const f32x4 (&acc)[2][2][4][2], const Unit& u, int wr, int wc, int fr, int fq) const {
        const int row0 = u.pm * BM + wr * 64 + fr, col0 = u.pn * BM + wc * 32 + 8 * fq;
#pragma unroll
        for (int ai = 0; ai < 2; ++ai)
#pragma unroll
            for (int m = 0; m < 4; ++m) { bf16_t* rowp = O + (size_t)(row0 + ai * HALF + m * 16) * ldc + col0;
#pragma unroll
                for (int bj = 0; bj < 2; ++bj) { const f32x4 v0 = acc[ai][bj][m][0], v1 = acc[ai][bj][m][1];
                    u32x4 w; w.x = cvt_pk_bf16(v0[0], v0[1]); w.y = cvt_pk_bf16(v0[2], v0[3]); w.z = cvt_pk_bf16(v1[0], v1[1]); w.w = cvt_pk_bf16(v1[2], v1[3]);
                    *(u32x4*)(rowp + bj * HALF) = w; } }
    }
};
struct EpiSwiglu {
    static constexpr bool PERM = true, HAS_MID = false;
    bf16_t* O; int ldc;
    __device__ __forceinline__ void mid(f32x4 (&)[2][2][4][2], const Unit&, int, int, int, int, int) const {}
    __device__ __forceinline__ void operator()(const f32x4 (&acc)[2][2][4][2], const Unit& u, int wr, int wc, int fr, int fq) const {
        const int row0 = u.pm * BM + wr * 64 + fr, col0 = u.pn * HALF + wc * 32 + 8 * fq;
#pragma unroll
        for (int ai = 0; ai < 2; ++ai)
#pragma unroll
            for (int m = 0; m < 4; ++m) { bf16_t* rowp = O + (size_t)(row0 + ai * HALF + m * 16) * ldc + col0;
                float r[8];
#pragma unroll
                for (int n = 0; n < 2; ++n)
#pragma unroll
                    for (int j = 0; j < 4; ++j) { const float g = acc[ai][0][m][n][j], uu = acc[ai][1][m][n][j]; r[n * 4 + j] = g * uu * __builtin_amdgcn_rcpf(1.f + __expf(-g)); }
                u32x4 w; w.x = cvt_pk_bf16(r[0], r[1]); w.y = cvt_pk_bf16(r[2], r[3]); w.z = cvt_pk_bf16(r[4], r[5]); w.w = cvt_pk_bf16(r[6], r[7]);
                *(u32x4*)rowp = w; }
    }
};
struct EpiF32 {
    static constexpr bool PERM = false, HAS_MID = false;
    float* C; int ldc;
    __device__ __forceinline__ void mid(f32x4 (&)[2][2][4][2], const Unit&, int, int, int, int, int) const {}
    __device__ __forceinline__ void operator()(const f32x4 (&acc)[2][2][4][2], const Unit& u, int wr, int wc, int fr, int fq) const {
        const int row0 = u.pm * BM + wr * 64 + fr, col0 = u.pn * BM + wc * 32 + 4 * fq;
#pragma unroll
        for (int ai = 0; ai < 2; ++ai)
#pragma unroll
            for (int m = 0; m < 4; ++m) { float* rowp = C + (size_t)(row0 + ai * HALF + m * 16) * ldc + col0;
#pragma unroll
                for (int bj = 0; bj < 2; ++bj)
#pragma unroll
                    for (int n = 0; n < 2; ++n) *(f32x4*)(rowp + bj * HALF + n * 16) = acc[ai][bj][m][n]; }
    }
};
struct EpiMerge {
    static constexpr bool PERM = false, HAS_MID = true;
    const bf16_t* Z; bf16_t* O;
    __device__ __forceinline__ static float ez(bf16_t zb) { float z = bf2f(zb); z = fminf(fmaxf(z, -30.f), 30.f); return __expf(-z); }
    __device__ __forceinline__ void mid(f32x4 (&acc)[2][2][4][2], const Unit& u, int t, int wr, int wc, int fr, int fq) const {
        if (t != 8 && t != 16) return;
        const int gi = (t >> 3);
        const int row0 = u.pm * BM + wr * 64 + fr, col0 = u.pn * BM + wc * 32 + 4 * fq;
#pragma unroll
        for (int ai = 0; ai < 2; ++ai)
#pragma unroll
            for (int m = 0; m < 4; ++m) { const bf16_t* zr = Z + (size_t)(row0 + ai * HALF + m * 16) * ZW + ZC_GATE + col0;
#pragma unroll
                for (int bj = 0; bj < 2; ++bj)
#pragma unroll
                    for (int n = 0; n < 2; ++n) { const unsigned short* p0 = zr + (gi - 1) * 1024 + bj * HALF + n * 16; const unsigned short* p1 = zr + gi * 1024 + bj * HALF + n * 16;
                        const u32x2 a = *(const u32x2*)p0, b = *(const u32x2*)p1;
                        const bf16_t za[4] = {(bf16_t)(a.x & 0xffff), (bf16_t)(a.x >> 16), (bf16_t)(a.y & 0xffff), (bf16_t)(a.y >> 16)};
                        const bf16_t zb[4] = {(bf16_t)(b.x & 0xffff), (bf16_t)(b.x >> 16), (bf16_t)(b.y & 0xffff), (bf16_t)(b.y >> 16)};
#pragma unroll
                        for (int j = 0; j < 4; ++j) acc[ai][bj][m][n][j] *= (1.f + ez(zb[j])) * __builtin_amdgcn_rcpf(1.f + ez(za[j])); }
                asm volatile("" ::: "memory"); }
    }
    __device__ __forceinline__ void operator()(const f32x4 (&acc)[2][2][4][2], const Unit& u, int wr, int wc, int fr, int fq) const {
        const int row0 = u.pm * BM + wr * 64 + fr, col0 = u.pn * BM + wc * 32 + 4 * fq;
#pragma unroll
        for (int ai = 0; ai < 2; ++ai)
#pragma unroll
            for (int m = 0; m < 4; ++m) { const size_t r = (size_t)(row0 + ai * HALF + m * 16); const bf16_t* zr = Z + r * ZW + ZC_GATE + 2048 + col0; bf16_t* orow = O + r * 1024 + col0;
#pragma unroll
                for (int bj = 0; bj < 2; ++bj)
#pragma unroll
                    for (int n = 0; n < 2; ++n) { const u32x2 b = *(const u32x2*)(zr + bj * HALF + n * 16);
                        const bf16_t zb[4] = {(bf16_t)(b.x & 0xffff), (bf16_t)(b.x >> 16), (bf16_t)(b.y & 0xffff), (bf16_t)(b.y >> 16)};
                        float v[4];
#pragma unroll
                        for (int j = 0; j < 4; ++j) v[j] = acc[ai][bj][m][n][j] * __builtin_amdgcn_rcpf(1.f + ez(zb[j]));
                        u32x2 w; w.x = cvt_pk_bf16(v[0], v[1]); w.y = cvt_pk_bf16(v[2], v[3]); *(u32x2*)(orow + bj * HALF + n * 16) = w; }
                asm volatile("" ::: "memory"); }
    }
};

template <class Epi, class Sched>
__device__ __forceinline__ void gemm_phase(LAS unsigned char* lds, const int K, const Sched& S, const Epi& E) {
    int tid_ = threadIdx.x; asm volatile("" : "+v"(tid_));
    const int tid = tid_, wid = __builtin_amdgcn_readfirstlane(tid >> 6), lane = tid & 63, wr = wid >> 2, wc = wid & 3, fr = lane & 15, fq = lane >> 4;
    const int nt = K / BK;
    unsigned voffA[2], voffB[2];
#pragma unroll
    for (int i = 0; i < 2; ++i) { int R, C; stage_rc(tid * 16 + i * 8192, R, C); const int Rb = Epi::PERM ? ((R & ~31) + perm32(R & 31)) : R;
        voffA[i] = (unsigned)(R * K + C) * 2u; voffB[i] = (unsigned)(Rb * K + C) * 2u; }
    const size_t kstep = (size_t)(BK * 2);
    const size_t hstep = (size_t)HALF * K * 2;
    const unsigned ldsw = (unsigned)wid * 1024u;
    const int aoff = lds_byte(wr * 64 + fr, fq * 8), boff = lds_byte(wc * 32 + fr, fq * 8);
#define PG8_SA(b, h) (((b) * 2 + (h)) * HTB)
#define PG8_SB(b, h) ((4 + (b) * 2 + (h)) * HTB)
#define PG8_STAGE(bufoff, gbase, voff) do { _Pragma("unroll") for (int _i = 0; _i < 2; ++_i) \
        __builtin_amdgcn_global_load_lds((const unsigned*)((const char*)(gbase) + (voff)[_i]), (LAS unsigned*)(lds + (bufoff) + ldsw + _i * 8192), 16, 0, 0); } while (0)
#define PG8_LDA(dst, b, h) do { _Pragma("unroll") for (int m = 0; m < 4; ++m) _Pragma("unroll") for (int k = 0; k < 2; ++k) dst[m][k] = *(const LAS bf16x8*)(lds + PG8_SA(b, h) + aoff + m * 2048 + k * 1024); } while (0)
#define PG8_LDB(dst, b, h) do { _Pragma("unroll") for (int n = 0; n < 2; ++n) _Pragma("unroll") for (int k = 0; k < 2; ++k) dst[n][k] = *(const LAS bf16x8*)(lds + PG8_SB(b, h) + boff + n * 2048 + k * 1024); } while (0)
#define PG8_MMA(ai, bj, At, Bt) do { __builtin_amdgcn_s_setprio(1); _Pragma("unroll") for (int m = 0; m < 4; ++m) _Pragma("unroll") for (int n = 0; n < 2; ++n) _Pragma("unroll") for (int k = 0; k < 2; ++k) \
        acc[ai][bj][m][n] = __builtin_amdgcn_mfma_f32_16x16x32_bf16(Bt[n][k], At[m][k], acc[ai][bj][m][n], 0, 0, 0); __builtin_amdgcn_s_setprio(0); } while (0)
#define PG8_WAIT_V(n) asm volatile("s_waitcnt vmcnt(" #n ")" ::: "memory")
#define PG8_WAIT_L(n) asm volatile("s_waitcnt lgkmcnt(" #n ")" ::: "memory")
#define PG8_BAR __builtin_amdgcn_s_barrier()
#define PG8_SCHED __builtin_amdgcn_sched_barrier(0)
    Unit cur, nxt; int ui = 0;
    if (!S.next(0, cur)) return;
    f32x4 acc[2][2][4][2];
#pragma unroll
    for (int a = 0; a < 2; ++a)
#pragma unroll
        for (int b = 0; b < 2; ++b)
#pragma unroll
            for (int m = 0; m < 4; ++m)
#pragma unroll
                for (int n = 0; n < 2; ++n) acc[a][b][m][n] = (f32x4){0.f, 0.f, 0.f, 0.f};
    bf16x8 At[4][2], B0[2][2], B1[2][2];
    const char* cA = cur.a; const char* cB = cur.b;
    PG8_STAGE(PG8_SB(0, 0), cB, voffB); PG8_STAGE(PG8_SA(0, 0), cA, voffA); PG8_STAGE(PG8_SB(0, 1), cB + hstep, voffB); PG8_STAGE(PG8_SA(0, 1), cA + hstep, voffA);
    if (wr == 1) PG8_BAR;
    PG8_WAIT_V(4); PG8_BAR;
    PG8_STAGE(PG8_SB(1, 0), cB + kstep, voffB); PG8_STAGE(PG8_SA(1, 0), cA + kstep, voffA); PG8_STAGE(PG8_SB(1, 1), cB + hstep + kstep, voffB);
    PG8_WAIT_V(6); PG8_BAR;
    for (;;) {
        const bool has_next = S.next(ui + 1, nxt);
        const char* nA = has_next ? nxt.a : cA; const char* nB = has_next ? nxt.b : cB;
        for (int t = 0; t < nt; t += 2) {
            const bool last = (t == nt - 2);
            const char* a1 = cA + (size_t)(t + 1) * kstep;
            const char* a2 = last ? nA : cA + (size_t)(t + 2) * kstep; const char* b2 = last ? nB : cB + (size_t)(t + 2) * kstep;
            const char* a3 = a2 + kstep; const char* b3 = b2 + kstep;
            if constexpr (Epi::HAS_MID) E.mid(acc, cur, t, wr, wc, fr, fq);
            PG8_LDB(B0, 0, 0); PG8_SCHED; PG8_LDA(At, 0, 0); PG8_STAGE(PG8_SA(1, 1), a1 + hstep, voffA);
            PG8_WAIT_L(8); PG8_BAR; PG8_WAIT_L(0); PG8_MMA(0, 0, At, B0); PG8_BAR; PG8_SCHED;
            PG8_LDB(B1, 0, 1); PG8_STAGE(PG8_SB(0, 0), b2, voffB);
            PG8_BAR; PG8_WAIT_L(0); PG8_MMA(0, 1, At, B1); PG8_BAR;
            PG8_LDA(At, 0, 1); PG8_STAGE(PG8_SA(0, 0), a2, voffA);
            PG8_BAR; PG8_WAIT_L(0); PG8_MMA(1, 0, At, B0); PG8_BAR; PG8_SCHED;
            PG8_STAGE(PG8_SB(0, 1), b2 + hstep, voffB);
            PG8_WAIT_V(6); PG8_BAR; PG8_MMA(1, 1, At, B1); PG8_BAR;
            PG8_LDB(B0, 1, 0); PG8_SCHED; PG8_LDA(At, 1, 0); PG8_STAGE(PG8_SA(0, 1), a2 + hstep, voffA);
            PG8_WAIT_L(8); PG8_BAR; PG8_WAIT_L(0); PG8_MMA(0, 0, At, B0); PG8_BAR; PG8_SCHED;
            PG8_LDB(B1, 1, 1); PG8_STAGE(PG8_SB(1, 0), b3, voffB);
            PG8_BAR; PG8_WAIT_L(0); PG8_MMA(0, 1, At, B1); PG8_BAR;
            PG8_LDA(At, 1, 1); PG8_STAGE(PG8_SA(1, 0), a3, voffA);
            PG8_BAR; PG8_WAIT_L(0); PG8_MMA(1, 0, At, B0); PG8_BAR; PG8_SCHED;
            PG8_STAGE(PG8_SB(1, 1), b3 + hstep, voffB);
            PG8_WAIT_V(6); PG8_BAR; PG8_MMA(1, 1, At, B1); PG8_BAR;
        }
        E(acc, cur, wr, wc, fr, fq);
        if (!has_next) break;
#pragma unroll
        for (int a = 0; a < 2; ++a)
#pragma unroll
            for (int b = 0; b < 2; ++b)
#pragma unroll
                for (int m = 0; m < 4; ++m)
#pragma unroll
                    for (int n = 0; n < 2; ++n) acc[a][b][m][n] = (f32x4){0.f, 0.f, 0.f, 0.f};
        cur = nxt; cA = nA; cB = nB; ++ui;
    }
    PG8_WAIT_V(0);
    if (wr == 0) PG8_BAR;
    PG8_BAR;
#undef PG8_SA
#undef PG8_SB
#undef PG8_STAGE
#undef PG8_LDA
#undef PG8_LDB
#undef PG8_MMA
#undef PG8_WAIT_V
#undef PG8_WAIT_L
#undef PG8_BAR
#undef PG8_SCHED
}
}

constexpr int NWAVES = 8, NTHREADS = NWAVES * 64;
constexpr int LDS_BYTES = pg8::STAGE_BYTES;
struct Frame {
    LAS unsigned char* lds;
    int tid, lane, wave, G, bid;
    const Args* a;
    unsigned char* ws;
};
__device__ __forceinline__ const float* lp_(const float* p) { asm volatile("" : "+s"(p)); return p; }
#define INP(i) lp_(F.a->in[i])
#define LAUNDER(F) asm volatile("" : "+v"((F).lane), "+v"((F).tid))

__device__ __forceinline__ void conv_item(const Job& J, int local, LAS float* scr, int lane) {
    const int nkb = (J.K + 63) / 64, nnb = (J.ncols + 31) / 32, per = nkb * nnb;
    const int bi = local / per, rem = local % per, kb = rem / nnb, nb = rem % nnb, k0 = 64 * kb, n0 = 32 * nb;
    const float* W = J.src + (size_t)bi * J.src_bs; bf16_t* WT = J.dst + (size_t)bi * J.dst_bs;
    const int cl = n0 + (lane & 31); const bool okc = cl < J.ncols;
#pragma unroll 8
    for (int i = 0; i < 32; ++i) { const int kk = 2 * i + (lane >> 5); scr[kk * 33 + (lane & 31)] = (okc && k0 + kk < J.K) ? W[(size_t)(k0 + kk) * J.ld_src + J.col0 + cl] : 0.f; }
    asm volatile("s_waitcnt lgkmcnt(0)" ::: "memory");
    const int c = lane & 7;
#pragma unroll
    for (int j = 0; j < 4; ++j) { const int n = (lane >> 3) + 8 * j; const LAS float* s = scr + (8 * c) * 33 + n; const int cc = n0 + n;
        if (cc < J.ncols && k0 + 8 * c < J.K) { const int drow = J.r0 + (J.mode ? ((cc >> 7) * 256 + (cc & 127)) : cc);
            u32x4 o; o.x = pk2(s[0 * 33], s[1 * 33]); o.y = pk2(s[2 * 33], s[3 * 33]); o.z = pk2(s[4 * 33], s[5 * 33]); o.w = pk2(s[6 * 33], s[7 * 33]);
            *(u32x4*)(WT + (size_t)drow * J.ld_dst + k0 + 8 * c) = o; } }
    asm volatile("s_waitcnt lgkmcnt(0)" ::: "memory");
}
__device__ __forceinline__ void phase_convert(Frame& F, int j0, int j1, int it0, int nitems) {
    LAUNDER(F);
    LAS float* scr = (LAS float*)(F.lds + F.wave * 8704);
    const int gw = F.bid * NWAVES + F.wave, NGW = F.G * NWAVES;
    for (int it = it0 + gw; it < nitems; it += NGW) {
        int j = j0;
        while (j + 1 < j1 && it >= F.a->jobs[j + 1].item0) ++j;
        conv_item(F.a->jobs[j], it - F.a->jobs[j].item0, scr, F.lane);
    }
}

__device__ __forceinline__ void phase_mod(Frame& F) {
    LAUNDER(F);
    float* mod = (float*)(F.ws + WS_MOD);
    LAS float* red = (LAS float*)(F.lds + 72 * 1024);
    const float* cvec = INP(I_C);
    for (int item = F.bid; item < 2 * 96; item += F.G) {
        const int l = item / 96, n0 = (item % 96) * 64;
        const float* W = INP(I_ADA_W) + (size_t)l * 1024 * 6144 + n0 + F.lane;
        float a0 = 0.f, a1 = 0.f;
        const int kbeg = F.wave * 128;
#pragma unroll 8
        for (int k = kbeg; k < kbeg + 128; ++k) { const float w = W[(size_t)k * 6144]; a0 += siluf_(cvec[k]) * w; a1 += siluf_(cvec[1024 + k]) * w; }
        red[(F.wave * 2 + 0) * 64 + F.lane] = a0; red[(F.wave * 2 + 1) * 64 + F.lane] = a1;
        __syncthreads();
        if (F.tid < 128) { const int b = F.tid >> 6, ln = F.tid & 63; float s = 0.f;
#pragma unroll
            for (int w = 0; w < 8; ++w) s += red[(w * 2 + b) * 64 + ln];
            mod[(size_t)(l * 2 + b) * 6144 + n0 + ln] = s + INP(I_ADA_B)[l * 6144 + n0 + ln]; }
        __syncthreads();
    }
}

__device__ __forceinline__ void phase_ln(Frame& F, int kind, const float* lg, const float* lb, int gt_layer, int gt_off, int h_layer, int sh_off, int sc_off, bool route, bool last) {
    LAUNDER(F);
    const float* mod = (const float*)(F.ws + WS_MOD);
    float* X = F.a->out;
    const float* YF = (const float*)(F.ws + WS_YF);
    bf16_t* H = (bf16_t*)(F.ws + WS_H);
    const int gw = F.bid * NWAVES + F.wave, NGW = F.G * NWAVES;
    for (int row = gw; row < NTOK; row += NGW) {
        const int b = row / SEQ;
        f32x4 v[4];
        if (kind == 0) {
            const f32x4* xr = (const f32x4*)(INP(I_X) + (size_t)row * D) + F.lane;
#pragma unroll
            for (int j = 0; j < 4; ++j) v[j] = xr[64 * j];
        } else {
            const f32x4* xr = (const f32x4*)(X + (size_t)row * D) + F.lane;
            const f32x4* gt = (const f32x4*)(mod + (size_t)(gt_layer * 2 + b) * 6144 + gt_off) + F.lane;
            if (kind == 1) {
                const f32x4* yr = (const f32x4*)(YF + (size_t)row * D) + F.lane;
#pragma unroll
                for (int j = 0; j < 4; ++j) v[j] = DN_ALPHA * xr[64 * j] + (1.f + gt[64 * j]) * yr[64 * j];
            } else {
                const int2 rr = ((const int2*)(F.ws + WS_TOPP))[row];
                const float2 gg = ((const float2*)(F.ws + WS_TOPG))[row];
                const bf16_t* ym = (const bf16_t*)(F.ws + WS_MY);
                const u32x2* y0 = (const u32x2*)(ym + (size_t)rr.x * D) + F.lane; const u32x2* y1 = (const u32x2*)(ym + (size_t)rr.y * D) + F.lane;
#pragma unroll
                for (int j = 0; j < 4; ++j) { const u32x2 p = y0[64 * j], q = y1[64 * j];
                    f32x4 y; y[0] = gg.x * __uint_as_float(p.x << 16) + gg.y * __uint_as_float(q.x << 16); y[1] = gg.x * __uint_as_float(p.x & 0xffff0000u) + gg.y * __uint_as_float(q.x & 0xffff0000u);
                    y[2] = gg.x * __uint_as_float(p.y << 16) + gg.y * __uint_as_float(q.y << 16); y[3] = gg.x * __uint_as_float(p.y & 0xffff0000u) + gg.y * __uint_as_float(q.y & 0xffff0000u);
                    v[j] = DN_ALPHA * xr[64 * j] + (1.f + gt[64 * j]) * y; }
            }
        }
        float s = 0.f;
#pragma unroll
        for (int j = 0; j < 4; ++j) s += (v[j][0] + v[j][1]) + (v[j][2] + v[j][3]);
        const float mean = wave_sum(s) * (1.f / D); float s2 = 0.f;
#pragma unroll
        for (int j = 0; j < 4; ++j) { v[j] = v[j] - mean; s2 += (v[j][0] * v[j][0] + v[j][1] * v[j][1]) + (v[j][2] * v[j][2] + v[j][3] * v[j][3]); }
        const float rstd = 1.f / sqrtf(wave_sum(s2) * (1.f / D) + LN_EPS);
        const f32x4* g4 = (const f32x4*)lg + F.lane; const f32x4* b4 = (const f32x4*)lb + F.lane;
        f32x4* xo = (f32x4*)(X + (size_t)row * D) + F.lane;
#pragma unroll
        for (int j = 0; j < 4; ++j) { v[j] = v[j] * rstd * g4[64 * j] + b4[64 * j]; xo[64 * j] = v[j]; }
        if (!last) {
            const f32x4* sh = (const f32x4*)(mod + (size_t)(h_layer * 2 + b) * 6144 + sh_off) + F.lane; const f32x4* sc = (const f32x4*)(mod + (size_t)(h_layer * 2 + b) * 6144 + sc_off) + F.lane;
            u32x2* ho = (u32x2*)(H + (size_t)row * D) + F.lane;
#pragma unroll
            for (int j = 0; j < 4; ++j) { v[j] = v[j] * (1.f + sc[64 * j]) + sh[64 * j]; u32x2 w; w.x = pk2(v[j][0], v[j][1]); w.y = pk2(v[j][2], v[j][3]); ho[64 * j] = w; }
            if (route) {
                const float* rw = INP(I_MOE_R); float lg8[8];
#pragma unroll
                for (int e = 0; e < 8; ++e) lg8[e] = 0.f;
#pragma unroll
                for (int j = 0; j < 4; ++j)
#pragma unroll
                    for (int q = 0; q < 4; ++q) { const int c = 4 * F.lane + 256 * j + q; const f32x4 w0 = *(const f32x4*)(rw + c * 8), w1 = *(const f32x4*)(rw + c * 8 + 4); const float hv = v[j][q];
                        lg8[0] += hv * w0[0]; lg8[1] += hv * w0[1]; lg8[2] += hv * w0[2]; lg8[3] += hv * w0[3]; lg8[4] += hv * w1[0]; lg8[5] += hv * w1[1]; lg8[6] += hv * w1[2]; lg8[7] += hv * w1[3]; asm volatile("" ::: "memory"); }
#pragma unroll
                for (int e = 0; e < 8; ++e) lg8[e] = wave_sum(lg8[e]) + INP(I_MOE_RB)[e];
                int e0 = 0; float l0 = lg8[0];
#pragma unroll
                for (int e = 1; e < 8; ++e) if (lg8[e] > l0) { l0 = lg8[e]; e0 = e; }
                int e1 = -1; float l1 = -3.0e38f;
#pragma unroll
                for (int e = 0; e < 8; ++e) if (e != e0 && lg8[e] > l1) { l1 = lg8[e]; e1 = e; }
                if (F.lane == 0) {
                    const float g0 = 1.f / (1.f + __expf(l1 - l0));
                    unsigned* cnt = (unsigned*)(F.ws + WS_CTL) + CW_CNT;
                    const int p0 = (int)atomicAdd(cnt + e0, 1u), p1 = (int)atomicAdd(cnt + e1, 1u);
                    ((int2*)(F.ws + WS_TOPE))[row] = make_int2(e0, e1); ((float2*)(F.ws + WS_TOPG))[row] = make_float2(g0, 1.f - g0); ((int2*)(F.ws + WS_TOPP))[row] = make_int2(p0, p1);
                }
            }
        }
    }
}

constexpr size_t WS_TEXP = 640 * 1024;
__device__ __forceinline__ void phase_moe_setup(Frame& F) {
    LAUNDER(F);
    const unsigned* cnt = (const unsigned*)(F.ws + WS_CTL) + CW_CNT;
    int pstart[8]; int tot = 0;
#pragma unroll
    for (int e = 0; e < 8; ++e) { pstart[e] = tot; tot += ((int)cnt[e] + 255) / 256 * 256; }
    int* texp = (int*)(F.ws + WS_TEXP);
    if (F.bid == 0 && F.tid < MOE_RT_MAX + 1) {
        if (F.tid == MOE_RT_MAX) texp[MOE_RT_MAX] = tot / 256;
        else { int e = 0;
#pragma unroll
            for (int q = 1; q < 8; ++q) if (F.tid * 256 >= pstart[q]) e = q;
            texp[F.tid] = e; }
    }
    const bf16_t* H = (const bf16_t*)(F.ws + WS_H); bf16_t* MA = (bf16_t*)(F.ws + WS_MA);
    const int gw = F.bid * NWAVES + F.wave, NGW = F.G * NWAVES;
    for (int row = gw; row < NTOK; row += NGW) {
        const int2 ee = ((const int2*)(F.ws + WS_TOPE))[row]; int2 pp = ((const int2*)(F.ws + WS_TOPP))[row];
        int r0 = pp.x, r1 = pp.y;
#pragma unroll
        for (int e = 0; e < 8; ++e) { if (ee.x == e) r0 += pstart[e]; if (ee.y == e) r1 += pstart[e]; }
        const u32x4* src = (const u32x4*)(H + (size_t)row * D) + F.lane;
        const u32x4 a = src[0], b = src[64];
        u32x4* d0 = (u32x4*)(MA + (size_t)r0 * D) + F.lane; u32x4* d1 = (u32x4*)(MA + (size_t)r1 * D) + F.lane;
        d0[0] = a; d0[64] = b; d1[0] = a; d1[64] = b;
        if (F.lane == 0) ((int2*)(F.ws + WS_TOPP))[row] = make_int2(r0, r1);
    }
}

__device__ __forceinline__ void phase_gdn_prep(Frame& F, int l) {
    LAUNDER(F);
    const bf16_t* Z = (const bf16_t*)(F.ws + WS_Z);
    float* Q = (float*)(F.ws + WS_S0); float* Kk = (float*)(F.ws + WS_S1); float* V = (float*)(F.ws + WS_S2); float* AB = (float*)(F.ws + WS_S3);
    const float* cw = INP(I_GDN_CONV) + (size_t)l * 4 * 1536;
    const int gw = F.bid * NWAVES + F.wave, NGW = F.G * NWAVES;
    for (int it = gw; it < NTOK * 4; it += NGW) {
        const int row = it >> 2, h = it & 3, t = row % SEQ;
        float o[3][2];
#pragma unroll
        for (int g = 0; g < 3; ++g)
#pragma unroll
            for (int p = 0; p < 2; ++p) { const int c = g * 512 + h * 128 + F.lane + 64 * p; float s = 0.f;
#pragma unroll
                for (int j = 0; j < 4; ++j) { const int tt = t - 3 + j; if (tt >= 0) s += cw[j * 1536 + c] * bf2f(Z[(size_t)(row - 3 + j) * ZW + c]); }
                o[g][p] = siluf_(s); }
        const float nq = wave_sum(o[0][0] * o[0][0] + o[0][1] * o[0][1]), nk = wave_sum(o[1][0] * o[1][0] + o[1][1] * o[1][1]);
        const float rq = rsqrtf(nq + 1e-6f) * 0.08838834764831845f, rk = rsqrtf(nk + 1e-6f);
#pragma unroll
        for (int p = 0; p < 2; ++p) { const size_t idx = (size_t)row * 512 + h * 128 + F.lane + 64 * p; Q[idx] = o[0][p] * rq; Kk[idx] = o[1][p] * rk; V[idx] = o[2][p]; }
        if (F.lane == 0) {
            const float a = bf2f(Z[(size_t)row * ZW + ZC_GA + h]), bb = bf2f(Z[(size_t)row * ZW + ZC_GB + h]);
            const float g = -__expf(INP(I_GDN_ALOG)[l * 4 + h]) * softplusf_(a + INP(I_GDN_DTB)[l * 4 + h]);
            AB[(size_t)row * 8 + h * 2] = __expf(g); AB[(size_t)row * 8 + h * 2 + 1] = sigmoidf_(bb);
        }
    }
}
__device__ __forceinline__ void phase_gdn_core(Frame& F) {
    LAUNDER(F);
    if (F.bid >= 8) return;
    const int b = F.bid >> 2, h = F.bid & 3;
    float* Q = (float*)(F.ws + WS_S0); float* Kk = (float*)(F.ws + WS_S1); float* V = (float*)(F.ws + WS_S2); const float* AB = (const float*)(F.ws + WS_S3);
    LAS float* sq = (LAS float*)F.lds; LAS float* sk = sq + 16 * 128; LAS float* sv = sk + 16 * 128; LAS float* sab = sv + 16 * 128;
    float s[32];
#pragma unroll
    for (int i = 0; i < 32; ++i) s[i] = 0.f;
    const int j = F.tid >> 2, p = F.tid & 3;
    for (int t0 = 0; t0 < SEQ; t0 += 16) {
        const size_t rbase = (size_t)b * SEQ + t0;
        for (int e = F.tid; e < 16 * 128; e += NTHREADS) { const int tt = e >> 7, c = e & 127; const size_t idx = (rbase + tt) * 512 + h * 128 + c; sq[e] = Q[idx]; sk[e] = Kk[idx]; sv[e] = V[idx]; }
        if (F.tid < 32) sab[F.tid] = AB[(rbase + (F.tid >> 1)) * 8 + h * 2 + (F.tid & 1)];
        __syncthreads();
        for (int tt = 0; tt < 16; ++tt) {
            const float al = sab[tt * 2], be = sab[tt * 2 + 1];
            float k0 = 0.f, k1 = 0.f;
#pragma unroll
            for (int i = 0; i < 32; i += 4) { const f32x4 kk = *(const LAS f32x4*)(sk + tt * 128 + 32 * p + i); k0 += kk[0] * s[i] + kk[2] * s[i + 2]; k1 += kk[1] * s[i + 1] + kk[3] * s[i + 3]; }
            float kS = k0 + k1; kS += __shfl_xor(kS, 1); kS += __shfl_xor(kS, 2);
            const float c = be * (sv[tt * 128 + j] - al * kS);
            float o0 = 0.f, o1 = 0.f;
#pragma unroll
            for (int i = 0; i < 32; i += 4) { const f32x4 kk = *(const LAS f32x4*)(sk + tt * 128 + 32 * p + i); const f32x4 qq = *(const LAS f32x4*)(sq + tt * 128 + 32 * p + i);
                s[i] = al * s[i] + c * kk[0]; s[i + 1] = al * s[i + 1] + c * kk[1]; s[i + 2] = al * s[i + 2] + c * kk[2]; s[i + 3] = al * s[i + 3] + c * kk[3];
                o0 += qq[0] * s[i] + qq[2] * s[i + 2]; o1 += qq[1] * s[i + 1] + qq[3] * s[i + 3]; }
            float o = o0 + o1; o += __shfl_xor(o, 1); o += __shfl_xor(o, 2);
            if (p == 0) V[(rbase + tt) * 512 + h * 128 + j] = o;
        }
        __syncthreads();
    }
}
__device__ __forceinline__ void phase_gdn_post(Frame& F, int l) {
    LAUNDER(F);
    const bf16_t* Z = (const bf16_t*)(F.ws + WS_Z); const float* O = (const float*)(F.ws + WS_S2); bf16_t* Y = (bf16_t*)(F.ws + WS_Y);
    const float* ng = INP(I_GDN_NG) + l * 128;
    const int gw = F.bid * NWAVES + F.wave, NGW = F.G * NWAVES;
    for (int it = gw; it < NTOK * 4; it += NGW) {
        const int row = it >> 2, h = it & 3;
        const float a = O[(size_t)row * 512 + h * 128 + F.lane], b = O[(size_t)row * 512 + h * 128 + 64 + F.lane];
        const float r = rsqrtf(wave_sum(a * a + b * b) * (1.f / 128.f) + 1e-6f);
        const float z0 = bf2f(Z[(size_t)row * ZW + ZC_GZ + h * 128 + F.lane]), z1 = bf2f(Z[(size_t)row * ZW + ZC_GZ + h * 128 + 64 + F.lane]);
        Y[(size_t)row * 1536 + h * 128 + F.lane] = f2bf(a * r * ng[F.lane] * siluf_(z0));
        Y[(size_t)row * 1536 + h * 128 + 64 + F.lane] = f2bf(b * r * ng[64 + F.lane] * siluf_(z1));
    }
}

__device__ __forceinline__ float capf_(float t) { return 15.f * tanhf(t * (1.f / 15.f)); }
__device__ __forceinline__ void phase_ml_prep(Frame& F, int l) {
    LAUNDER(F);
    const bf16_t* Z = (const bf16_t*)(F.ws + WS_Z); float* IFg = (float*)(F.ws + WS_S3);
    const int gt = F.bid * NTHREADS + F.tid, NGT = F.G * NTHREADS;
    for (int it = gt; it < NTOK * 4; it += NGT) {
        const int row = it >> 2, h = it & 3;
        const float ip = bf2f(Z[(size_t)row * ZW + ZC_MI + h]) + INP(I_ML_BI)[l * 4 + h], fp = bf2f(Z[(size_t)row * ZW + ZC_MF + h]) + INP(I_ML_BF)[l * 4 + h];
        IFg[(size_t)row * 8 + h * 2] = __expf(capf_(ip)); IFg[(size_t)row * 8 + h * 2 + 1] = sigmoidf_(capf_(fp));
    }
}
__device__ __forceinline__ void phase_ml_core(Frame& F) {
    LAUNDER(F);
    if (F.bid >= 8) return;
    const int b = F.bid >> 2, h = F.bid & 3;
    const bf16_t* Z = (const bf16_t*)(F.ws + WS_Z); const float* IFg = (const float*)(F.ws + WS_S3); float* Hh = (float*)(F.ws + WS_S2);
    LAS float* sq = (LAS float*)F.lds; LAS float* sk = sq + 16 * 64; LAS float* sv = sk + 16 * 64; LAS float* sif = sv + 16 * 128;
    float c[16], n[16];
#pragma unroll
    for (int i = 0; i < 16; ++i) { c[i] = 0.f; n[i] = 0.f; }
    const int j = F.tid >> 2, p = F.tid & 3;
    for (int t0 = 0; t0 < SEQ; t0 += 16) {
        const size_t rbase = (size_t)b * SEQ + t0;
        for (int e = F.tid; e < 16 * 64; e += NTHREADS) { const int tt = e >> 6, cc = e & 63; const bf16_t* zr = Z + (rbase + tt) * ZW; sq[e] = bf2f(zr[ZC_MQ + h * 64 + cc]); sk[e] = bf2f(zr[ZC_MK + h * 64 + cc]) * 0.125f; }
        for (int e = F.tid; e < 16 * 128; e += NTHREADS) { const int tt = e >> 7, cc = e & 127; sv[e] = bf2f(Z[(rbase + tt) * ZW + ZC_MV + h * 128 + cc]); }
        if (F.tid < 32) sif[F.tid] = IFg[(rbase + (F.tid >> 1)) * 8 + h * 2 + (F.tid & 1)];
        __syncthreads();
        for (int tt = 0; tt < 16; ++tt) {
            const float ig = sif[tt * 2], fg = sif[tt * 2 + 1]; const float iv = ig * sv[tt * 128 + j];
            float a0 = 0.f, d0 = 0.f;
#pragma unroll
            for (int i = 0; i < 16; i += 4) { const f32x4 kk = *(const LAS f32x4*)(sk + tt * 64 + 16 * p + i); const f32x4 qq = *(const LAS f32x4*)(sq + tt * 64 + 16 * p + i);
#pragma unroll
                for (int u = 0; u < 4; ++u) { c[i + u] = fg * c[i + u] + iv * kk[u]; n[i + u] = fg * n[i + u] + ig * kk[u]; a0 += qq[u] * c[i + u]; d0 += qq[u] * n[i + u]; } }
            a0 += __shfl_xor(a0, 1); a0 += __shfl_xor(a0, 2); d0 += __shfl_xor(d0, 1); d0 += __shfl_xor(d0, 2);
            if (p == 0) Hh[(rbase + tt) * 512 + h * 128 + j] = a0 / fmaxf(fabsf(d0), 1.f);
        }
        __syncthreads();
    }
}
__device__ __forceinline__ void phase_ml_post(Frame& F, int l) {
    LAUNDER(F);
    const bf16_t* Z = (const bf16_t*)(F.ws + WS_Z); const float* O = (const float*)(F.ws + WS_S2); bf16_t* Y = (bf16_t*)(F.ws + WS_Y);
    const float* ng = INP(I_ML_NG) + l * 512;
    const int gw = F.bid * NWAVES + F.wave, NGW = F.G * NWAVES;
    for (int it = gw; it < NTOK * 4; it += NGW) {
        const int row = it >> 2, h = it & 3;
        const float a = O[(size_t)row * 512 + h * 128 + F.lane], b = O[(size_t)row * 512 + h * 128 + 64 + F.lane];
        const float r = rsqrtf(wave_sum(a * a + b * b) * (1.f / 128.f) + 1e-6f);
        const float z0 = bf2f(Z[(size_t)row * ZW + ZC_MO + h * 128 + F.lane]), z1 = bf2f(Z[(size_t)row * ZW + ZC_MO + h * 128 + 64 + F.lane]);
        Y[(size_t)row * 1536 + 512 + h * 128 + F.lane] = f2bf(a * r * ng[h * 128 + F.lane] * sigmoidf_(z0));
        Y[(size_t)row * 1536 + 512 + h * 128 + 64 + F.lane] = f2bf(b * r * ng[h * 128 + 64 + F.lane] * sigmoidf_(z1));
    }
}


__device__ __forceinline__ const LAS bf16x8* vec8_ptr(const LAS bf16_t*) { return nullptr; }
__device__ __forceinline__ const LAS bf16x8* vec8_ptr(LAS bf16_t*) { return nullptr; }
__device__ __forceinline__ const bf16x8* vec8_ptr(const bf16_t*) { return nullptr; }
template <int K, class PA, class PB> __device__ __forceinline__ f32x4 mma_tile(PA A, int lda, PB Bt, int ldb, int m0, int n0, f32x4 acc, int lane) {
    const int r = lane & 15, q = lane >> 4;
#pragma unroll
    for (int k0 = 0; k0 < K; k0 += 32) {
        const bf16x8 a = *(decltype(vec8_ptr(A)))(A + (m0 + r) * lda + k0 + 8 * q);
        const bf16x8 b = *(decltype(vec8_ptr(Bt)))(Bt + (n0 + r) * ldb + k0 + 8 * q);
        acc = __builtin_amdgcn_mfma_f32_16x16x32_bf16(a, b, acc, 0, 0, 0);
    }
    return acc;
}
__device__ __forceinline__ u32x2 pack4(f32x4 v) { u32x2 w; w.x = pk2(v[0], v[1]); w.y = pk2(v[2], v[3]); return w; }
__device__ __forceinline__ f32x4 unpack4(u32x2 w) { f32x4 v; v[0] = __uint_as_float(w.x << 16); v[1] = __uint_as_float(w.x & 0xffff0000u); v[2] = __uint_as_float(w.y << 16); v[3] = __uint_as_float(w.y & 0xffff0000u); return v; }
__device__ __forceinline__ float wave_incl_scan(float x, int lane) {
#pragma unroll
    for (int o = 1; o < 64; o <<= 1) { const float y = __shfl_up(x, o); if (lane >= o) x += y; }
    return x;
}

constexpr size_t WS_MLB = WS_S + 97 * MB;
constexpr size_t WS_MLT = WS_S + 113 * MB;
constexpr size_t WS_MLN = WS_S + 114 * MB;
__device__ __forceinline__ void ml_gates(Frame& F, int l, int h, int row0, LAS float* bc, LAS float* li) {
    if (F.wave == 0) {
        const bf16_t* Z = (const bf16_t*)(F.ws + WS_Z) + (size_t)(row0 + F.lane) * ZW;
        const float ip = bf2f(Z[ZC_MI + h]) + INP(I_ML_BI)[l * 4 + h], fp = bf2f(Z[ZC_MF + h]) + INP(I_ML_BF)[l * 4 + h];
        const float lf = -softplusf_(-capf_(fp));
        bc[F.lane] = wave_incl_scan(lf, F.lane); li[F.lane] = capf_(ip);
    }
}
__device__ __forceinline__ void ml_sa_item(Frame& F, int l, int item) {
    const int bh = item >> 7, c = item & 127, b = bh >> 2, h = bh & 3, row0 = b * SEQ + c * 64;
    LAS float* bc = (LAS float*)F.lds; LAS float* li = bc + 64;
    LAS bf16_t* KwT = (LAS bf16_t*)(F.lds + 1024); LAS bf16_t* VT = (LAS bf16_t*)(F.lds + 10240);
    const bf16_t* Z = (const bf16_t*)(F.ws + WS_Z);
    ml_gates(F, l, h, row0, bc, li);
    __syncthreads();
    {
        const int t = F.tid & 63, u = F.tid >> 6; const bf16_t* zr = Z + (size_t)(row0 + t) * ZW;
        const float ew = __expf(bc[63] - bc[t] + li[t]) * 0.125f;
        const u32x4 kq = *(const u32x4*)(zr + ZC_MK + h * 64 + 8 * u);
        const unsigned kw[4] = {kq.x, kq.y, kq.z, kq.w};
#pragma unroll
        for (int j = 0; j < 4; ++j) { KwT[(8 * u + 2 * j) * 72 + t] = f2bf(__uint_as_float(kw[j] << 16) * ew); KwT[(8 * u + 2 * j + 1) * 72 + t] = f2bf(__uint_as_float(kw[j] & 0xffff0000u) * ew); }
#pragma unroll
        for (int p = 0; p < 2; ++p) { const u32x4 vq = *(const u32x4*)(zr + ZC_MV + h * 128 + 64 * p + 8 * u); const unsigned vw[4] = {vq.x, vq.y, vq.z, vq.w};
#pragma unroll
            for (int j = 0; j < 4; ++j) { VT[(64 * p + 8 * u + 2 * j) * 72 + t] = (bf16_t)(vw[j] & 0xffff); VT[(64 * p + 8 * u + 2 * j + 1) * 72 + t] = (bf16_t)(vw[j] >> 16); } }
    }
    __syncthreads();
    bf16_t* BT = (bf16_t*)(F.ws + WS_MLB) + (size_t)item * 128 * 64;
    {
        const int mt = F.wave & 3, q = F.lane >> 4, cl = F.lane & 15;
#pragma unroll
        for (int j = 0; j < 4; ++j) { const int nt = 4 * (F.wave >> 2) + j;
            const f32x4 acc = mma_tile<64>(KwT, 72, VT, 72, 16 * mt, 16 * nt, (f32x4){0.f, 0.f, 0.f, 0.f}, F.lane);
            *(u32x2*)(BT + (size_t)(16 * nt + cl) * 64 + 16 * mt + 4 * q) = pack4(acc); }
    }
    if (F.wave == 0) {
        float s = 0.f;
#pragma unroll
        for (int j = 0; j < 8; ++j) { const bf16x8 v8 = *(const LAS bf16x8*)(KwT + F.lane * 72 + 8 * j);
#pragma unroll
            for (int e = 0; e < 8; ++e) s += bf2f((bf16_t)v8[e]); }
        float* tb = (float*)(F.ws + WS_MLT) + (size_t)item * 66; tb[F.lane] = s; if (F.lane == 0) tb[64] = __expf(bc[63]);
    }
    __syncthreads();
}
__device__ __forceinline__ void ml_scan(Frame& F, int vblk, int nblk) {
    const float* tb = (const float*)(F.ws + WS_MLT);
    if (vblk >= 0) {
        const int bh = vblk >> 1, e0 = (vblk & 1) * 4096 + F.tid * 8;
        bf16_t* base = (bf16_t*)(F.ws + WS_MLB) + (size_t)bh * 128 * 8192 + e0;
        float C[8];
#pragma unroll
        for (int j = 0; j < 8; ++j) C[j] = 0.f;
#pragma unroll 4
        for (int c = 0; c < 128; ++c) {
            u32x4* p = (u32x4*)(base + (size_t)c * 8192); const u32x4 bv = *p; const float gl = tb[(size_t)(bh * 128 + c) * 66 + 64];
            u32x4 o; o.x = pk2(C[0], C[1]); o.y = pk2(C[2], C[3]); o.z = pk2(C[4], C[5]); o.w = pk2(C[6], C[7]); *p = o;
            const unsigned w[4] = {bv.x, bv.y, bv.z, bv.w};
#pragma unroll
            for (int j = 0; j < 4; ++j) { C[2 * j] = gl * C[2 * j] + __uint_as_float(w[j] << 16); C[2 * j + 1] = gl * C[2 * j + 1] + __uint_as_float(w[j] & 0xffff0000u); }
        }
    }
    if (nblk >= 0 && F.tid < 512) {
        const int bh = F.tid >> 6, k = F.tid & 63; float n = 0.f; float* N = (float*)(F.ws + WS_MLN);
        for (int c = 0; c < 128; ++c) { const size_t it = (size_t)(bh * 128 + c); N[it * 64 + k] = n; n = tb[it * 66 + 64] * n + tb[it * 66 + k]; }
    }
}
__device__ __forceinline__ void ml_sc_item(Frame& F, int l, int item) {
    const int bh = item >> 7, c = item & 127, b = bh >> 2, h = bh & 3, row0 = b * SEQ + c * 64;
    LAS float* bc = (LAS float*)F.lds; LAS float* li = bc + 64; LAS float* den = bc + 128; LAS float* nn = bc + 192; LAS float* ssq = bc + 256;
    LAS bf16_t* Qt = (LAS bf16_t*)(F.lds + 2048); LAS bf16_t* Qd = (LAS bf16_t*)(F.lds + 11264); LAS bf16_t* Kt = (LAS bf16_t*)(F.lds + 20480);
    LAS bf16_t* VT = (LAS bf16_t*)(F.lds + 29696); LAS bf16_t* CT = (LAS bf16_t*)(F.lds + 48128); LAS bf16_t* P = (LAS bf16_t*)(F.lds + 66560);
    const bf16_t* Z = (const bf16_t*)(F.ws + WS_Z);
    ml_gates(F, l, h, row0, bc, li);
    if (F.tid < 64) { den[F.tid] = 0.f; nn[F.tid] = ((const float*)(F.ws + WS_MLN))[(size_t)item * 64 + F.tid]; }
    __syncthreads();
    {
        const int t = F.tid & 63, u = F.tid >> 6; const bf16_t* zr = Z + (size_t)(row0 + t) * ZW; const float ed = __expf(bc[t]);
        const u32x4 qq = *(const u32x4*)(zr + ZC_MQ + h * 64 + 8 * u), kq = *(const u32x4*)(zr + ZC_MK + h * 64 + 8 * u);
        *(u32x4*)(Qt + t * 72 + 8 * u) = qq;
        const unsigned qw[4] = {qq.x, qq.y, qq.z, qq.w}, kw[4] = {kq.x, kq.y, kq.z, kq.w}; u32x4 qd, ks; unsigned* qdp = (unsigned*)&qd; unsigned* ksp = (unsigned*)&ks;
#pragma unroll
        for (int j = 0; j < 4; ++j) { qdp[j] = pk2(__uint_as_float(qw[j] << 16) * ed, __uint_as_float(qw[j] & 0xffff0000u) * ed); ksp[j] = pk2(__uint_as_float(kw[j] << 16) * 0.125f, __uint_as_float(kw[j] & 0xffff0000u) * 0.125f); }
        *(u32x4*)(Qd + t * 72 + 8 * u) = qd; *(u32x4*)(Kt + t * 72 + 8 * u) = ks;
#pragma unroll
        for (int p = 0; p < 2; ++p) { const u32x4 vq = *(const u32x4*)(zr + ZC_MV + h * 128 + 64 * p + 8 * u); const unsigned vw[4] = {vq.x, vq.y, vq.z, vq.w};
#pragma unroll
            for (int j = 0; j < 4; ++j) { VT[(64 * p + 8 * u + 2 * j) * 72 + t] = (bf16_t)(vw[j] & 0xffff); VT[(64 * p + 8 * u + 2 * j + 1) * 72 + t] = (bf16_t)(vw[j] >> 16); } }
        const bf16_t* ct = (const bf16_t*)(F.ws + WS_MLB) + (size_t)item * 128 * 64;
#pragma unroll
        for (int p = 0; p < 2; ++p) { const int e = F.tid + 512 * p, rr = e >> 3, cc = (e & 7) * 8; *(u32x4*)(CT + rr * 72 + cc) = *(const u32x4*)(ct + rr * 64 + cc); }
    }
    __syncthreads();
    {
        const int q = F.lane >> 4, cl = F.lane & 15;
#pragma unroll
        for (int j = 0; j < 2; ++j) { const int tile = F.wave * 2 + j, mt = tile & 3, nt = tile >> 2;
            f32x4 acc = mma_tile<64>(Kt, 72, Qt, 72, 16 * mt, 16 * nt, (f32x4){0.f, 0.f, 0.f, 0.f}, F.lane);
            const int t = 16 * nt + cl; const float bt = bc[t]; float part = 0.f;
#pragma unroll
            for (int r = 0; r < 4; ++r) { const int sidx = 16 * mt + 4 * q + r; const float v = (sidx <= t) ? acc[r] * __expf(bt - bc[sidx] + li[sidx]) : 0.f; const float vr = bf2f(f2bf(v)); acc[r] = vr; part += vr; }
            *(u32x2*)(P + t * 72 + 16 * mt + 4 * q) = pack4(acc);
            part += __shfl_xor(part, 16); part += __shfl_xor(part, 32);
            if (q == 0) atomicAdd((float*)(den + t), part);
        }
    }
    __syncthreads();
    if (F.tid < 64) {
        float d = 0.f;
#pragma unroll
        for (int j = 0; j < 8; ++j) { const bf16x8 v8 = *(const LAS bf16x8*)(Qd + F.tid * 72 + 8 * j);
#pragma unroll
            for (int e = 0; e < 8; ++e) d += bf2f((bf16_t)v8[e]) * nn[8 * j + e]; }
        den[F.tid] += d;
    }
    const int nt = F.wave >> 1, q = F.lane >> 4, cl = F.lane & 15, t = 16 * nt + cl;
    f32x4 acc[4];
#pragma unroll
    for (int j = 0; j < 4; ++j) { const int mt = 4 * (F.wave & 1) + j;
        acc[j] = mma_tile<64>(CT, 72, Qd, 72, 16 * mt, 16 * nt, (f32x4){0.f, 0.f, 0.f, 0.f}, F.lane);
        acc[j] = mma_tile<64>(VT, 72, P, 72, 16 * mt, 16 * nt, acc[j], F.lane); }
    __syncthreads();
    {
        const float dinv = 1.f / fmaxf(fabsf(den[t]), 1.f); float sq = 0.f;
#pragma unroll
        for (int j = 0; j < 4; ++j) { acc[j] = acc[j] * dinv; sq += (acc[j][0] * acc[j][0] + acc[j][1] * acc[j][1]) + (acc[j][2] * acc[j][2] + acc[j][3] * acc[j][3]); }
        sq += __shfl_xor(sq, 16); sq += __shfl_xor(sq, 32);
        if (q == 0) ssq[t * 2 + (F.wave & 1)] = sq;
    }
    __syncthreads();
    {
        const float rms = rsqrtf((ssq[t * 2] + ssq[t * 2 + 1]) * (1.f / 128.f) + 1e-6f);
        const float* ng = INP(I_ML_NG) + l * 512 + h * 128; bf16_t* Y = (bf16_t*)(F.ws + WS_Y) + (size_t)(row0 + t) * 1536 + 512 + h * 128; const bf16_t* zo = Z + (size_t)(row0 + t) * ZW + ZC_MO + h * 128;
#pragma unroll
        for (int j = 0; j < 4; ++j) { const int v0 = 16 * (4 * (F.wave & 1) + j) + 4 * q; const f32x4 g4 = *(const f32x4*)(ng + v0); const f32x4 o4 = unpack4(*(const u32x2*)(zo + v0));
            f32x4 y;
#pragma unroll
            for (int r = 0; r < 4; ++r) y[r] = acc[j][r] * rms * g4[r] * sigmoidf_(o4[r]);
            *(u32x2*)(Y + v0) = pack4(y); }
    }
    __syncthreads();
}
__device__ __forceinline__ void phase_ml_sa(Frame& F, int l) { LAUNDER(F); for (int item = F.bid; item < 1024; item += F.G) ml_sa_item(F, l, item); }
__device__ __forceinline__ void phase_ml_sb(Frame& F) { LAUNDER(F); if (F.bid < 16) ml_scan(F, F.bid, -1); else if (F.bid == 16) ml_scan(F, -1, 0); }
__device__ __forceinline__ void phase_ml_sc(Frame& F, int l) { LAUNDER(F); for (int item = F.bid; item < 1024; item += F.G) ml_sc_item(F, l, item); }


constexpr size_t WS_RWM = WS_S0;
constexpr size_t WS_RWS = WS_S0 + 16 * MB;
constexpr size_t WS_RWR = WS_S0 + 32 * MB;
constexpr size_t WS_RWY = WS_S0 + 48 * MB;
constexpr size_t WS_RWG = WS_S0 + 64 * MB;
constexpr size_t WS_RWB = WS_S0 + 64 * MB + 512 * 1024;
__device__ __forceinline__ void tri_inv_inplace(LAS float* N, int ld, int lane) {
    for (int B = 0; B < 4; ++B) {
        float acc[16];
#pragma unroll
        for (int r = 0; r < 16; ++r) acc[r] = (16 * B + r == lane) ? 1.f : 0.f;
        for (int Jc = 0; Jc < B; ++Jc) {
            float tj[16];
#pragma unroll
            for (int e = 0; e < 16; ++e) tj[e] = N[(16 * Jc + e) * ld + lane];
#pragma unroll
            for (int r = 0; r < 16; ++r) {
#pragma unroll
                for (int e4 = 0; e4 < 4; ++e4) { const f32x4 n4 = *(const LAS f32x4*)(N + (16 * B + r) * ld + 16 * Jc + 4 * e4);
                    acc[r] += (n4[0] * tj[4 * e4] + n4[1] * tj[4 * e4 + 1]) + (n4[2] * tj[4 * e4 + 2] + n4[3] * tj[4 * e4 + 3]); } }
        }
        float tb[16];
#pragma unroll
        for (int r = 0; r < 16; ++r) { float a = acc[r];
#pragma unroll
            for (int e = 0; e < r; ++e) a += N[(16 * B + r) * ld + 16 * B + e] * tb[e];
            tb[r] = a; }
        asm volatile("" ::: "memory");
#pragma unroll
        for (int r = 0; r < 16; ++r) N[(16 * B + r) * ld + lane] = tb[r];
        asm volatile("" ::: "memory");
    }
}
__device__ __forceinline__ float zsh(const bf16_t* zr, int t, int col, float mu) { const float cur = bf2f(zr[col]); const float prev = t > 0 ? bf2f(zr[col - ZW]) : 0.f; return cur + mu * (prev - cur); }

__device__ __forceinline__ void rw_sa_item(Frame& F, int l, int item) {
    const int bh = item >> 7, c = item & 127, b = bh >> 3, h = bh & 7, row0 = b * SEQ + c * 64, tq0 = c * 64;
    LAS bf16_t* RAW = (LAS bf16_t*)F.lds; LAS bf16_t* XW = (LAS bf16_t*)(F.lds + 24960); LAS bf16_t* XA = (LAS bf16_t*)(F.lds + 34176); LAS bf16_t* XV = (LAS bf16_t*)(F.lds + 43392);
    LAS float* KKP = (LAS float*)(F.lds + 48640); LAS float* BPP = (LAS float*)(F.lds + 49664); LAS float* HT = (LAS float*)(F.lds + 50688);
    LAS float* AF = (LAS float*)F.lds; LAS bf16_t* LAK = (LAS bf16_t*)(F.lds + 17408); LAS bf16_t* QRB = (LAS bf16_t*)(F.lds + 26624); LAS bf16_t* QRK = (LAS bf16_t*)(F.lds + 35840); LAS bf16_t* TT = (LAS bf16_t*)(F.lds + 45056);
    LAS bf16_t* ALB = (LAS bf16_t*)(F.lds + 54272); LAS bf16_t* BEH = ALB + 4608; LAS bf16_t* KH = BEH + 4608; LAS bf16_t* RB = KH + 4608; LAS bf16_t* ALBT = RB + 4608; LAS bf16_t* VT = ALBT + 4608; LAS bf16_t* BEET = VT + 4608; LAS bf16_t* KET = BEET + 4608;
    LAS bf16_t* XT = ALB; LAS bf16_t* WUT = BEH; LAS bf16_t* U0T = KH;
    const bf16_t* Z = (const bf16_t*)(F.ws + WS_Z);
    const float* mu = INP(I_RW_MU) + l * 1792;
    const bf16_t* lorat = (const bf16_t*)(F.ws + WS_LORAT) + (size_t)l * LORAT_LAYER;
    const int q = F.lane >> 4, cl = F.lane & 15;
    for (int e = F.tid; e < 65 * 24; e += NTHREADS) { const int rr = e / 24, pc = e % 24, g = pc >> 3, cc = (pc & 7) * 8;
        u32x4 v = (u32x4){0u, 0u, 0u, 0u};
        if (rr > 0 || tq0 > 0) v = *(const u32x4*)(Z + (size_t)(row0 + rr - 1) * ZW + (g == 0 ? ZC_RR : (g == 1 ? ZC_RK : ZC_RV)) + h * 64 + cc);
        *(u32x4*)(RAW + rr * 192 + g * 64 + cc) = v; }
    {
        const int t = F.tid & 63, u = F.tid >> 6; const bf16_t* zr = Z + (size_t)(row0 + t) * ZW; const int tt = tq0 + t;
        u32x4 w; unsigned* wp = (unsigned*)&w;
#pragma unroll
        for (int j = 0; j < 4; ++j) wp[j] = pk2(tanhf(zsh(zr, tt, ZC_RW + 8 * u + 2 * j, mu[1536 + 8 * u + 2 * j])), tanhf(zsh(zr, tt, ZC_RW + 8 * u + 2 * j + 1, mu[1536 + 8 * u + 2 * j + 1])));
        *(u32x4*)(XW + t * 72 + 8 * u) = w;
#pragma unroll
        for (int j = 0; j < 4; ++j) wp[j] = pk2(zsh(zr, tt, ZC_RA + 8 * u + 2 * j, mu[1600 + 8 * u + 2 * j]), zsh(zr, tt, ZC_RA + 8 * u + 2 * j + 1, mu[1600 + 8 * u + 2 * j + 1]));
        *(u32x4*)(XA + t * 72 + 8 * u) = w;
        if (l == 1 && u < 4) { const float* muv = INP(I_RW_MUV1);
#pragma unroll
            for (int j = 0; j < 4; ++j) wp[j] = pk2(zsh(zr, tt, ZC_XV + 8 * u + 2 * j, muv[8 * u + 2 * j]), zsh(zr, tt, ZC_XV + 8 * u + 2 * j + 1, muv[8 * u + 2 * j + 1]));
            *(u32x4*)(XV + t * 40 + 8 * u) = w; }
    }
    __syncthreads();
    const int nt = F.wave & 3, th = F.wave >> 2, ch = 16 * nt + cl, gch = h * 64 + ch;
    float lwv[2][4], av[2][4], kv[2][4], vv[2][4], rv[2][4], kpv[2][4], kkv[2][4];
    {
        const float w0 = INP(I_RW_W0)[l * 512 + gch], a0 = INP(I_RW_A0)[l * 512 + gch], k_k = INP(I_RW_KK)[l * 512 + gch], k_a = INP(I_RW_KA)[l * 512 + gch], r_k = INP(I_RW_RK)[l * 512 + gch];
        const float mur = mu[gch], muk = mu[512 + gch], muv_ = mu[1024 + gch];
        const float v0 = (l == 1) ? INP(I_RW_V0)[gch] : 0.f;
        bf16_t* VFp = (bf16_t*)(F.ws + WS_VF);
        float kk2[2][4], bp[2][4];
#pragma unroll
        for (int j = 0; j < 2; ++j) { const int mt = 2 * th + j;
            const f32x4 LW = mma_tile<64>(XW, 72, lorat + (size_t)(h * 64) * 64, 64, 16 * mt, 16 * nt, (f32x4){0.f, 0.f, 0.f, 0.f}, F.lane);
            const f32x4 LA = mma_tile<64>(XA, 72, lorat + 512 * 64 + (size_t)(h * 64) * 64, 64, 16 * mt, 16 * nt, (f32x4){0.f, 0.f, 0.f, 0.f}, F.lane);
            f32x4 LV = (f32x4){0.f, 0.f, 0.f, 0.f};
            if (l == 1) LV = mma_tile<32>(XV, 40, lorat + 2 * 512 * 64 + 512 * 128 + (size_t)(h * 64) * 32, 32, 16 * mt, 16 * nt, LV, F.lane);
#pragma unroll
            for (int r = 0; r < 4; ++r) { const int t = 16 * mt + 4 * q + r;
                const float rc = bf2f(RAW[(t + 1) * 192 + ch]), rp = bf2f(RAW[t * 192 + ch]), kc = bf2f(RAW[(t + 1) * 192 + 64 + ch]), kp_ = bf2f(RAW[t * 192 + 64 + ch]), vc = bf2f(RAW[(t + 1) * 192 + 128 + ch]), vp = bf2f(RAW[t * 192 + 128 + ch]);
                const float rr = rc + mur * (rp - rc), kk_ = kc + muk * (kp_ - kc); float vx = vc + muv_ * (vp - vc);
                lwv[j][r] = -__expf(-softplusf_(-(w0 + LW[r])) - 0.5f);
                const float a = sigmoidf_(a0 + LA[r]);
                if (l == 1) { const float vf = bf2f(VFp[(size_t)(row0 + t) * 512 + gch]); vx = vx + (vf - vx) * sigmoidf_(v0 + LV[r]); }
                VFp[(size_t)(row0 + t) * 512 + gch] = f2bf(vx);
                const float kkr = kk_ * k_k, kp = kk_ * (1.f + (a - 1.f) * k_a);
                av[j][r] = a; kv[j][r] = kk_; vv[j][r] = vx; rv[j][r] = rr; kpv[j][r] = kp; kkv[j][r] = kkr; kk2[j][r] = kkr * kkr; bp[j][r] = rr * kp * r_k; }
        }
#pragma unroll
        for (int j = 0; j < 2; ++j)
#pragma unroll
            for (int r = 0; r < 4; ++r) { float x = kk2[j][r], y = bp[j][r];
#pragma unroll
                for (int o = 1; o < 16; o <<= 1) { x += __shfl_xor(x, o); y += __shfl_xor(y, o); }
                if (cl == 0) { const int t = 16 * (2 * th + j) + 4 * q + r; KKP[t * 4 + nt] = x; BPP[t * 4 + nt] = y; } }
    }
    float cum[2][4]; float halftot;
    {
        float base = 0.f;
#pragma unroll
        for (int j = 0; j < 2; ++j) {
            float p0 = lwv[j][0], p1 = p0 + lwv[j][1], p2 = p1 + lwv[j][2], p3 = p2 + lwv[j][3];
            const float s1 = __shfl_up(p3, 16), s2 = __shfl_up(p3, 32), s3 = __shfl_up(p3, 48);
            const float excl = (q >= 1 ? s1 : 0.f) + (q >= 2 ? s2 : 0.f) + (q >= 3 ? s3 : 0.f);
            float tot = p3; tot += __shfl_xor(tot, 16); tot += __shfl_xor(tot, 32);
            cum[j][0] = base + excl + p0; cum[j][1] = base + excl + p1; cum[j][2] = base + excl + p2; cum[j][3] = base + excl + p3;
            base += tot; }
        halftot = base;
        if (q == 0) HT[th * 64 + ch] = halftot;
    }
    __syncthreads();
    {
        const float lwl = HT[ch] + HT[64 + ch]; const float hb = th ? HT[ch] : 0.f;
        if (th == 0 && q == 0) ((float*)(F.ws + WS_RWG))[(size_t)item * 64 + ch] = __expf(lwl);
#pragma unroll
        for (int j = 0; j < 2; ++j) { const int mt = 2 * th + j; f32x4 albT, vT, beeT, keT;
#pragma unroll
            for (int r = 0; r < 4; ++r) { const int t = 16 * mt + 4 * q + r;
                const float nrm = rsqrtf((KKP[t * 4] + KKP[t * 4 + 1]) + (KKP[t * 4 + 2] + KKP[t * 4 + 3]) + 1e-6f);
                const float kk = kkv[j][r] * nrm, lwi = cum[j][r] + hb, lwe = lwi - lwv[j][r], be = kk * av[j][r];
                const float ei = __expf(lwi), en = __expf(-lwi), ee = __expf(lwl - lwi);
                const float alb = -kk * __expf(lwe);
                ALB[t * 72 + ch] = f2bf(alb); BEH[t * 72 + ch] = f2bf(be * en); KH[t * 72 + ch] = f2bf(kpv[j][r] * en); RB[t * 72 + ch] = f2bf(rv[j][r] * ei);
                albT[r] = alb; vT[r] = vv[j][r]; beeT[r] = be * ee; keT[r] = kpv[j][r] * ee; }
            const int t0 = 16 * mt + 4 * q;
            *(u32x2*)(ALBT + ch * 72 + t0) = pack4(albT); *(u32x2*)(VT + ch * 72 + t0) = pack4(vT); *(u32x2*)(BEET + ch * 72 + t0) = pack4(beeT); *(u32x2*)(KET + ch * 72 + t0) = pack4(keT); }
        if (F.tid < 64) ((float*)(F.ws + WS_RWB))[(size_t)(row0 + F.tid) * 8 + h] = (BPP[F.tid * 4] + BPP[F.tid * 4 + 1]) + (BPP[F.tid * 4 + 2] + BPP[F.tid * 4 + 3]);
    }
    __syncthreads();
#pragma unroll
    for (int k2 = 0; k2 < 2; ++k2) { const int tile = F.wave * 2 + k2, mt = tile & 3, n2 = tile >> 2;
        const int i = 16 * n2 + cl, j0 = 16 * mt + 4 * q;
        f32x4 lab = mma_tile<64>(BEH, 72, ALB, 72, 16 * mt, 16 * n2, (f32x4){0.f, 0.f, 0.f, 0.f}, F.lane);
        f32x4 lak = mma_tile<64>(KH, 72, ALB, 72, 16 * mt, 16 * n2, (f32x4){0.f, 0.f, 0.f, 0.f}, F.lane);
        f32x4 qrb = mma_tile<64>(BEH, 72, RB, 72, 16 * mt, 16 * n2, (f32x4){0.f, 0.f, 0.f, 0.f}, F.lane);
        f32x4 qrk = mma_tile<64>(KH, 72, RB, 72, 16 * mt, 16 * n2, (f32x4){0.f, 0.f, 0.f, 0.f}, F.lane);
#pragma unroll
        for (int r = 0; r < 4; ++r) { const int j = j0 + r; if (!(i > j)) { lab[r] = 0.f; lak[r] = 0.f; } if (!(i >= j)) { qrb[r] = 0.f; qrk[r] = 0.f; } }
        *(f32x4*)(AF + i * 68 + j0) = lab; *(u32x2*)(LAK + i * 72 + j0) = pack4(lak); *(u32x2*)(QRB + i * 72 + j0) = pack4(qrb); *(u32x2*)(QRK + i * 72 + j0) = pack4(qrk); }
    __syncthreads();
    if (F.wave == 0) tri_inv_inplace(AF, 68, F.lane);
    else for (int tile = F.wave - 1; tile < 16; tile += 7) { const int mt = tile & 3, n2 = tile >> 2;
        const f32x4 x = mma_tile<64>(LAK, 72, VT, 72, 16 * mt, 16 * n2, (f32x4){0.f, 0.f, 0.f, 0.f}, F.lane);
        *(u32x2*)(XT + (16 * n2 + cl) * 72 + 16 * mt + 4 * q) = pack4(x); }
    __syncthreads();
    {
        const int i = F.tid >> 3, j0 = (F.tid & 7) * 8; const f32x4 a = *(const LAS f32x4*)(AF + i * 68 + j0), bq = *(const LAS f32x4*)(AF + i * 68 + j0 + 4);
        u32x4 w; w.x = pk2(a[0], a[1]); w.y = pk2(a[2], a[3]); w.z = pk2(bq[0], bq[1]); w.w = pk2(bq[2], bq[3]); *(u32x4*)(TT + i * 72 + j0) = w;
    }
    __syncthreads();
#pragma unroll
    for (int k2 = 0; k2 < 2; ++k2) { const int tile = F.wave * 2 + k2, mt = tile & 3, n2 = tile >> 2;
        const f32x4 wu = mma_tile<64>(TT, 72, ALBT, 72, 16 * mt, 16 * n2, (f32x4){0.f, 0.f, 0.f, 0.f}, F.lane);
        const f32x4 u0 = mma_tile<64>(TT, 72, XT, 72, 16 * mt, 16 * n2, (f32x4){0.f, 0.f, 0.f, 0.f}, F.lane);
        *(u32x2*)(WUT + (16 * n2 + cl) * 72 + 16 * mt + 4 * q) = pack4(wu); *(u32x2*)(U0T + (16 * n2 + cl) * 72 + 16 * mt + 4 * q) = pack4(u0); }
    __syncthreads();
    bf16_t* gM = (bf16_t*)(F.ws + WS_RWM) + (size_t)item * 4096; bf16_t* gS = (bf16_t*)(F.ws + WS_RWS) + (size_t)item * 4096; bf16_t* gR = (bf16_t*)(F.ws + WS_RWR) + (size_t)item * 4096; bf16_t* gY = (bf16_t*)(F.ws + WS_RWY) + (size_t)item * 4096;
#pragma unroll
    for (int k2 = 0; k2 < 2; ++k2) { const int tile = F.wave * 2 + k2, mt = tile & 3, n2 = tile >> 2; const int col = 16 * n2 + cl, r0 = 16 * mt + 4 * q;
        f32x4 x = mma_tile<64>(WUT, 72, QRB, 72, 16 * mt, 16 * n2, (f32x4){0.f, 0.f, 0.f, 0.f}, F.lane);
        x = x + unpack4(*(const LAS u32x2*)(RB + col * 72 + r0));
        *(u32x2*)(gR + col * 64 + r0) = pack4(x);
        x = mma_tile<64>(U0T, 72, QRB, 72, 16 * mt, 16 * n2, (f32x4){0.f, 0.f, 0.f, 0.f}, F.lane);
        x = mma_tile<64>(VT, 72, QRK, 72, 16 * mt, 16 * n2, x, F.lane);
        *(u32x2*)(gY + col * 64 + r0) = pack4(x);
        x = mma_tile<64>(WUT, 72, BEET, 72, 16 * mt, 16 * n2, (f32x4){0.f, 0.f, 0.f, 0.f}, F.lane);
        *(u32x2*)(gM + col * 64 + 32 * (mt >> 1) + 8 * q + 4 * (mt & 1)) = pack4(x);
        x = mma_tile<64>(BEET, 72, U0T, 72, 16 * mt, 16 * n2, (f32x4){0.f, 0.f, 0.f, 0.f}, F.lane);
        x = mma_tile<64>(KET, 72, VT, 72, 16 * mt, 16 * n2, x, F.lane);
        *(u32x2*)(gS + col * 64 + r0) = pack4(x); }
    __syncthreads();
}
__device__ __forceinline__ void rw_scan_wave(Frame& F, int bh, int sl) {
    const int q = F.lane >> 4, cl = F.lane & 15, v = 16 * sl + cl;
    const bf16_t* gM = (const bf16_t*)(F.ws + WS_RWM) + (size_t)bh * 128 * 4096; bf16_t* gS = (bf16_t*)(F.ws + WS_RWS) + (size_t)bh * 128 * 4096; const float* gG = (const float*)(F.ws + WS_RWG) + (size_t)bh * 128 * 64;
    f32x4 S[4];
#pragma unroll
    for (int m = 0; m < 4; ++m) S[m] = (f32x4){0.f, 0.f, 0.f, 0.f};
    bf16x8 A[4][2]; u32x2 Bs[4]; f32x4 G[4];
#define RW_LOAD(c_) do { const bf16_t* m_ = gM + (size_t)(c_) * 4096; const bf16_t* s_ = gS + (size_t)(c_) * 4096; const float* g_ = gG + (size_t)(c_) * 64; \
        _Pragma("unroll") for (int m = 0; m < 4; ++m) { A[m][0] = *(const bf16x8*)(m_ + (16 * m + cl) * 64 + 8 * q); A[m][1] = *(const bf16x8*)(m_ + (16 * m + cl) * 64 + 32 + 8 * q); \
            Bs[m] = *(const u32x2*)(s_ + v * 64 + 16 * m + 4 * q); G[m] = *(const f32x4*)(g_ + 16 * m + 4 * q); } } while (0)
    RW_LOAD(0);
    for (int c = 0; c < 128; ++c) {
        bf16x8 cA[4][2]; u32x2 cB[4]; f32x4 cG[4];
#pragma unroll
        for (int m = 0; m < 4; ++m) { cA[m][0] = A[m][0]; cA[m][1] = A[m][1]; cB[m] = Bs[m]; cG[m] = G[m]; }
        if (c + 1 < 128) RW_LOAD(c + 1);
        bf16x8 Bop[2];
#pragma unroll
        for (int ks = 0; ks < 2; ++ks) { u32x4 w; w.x = pk2(S[2 * ks][0], S[2 * ks][1]); w.y = pk2(S[2 * ks][2], S[2 * ks][3]); w.z = pk2(S[2 * ks + 1][0], S[2 * ks + 1][1]); w.w = pk2(S[2 * ks + 1][2], S[2 * ks + 1][3]); Bop[ks] = *(bf16x8*)&w; }
        bf16_t* so = gS + (size_t)c * 4096 + v * 64 + 4 * q;
#pragma unroll
        for (int m = 0; m < 4; ++m) { u32x2 w; w.x = ((const unsigned*)&Bop[m >> 1])[2 * (m & 1)]; w.y = ((const unsigned*)&Bop[m >> 1])[2 * (m & 1) + 1]; *(u32x2*)(so + 16 * m) = w; }
#pragma unroll
        for (int m = 0; m < 4; ++m) { f32x4 acc = cG[m] * S[m] + unpack4(cB[m]);
            acc = __builtin_amdgcn_mfma_f32_16x16x32_bf16(cA[m][0], Bop[0], acc, 0, 0, 0); acc = __builtin_amdgcn_mfma_f32_16x16x32_bf16(cA[m][1], Bop[1], acc, 0, 0, 0); S[m] = acc; }
    }
#undef RW_LOAD
}
__device__ __forceinline__ void rw_sc_item(Frame& F, int l, int item) {
    const int bh = item >> 7, c = item & 127, b = bh >> 3, h = bh & 7, row0 = b * SEQ + c * 64, tq0 = c * 64;
    LAS bf16_t* ST = (LAS bf16_t*)F.lds; LAS bf16_t* RP = (LAS bf16_t*)(F.lds + 9216); LAS bf16_t* XG = (LAS bf16_t*)(F.lds + 18432); LAS float* red = (LAS float*)(F.lds + 18432 + 17408);
    const bf16_t* Z = (const bf16_t*)(F.ws + WS_Z); const float* mu = INP(I_RW_MU) + l * 1792;
    const bf16_t* g2t = (const bf16_t*)(F.ws + WS_LORAT) + (size_t)l * LORAT_LAYER + 2 * 512 * 64 + (size_t)(h * 64) * 128;
    const bf16_t* gS = (const bf16_t*)(F.ws + WS_RWS) + (size_t)item * 4096; const bf16_t* gR = (const bf16_t*)(F.ws + WS_RWR) + (size_t)item * 4096; const bf16_t* gY = (const bf16_t*)(F.ws + WS_RWY) + (size_t)item * 4096;
    { const int rr = F.tid >> 3, cc = (F.tid & 7) * 8; *(u32x4*)(ST + rr * 72 + cc) = *(const u32x4*)(gS + rr * 64 + cc); *(u32x4*)(RP + rr * 72 + cc) = *(const u32x4*)(gR + rr * 64 + cc);
      const int t = F.tid & 63, u = F.tid >> 6; const bf16_t* zr = Z + (size_t)(row0 + t) * ZW; const int tt = tq0 + t;
#pragma unroll
      for (int p = 0; p < 2; ++p) { u32x4 w; unsigned* wp = (unsigned*)&w;
#pragma unroll
          for (int j = 0; j < 4; ++j) { const int cg = 16 * u + 8 * p + 2 * j; wp[j] = pk2(sigmoidf_(zsh(zr, tt, ZC_RG + cg, mu[1664 + cg])), sigmoidf_(zsh(zr, tt, ZC_RG + cg + 1, mu[1664 + cg + 1]))); }
          *(u32x4*)(XG + t * 136 + 16 * u + 8 * p) = w; } }
    __syncthreads();
    const int n2 = F.wave >> 1, vh = F.wave & 1, q = F.lane >> 4, cl = F.lane & 15, i = 16 * n2 + cl;
    f32x4 y[2], g[2];
#pragma unroll
    for (int j = 0; j < 2; ++j) { const int mt = 2 * vh + j;
        y[j] = mma_tile<64>(ST, 72, RP, 72, 16 * mt, 16 * n2, unpack4(*(const u32x2*)(gY + i * 64 + 16 * mt + 4 * q)), F.lane);
        g[j] = mma_tile<128>(g2t, 128, XG, 136, 16 * mt, 16 * n2, (f32x4){0.f, 0.f, 0.f, 0.f}, F.lane); }
    float s = (y[0][0] + y[0][1]) + (y[0][2] + y[0][3]) + (y[1][0] + y[1][1]) + (y[1][2] + y[1][3]);
    s += __shfl_xor(s, 16); s += __shfl_xor(s, 32);
    if (q == 0) red[i * 2 + vh] = s;
    __syncthreads();
    const float mean = (red[i * 2] + red[i * 2 + 1]) * (1.f / 64.f);
    float s2 = 0.f;
#pragma unroll
    for (int j = 0; j < 2; ++j)
#pragma unroll
        for (int r = 0; r < 4; ++r) { y[j][r] -= mean; s2 += y[j][r] * y[j][r]; }
    s2 += __shfl_xor(s2, 16); s2 += __shfl_xor(s2, 32);
    __syncthreads();
    if (q == 0) red[i * 2 + vh] = s2;
    __syncthreads();
    const float rstd = rsqrtf((red[i * 2] + red[i * 2 + 1]) * (1.f / 64.f) + 64e-5f);
    const float bonus = ((const float*)(F.ws + WS_RWB))[(size_t)(row0 + i) * 8 + h];
    const bf16_t* VFp = (const bf16_t*)(F.ws + WS_VF) + (size_t)(row0 + i) * 512 + h * 64; bf16_t* Y = (bf16_t*)(F.ws + WS_Y) + (size_t)(row0 + i) * 1536 + 1024 + h * 64;
#pragma unroll
    for (int j = 0; j < 2; ++j) { const int v0 = 16 * (2 * vh + j) + 4 * q; const f32x4 lg = *(const f32x4*)(INP(I_RW_LNG) + l * 512 + h * 64 + v0), lb = *(const f32x4*)(INP(I_RW_LNB) + l * 512 + h * 64 + v0); const f32x4 vv = unpack4(*(const u32x2*)(VFp + v0));
        f32x4 o;
#pragma unroll
        for (int r = 0; r < 4; ++r) o[r] = (y[j][r] * rstd * lg[r] + lb[r] + bonus * vv[r]) * g[j][r];
        *(u32x2*)(Y + v0) = pack4(o); }
    __syncthreads();
}
__device__ __forceinline__ void phase_rw_sa(Frame& F, int l) { LAUNDER(F); for (int item = F.bid; item < 2048; item += F.G) rw_sa_item(F, l, item); }
__device__ __forceinline__ void phase_rw_sb(Frame& F) { LAUNDER(F); if (F.bid >= 32 && F.bid < 96 && F.wave == 0) rw_scan_wave(F, (F.bid - 32) >> 2, (F.bid - 32) & 3); }
__device__ __forceinline__ void phase_rw_sc(Frame& F, int l) { LAUNDER(F); for (int item = F.bid; item < 2048; item += F.G) rw_sc_item(F, l, item); }


constexpr size_t WS_GDM = WS_H;
constexpr size_t WS_GDS = WS_S + 65 * MB;
constexpr size_t WS_GDR = WS_VF + 16 * MB;
constexpr size_t WS_GDG = WS_LORAT + 640 * 1024;
__device__ __forceinline__ size_t ws_gdo(int l) { return WS_WIN + (size_t)l * ZW * 1024 * 2; }
typedef float f32x16 __attribute__((ext_vector_type(16)));

__device__ __forceinline__ void gdn_sa_item(Frame& F, int l, int item) {
    const int bh = item >> 7, c = item & 127, b = bh >> 2, h = bh & 3, row0 = b * SEQ + c * 64, tq0 = c * 64;
    LAS bf16_t* Qt = (LAS bf16_t*)F.lds; LAS bf16_t* KdT = (LAS bf16_t*)(F.lds + 17408); LAS bf16_t* QKM = (LAS bf16_t*)(F.lds + 35840); LAS bf16_t* KgT = (LAS bf16_t*)(F.lds + 45056); LAS bf16_t* VT = (LAS bf16_t*)(F.lds + 63488);
    LAS bf16_t* TPP = (LAS bf16_t*)(F.lds + 81920); LAS bf16_t* Kt = (LAS bf16_t*)(F.lds + 91136); LAS float* AF = (LAS float*)(F.lds + 108544); LAS bf16_t* WT = (LAS bf16_t*)(F.lds + 91136); LAS bf16_t* UT = (LAS bf16_t*)(F.lds + 109568);
    LAS float* G = (LAS float*)(F.lds + 128000); LAS float* BETA = (LAS float*)(F.lds + 128256); LAS float* SSQ = (LAS float*)(F.lds + 81920);
    const bf16_t* Z = (const bf16_t*)(F.ws + WS_Z);
    const int q = F.lane >> 4, cl = F.lane & 15;
    const int t = F.lane, p = F.wave, tt = tq0 + t;
    float g_t, beta_t, gl;
    {
        const bf16_t* zr = Z + (size_t)(row0 + t) * ZW;
        const float a = bf2f(zr[ZC_GA + h]), bb = bf2f(zr[ZC_GB + h]);
        const float graw = -__expf(INP(I_GDN_ALOG)[l * 4 + h]) * softplusf_(a + INP(I_GDN_DTB)[l * 4 + h]);
        g_t = wave_incl_scan(graw, t); beta_t = sigmoidf_(bb); gl = __shfl(g_t, 63);
        if (p == 0) { G[t] = g_t; BETA[t] = beta_t; if (t == 0) ((float*)(F.ws + WS_GDG))[item] = __expf(gl); }
    }
    float xq[16], xk[16], xv[16];
    {
        const float* cw = INP(I_GDN_CONV) + (size_t)l * 4 * 1536 + h * 128 + 16 * p;
#pragma unroll
        for (int g = 0; g < 3; ++g) {
            float acc[16];
#pragma unroll
            for (int e = 0; e < 16; ++e) acc[e] = 0.f;
#pragma unroll
            for (int j = 0; j < 4; ++j) {
                if (tt - 3 + j >= 0) { const bf16_t* zp = Z + (size_t)(row0 + t - 3 + j) * ZW + (g == 0 ? ZC_GQ : (g == 1 ? ZC_GK : ZC_GV)) + h * 128 + 16 * p;
                    const u32x4 lo = *(const u32x4*)zp, hi = *(const u32x4*)(zp + 8); const unsigned w[8] = {lo.x, lo.y, lo.z, lo.w, hi.x, hi.y, hi.z, hi.w};
#pragma unroll
                    for (int e = 0; e < 8; ++e) { acc[2 * e] += cw[j * 1536 + g * 512 + 2 * e] * __uint_as_float(w[e] << 16); acc[2 * e + 1] += cw[j * 1536 + g * 512 + 2 * e + 1] * __uint_as_float(w[e] & 0xffff0000u); } } }
#pragma unroll
            for (int e = 0; e < 16; ++e) { const float y = siluf_(acc[e]); if (g == 0) xq[e] = y; else if (g == 1) xk[e] = y; else xv[e] = y; }
        }
        float sq = 0.f, sk = 0.f;
#pragma unroll
        for (int e = 0; e < 16; ++e) { sq += xq[e] * xq[e]; sk += xk[e] * xk[e]; }
        SSQ[t * 8 + p] = sq; SSQ[512 + t * 8 + p] = sk;
    }
    __syncthreads();
    {
        float sq = 0.f, sk = 0.f;
#pragma unroll
        for (int e = 0; e < 8; ++e) { sq += SSQ[t * 8 + e]; sk += SSQ[512 + t * 8 + e]; }
        const float rq = rsqrtf(sq + 1e-6f) * 0.08838834764831845f, rk = rsqrtf(sk + 1e-6f);
        const float eg = __expf(g_t), ed = __expf(gl - g_t);
        u32x4 w0, w1; unsigned* p0 = (unsigned*)&w0; unsigned* p1 = (unsigned*)&w1;
#pragma unroll
        for (int e = 0; e < 4; ++e) { p0[e] = pk2(xq[2 * e] * rq, xq[2 * e + 1] * rq); p1[e] = pk2(xq[8 + 2 * e] * rq, xq[8 + 2 * e + 1] * rq); }
        *(u32x4*)(Qt + t * 136 + 16 * p) = w0; *(u32x4*)(Qt + t * 136 + 16 * p + 8) = w1;
#pragma unroll
        for (int e = 0; e < 4; ++e) { p0[e] = pk2(xk[2 * e] * rk, xk[2 * e + 1] * rk); p1[e] = pk2(xk[8 + 2 * e] * rk, xk[8 + 2 * e + 1] * rk); }
        *(u32x4*)(Kt + t * 136 + 16 * p) = w0; *(u32x4*)(Kt + t * 136 + 16 * p + 8) = w1;
#pragma unroll
        for (int e = 0; e < 16; ++e) { const float kn = xk[e] * rk; KgT[(16 * p + e) * 72 + t] = f2bf(kn * eg); KdT[(16 * p + e) * 72 + t] = f2bf(kn * ed); VT[(16 * p + e) * 72 + t] = f2bf(xv[e]); }
    }
    __syncthreads();
#pragma unroll
    for (int k2 = 0; k2 < 2; ++k2) { const int tile = F.wave * 2 + k2, mt = tile & 3, n2 = tile >> 2; const int i = 16 * n2 + cl, j0 = 16 * mt + 4 * q;
        f32x4 kk = mma_tile<128>(Kt, 136, Kt, 136, 16 * mt, 16 * n2, (f32x4){0.f, 0.f, 0.f, 0.f}, F.lane);
        f32x4 qk = mma_tile<128>(Kt, 136, Qt, 136, 16 * mt, 16 * n2, (f32x4){0.f, 0.f, 0.f, 0.f}, F.lane);
        const float gi = G[i], bi = BETA[i];
#pragma unroll
        for (int r = 0; r < 4; ++r) { const int j = j0 + r; const float d = __expf(gi - G[j]); kk[r] = (i > j) ? -bi * kk[r] * d : 0.f; qk[r] = (i >= j) ? qk[r] * d : 0.f; }
        *(f32x4*)(AF + i * 68 + j0) = kk; *(u32x2*)(QKM + i * 72 + j0) = pack4(qk); }
    __syncthreads();
    if (F.wave == 0) tri_inv_inplace(AF, 68, F.lane);
    __syncthreads();
    {
        const int i = F.tid >> 3, j0 = (F.tid & 7) * 8; const f32x4 a = *(const LAS f32x4*)(AF + i * 68 + j0), bq = *(const LAS f32x4*)(AF + i * 68 + j0 + 4);
        u32x4 w; w.x = pk2(a[0] * BETA[j0], a[1] * BETA[j0 + 1]); w.y = pk2(a[2] * BETA[j0 + 2], a[3] * BETA[j0 + 3]); w.z = pk2(bq[0] * BETA[j0 + 4], bq[1] * BETA[j0 + 5]); w.w = pk2(bq[2] * BETA[j0 + 6], bq[3] * BETA[j0 + 7]);
        *(u32x4*)(TPP + i * 72 + j0) = w;
    }
    __syncthreads();
    {
        f32x4 wv[4], uv[4];
#pragma unroll
        for (int mt = 0; mt < 4; ++mt) { wv[mt] = mma_tile<64>(TPP, 72, KgT, 72, 16 * mt, 16 * F.wave, (f32x4){0.f, 0.f, 0.f, 0.f}, F.lane); uv[mt] = mma_tile<64>(TPP, 72, VT, 72, 16 * mt, 16 * F.wave, (f32x4){0.f, 0.f, 0.f, 0.f}, F.lane); }
#pragma unroll
        for (int mt = 0; mt < 4; ++mt) { *(u32x2*)(WT + (16 * F.wave + cl) * 72 + 16 * mt + 4 * q) = pack4(wv[mt]); *(u32x2*)(UT + (16 * F.wave + cl) * 72 + 16 * mt + 4 * q) = pack4(uv[mt]); }
    }
    __syncthreads();
    bf16_t* gM = (bf16_t*)(F.ws + WS_GDM) + (size_t)item * 16384; bf16_t* gS = (bf16_t*)(F.ws + WS_GDS) + (size_t)item * 16384; bf16_t* gR = (bf16_t*)(F.ws + WS_GDR) + (size_t)item * 8192; bf16_t* gO = (bf16_t*)(F.ws + ws_gdo(l)) + (size_t)item * 8192;
#pragma unroll
    for (int mt = 0; mt < 8; ++mt) { const int n2 = F.wave, col = 16 * n2 + cl;
        f32x4 x = mma_tile<64>(WT, 72, KdT, 72, 16 * mt, 16 * n2, (f32x4){0.f, 0.f, 0.f, 0.f}, F.lane);
        *(u32x2*)(gM + col * 128 + 16 * mt + 8 * (q & 1) + 4 * (q >> 1)) = pack4(-x);
        x = mma_tile<64>(KdT, 72, UT, 72, 16 * mt, 16 * n2, (f32x4){0.f, 0.f, 0.f, 0.f}, F.lane);
        *(u32x2*)(gS + col * 128 + 16 * mt + 4 * q) = pack4(x); }
#pragma unroll
    for (int k2 = 0; k2 < 4; ++k2) { const int tile = F.wave * 4 + k2, mt = tile & 7, n2 = tile >> 3; const int i = 16 * n2 + cl, r0 = 16 * mt + 4 * q;
        f32x4 x = mma_tile<64>(WT, 72, QKM, 72, 16 * mt, 16 * n2, (f32x4){0.f, 0.f, 0.f, 0.f}, F.lane);
        x = unpack4(*(const LAS u32x2*)(Qt + i * 136 + r0)) * __expf(G[i]) - x;
        *(u32x2*)(gR + i * 128 + r0) = pack4(x);
        x = mma_tile<64>(UT, 72, QKM, 72, 16 * mt, 16 * n2, (f32x4){0.f, 0.f, 0.f, 0.f}, F.lane);
        *(u32x2*)(gO + i * 128 + r0) = pack4(x); }
    __syncthreads();
}
__device__ __forceinline__ void gdn_scan_block(Frame& F, int bh) {
    const bf16_t* gM = (const bf16_t*)(F.ws + WS_GDM) + (size_t)bh * 128 * 16384; bf16_t* gS = (bf16_t*)(F.ws + WS_GDS) + (size_t)bh * 128 * 16384; const float* gG = (const float*)(F.ws + WS_GDG) + bh * 128;
    LAS bf16_t* MB0 = (LAS bf16_t*)F.lds; LAS bf16_t* MB1 = (LAS bf16_t*)(F.lds + 34816);
    const int col = F.lane & 31, h2 = F.lane >> 5, v = 32 * F.wave + col;
    f32x16 S[4];
#pragma unroll
    for (int m = 0; m < 4; ++m)
#pragma unroll
        for (int r = 0; r < 16; ++r) S[m][r] = 0.f;
    u32x4 st[4];
#pragma unroll
    for (int k = 0; k < 4; ++k) { const int e = F.tid + 512 * k; st[k] = *(const u32x4*)(gM + (e >> 4) * 128 + (e & 15) * 8); }
#pragma unroll
    for (int k = 0; k < 4; ++k) { const int e = F.tid + 512 * k; *(u32x4*)(MB0 + (e >> 4) * 136 + (e & 15) * 8) = st[k]; }
    __syncthreads();
    for (int c = 0; c < 128; ++c) {
        LAS bf16_t* MB = (c & 1) ? MB1 : MB0; LAS bf16_t* MBn = (c & 1) ? MB0 : MB1;
        if (c + 1 < 128) {
#pragma unroll
            for (int k = 0; k < 4; ++k) { const int e = F.tid + 512 * k; st[k] = *(const u32x4*)(gM + (size_t)(c + 1) * 16384 + (e >> 4) * 128 + (e & 15) * 8); } }
        if (F.wave < 4) {
            const float gl = gG[c];
            bf16_t* sp = gS + (size_t)c * 16384 + (size_t)v * 128;
            bf16x8 Bop[4][2]; f32x16 Sn[4];
#pragma unroll
            for (int T = 0; T < 4; ++T) {
#pragma unroll
                for (int sI = 0; sI < 2; ++sI) { u32x4 w; w.x = pk2(S[T][8 * sI], S[T][8 * sI + 1]); w.y = pk2(S[T][8 * sI + 2], S[T][8 * sI + 3]); w.z = pk2(S[T][8 * sI + 4], S[T][8 * sI + 5]); w.w = pk2(S[T][8 * sI + 6], S[T][8 * sI + 7]); Bop[T][sI] = *(bf16x8*)&w; }
#pragma unroll
                for (int g = 0; g < 4; ++g) { u32x2* ad = (u32x2*)(sp + 32 * T + 8 * g + 4 * h2); const f32x4 bv = unpack4(*ad);
                    u32x2 o; o.x = ((const unsigned*)&Bop[T][g >> 1])[2 * (g & 1)]; o.y = ((const unsigned*)&Bop[T][g >> 1])[2 * (g & 1) + 1]; *ad = o;
#pragma unroll
                    for (int r = 0; r < 4; ++r) Sn[T][4 * g + r] = gl * S[T][4 * g + r] + bv[r]; } }
#pragma unroll
            for (int mt = 0; mt < 4; ++mt) {
#pragma unroll
                for (int ks = 0; ks < 8; ++ks) { const bf16x8 a = *(const LAS bf16x8*)(MB + (32 * mt + col) * 136 + 16 * ks + 8 * h2);
                    Sn[mt] = __builtin_amdgcn_mfma_f32_32x32x16_bf16(a, Bop[ks >> 1][ks & 1], Sn[mt], 0, 0, 0); } }
#pragma unroll
            for (int m = 0; m < 4; ++m) S[m] = Sn[m];
        }
        if (c + 1 < 128) {
#pragma unroll
            for (int k = 0; k < 4; ++k) { const int e = F.tid + 512 * k; *(u32x4*)(MBn + (e >> 4) * 136 + (e & 15) * 8) = st[k]; } }
        __syncthreads();
    }
}
__device__ __forceinline__ void gdn_sc_item(Frame& F, int l, int item) {
    const int bh = item >> 7, c = item & 127, b = bh >> 2, h = bh & 3, row0 = b * SEQ + c * 64;
    LAS bf16_t* ST = (LAS bf16_t*)F.lds; LAS bf16_t* RP = (LAS bf16_t*)(F.lds + 34816); LAS float* red = (LAS float*)(F.lds + 34816 + 17408);
    const bf16_t* gS = (const bf16_t*)(F.ws + WS_GDS) + (size_t)item * 16384; const bf16_t* gR = (const bf16_t*)(F.ws + WS_GDR) + (size_t)item * 8192; const bf16_t* gO = (const bf16_t*)(F.ws + ws_gdo(l)) + (size_t)item * 8192;
#pragma unroll
    for (int k = 0; k < 4; ++k) { const int e = F.tid + 512 * k; *(u32x4*)(ST + (e >> 4) * 136 + (e & 15) * 8) = *(const u32x4*)(gS + (e >> 4) * 128 + (e & 15) * 8); }
#pragma unroll
    for (int k = 0; k < 2; ++k) { const int e = F.tid + 512 * k; *(u32x4*)(RP + (e >> 4) * 136 + (e & 15) * 8) = *(const u32x4*)(gR + (e >> 4) * 128 + (e & 15) * 8); }
    __syncthreads();
    const int n2 = F.wave >> 1, vh = F.wave & 1, q = F.lane >> 4, cl = F.lane & 15, i = 16 * n2 + cl;
    f32x4 o[4]; float sq = 0.f;
#pragma unroll
    for (int j = 0; j < 4; ++j) { const int mt = 4 * vh + j;
        o[j] = mma_tile<128>(ST, 136, RP, 136, 16 * mt, 16 * n2, unpack4(*(const u32x2*)(gO + i * 128 + 16 * mt + 4 * q)), F.lane);
        sq += (o[j][0] * o[j][0] + o[j][1] * o[j][1]) + (o[j][2] * o[j][2] + o[j][3] * o[j][3]); }
    sq += __shfl_xor(sq, 16); sq += __shfl_xor(sq, 32);
    if (q == 0) red[i * 2 + vh] = sq;
    __syncthreads();
    const float rms = rsqrtf((red[i * 2] + red[i * 2 + 1]) * (1.f / 128.f) + 1e-6f);
    const bf16_t* zg = (const bf16_t*)(F.ws + WS_Z) + (size_t)(row0 + i) * ZW + ZC_GZ + h * 128; bf16_t* Y = (bf16_t*)(F.ws + WS_Y) + (size_t)(row0 + i) * 1536 + h * 128; const float* ng = INP(I_GDN_NG) + l * 128;
#pragma unroll
    for (int j = 0; j < 4; ++j) { const int v0 = 16 * (4 * vh + j) + 4 * q; const f32x4 g4 = *(const f32x4*)(ng + v0); const f32x4 z4 = unpack4(*(const u32x2*)(zg + v0)); f32x4 y;
#pragma unroll
        for (int r = 0; r < 4; ++r) y[r] = o[j][r] * rms * g4[r] * siluf_(z4[r]);
        *(u32x2*)(Y + v0) = pack4(y); }
    __syncthreads();
}
__device__ __forceinline__ void phase_gdn_sa(Frame& F, int l) { LAUNDER(F); for (int item = F.bid; item < 1024; item += F.G) gdn_sa_item(F, l, item); }
__device__ __forceinline__ void phase_gdn_sb(Frame& F) { LAUNDER(F); if (F.bid >= 100 && F.bid < 108) gdn_scan_block(F, F.bid - 100); }
__device__ __forceinline__ void phase_gdn_sc(Frame& F, int l) { LAUNDER(F); for (int item = F.bid; item < 1024; item += F.G) gdn_sc_item(F, l, item); }

__device__ __forceinline__ float zshift(const bf16_t* Z, int row, int t, int col, float mu) {
    const float cur = bf2f(Z[(size_t)row * ZW + col]); const float prev = t > 0 ? bf2f(Z[(size_t)(row - 1) * ZW + col]) : 0.f; return cur + mu * (prev - cur);
}
__device__ __forceinline__ void phase_rw_prep(Frame& F, int l) {
    LAUNDER(F);
    const bf16_t* Z = (const bf16_t*)(F.ws + WS_Z);
    float* K1 = (float*)(F.ws + WS_S0); float* KK = (float*)(F.ws + WS_S1); float* AKK = (float*)(F.ws + WS_S2); float* Wd = (float*)(F.ws + WS_S4); float* VF = (float*)(F.ws + WS_VF);
    const float* mu = INP(I_RW_MU) + l * 1792;
    const float* w0 = INP(I_RW_W0) + l * 512; const float* w2 = INP(I_RW_W2) + (size_t)l * 64 * 512; const float* a0 = INP(I_RW_A0) + l * 512; const float* a2 = INP(I_RW_A2) + (size_t)l * 64 * 512;
    const float* k_k = INP(I_RW_KK) + l * 512; const float* k_a = INP(I_RW_KA) + l * 512;
    const int gw = F.bid * NWAVES + F.wave, NGW = F.G * NWAVES;
    for (int it = gw; it < NTOK * 8; it += NGW) {
        const int row = it >> 3, h = it & 7, t = row % SEQ, c = h * 64 + F.lane;
        const float k = zshift(Z, row, t, ZC_RK + c, mu[512 + c]); float v = zshift(Z, row, t, ZC_RV + c, mu[1024 + c]);
        const float xw = tanhf(zshift(Z, row, t, ZC_RW + F.lane, mu[1536 + F.lane])), xa = zshift(Z, row, t, ZC_RA + F.lane, mu[1600 + F.lane]);
        float sw = 0.f, sa = 0.f;
        for (int j = 0; j < 64; ++j) { const float xwj = __shfl(xw, j), xaj = __shfl(xa, j); sw += xwj * w2[j * 512 + c]; sa += xaj * a2[j * 512 + c]; }
        const float lw = -__expf(-softplusf_(-(w0[c] + sw)) - 0.5f);
        const float a = sigmoidf_(a0[c] + sa);
        if (l == 1) {
            const float* muv = INP(I_RW_MUV1); const float* v0 = INP(I_RW_V0); const float* v2 = INP(I_RW_V2);
            const float xv = F.lane < 32 ? zshift(Z, row, t, ZC_XV + F.lane, muv[F.lane]) : 0.f; float sv = 0.f;
            for (int j = 0; j < 32; ++j) sv += __shfl(xv, j) * v2[j * 512 + c];
            const float vf = VF[(size_t)row * 512 + c];
            v = v + (vf - v) * sigmoidf_(v0[c] + sv);
        }
        const float kkr = k * k_k[c]; const float kk = kkr * rsqrtf(wave_sum(kkr * kkr) + 1e-6f);
        const float kp = k * (1.f + (a - 1.f) * k_a[c]);
        const size_t idx = (size_t)row * 512 + c;
        K1[idx] = kp; KK[idx] = kk; AKK[idx] = a * kk; Wd[idx] = __expf(lw); VF[idx] = v;
    }
}
__device__ __forceinline__ void phase_rw_core(Frame& F, int l) {
    LAUNDER(F);
    if (F.bid >= 16) return;
    const int b = F.bid >> 3, h = F.bid & 7;
    const bf16_t* Z = (const bf16_t*)(F.ws + WS_Z); const float* mu = INP(I_RW_MU) + l * 1792;
    const float* K1 = (const float*)(F.ws + WS_S0); const float* KK = (const float*)(F.ws + WS_S1); float* AKK = (float*)(F.ws + WS_S2); const float* Wd = (const float*)(F.ws + WS_S4); const float* VF = (const float*)(F.ws + WS_VF);
    LAS float* sr = (LAS float*)F.lds; LAS float* sk = sr + 1024; LAS float* skk = sk + 1024; LAS float* sak = skk + 1024; LAS float* sw = sak + 1024; LAS float* sv = sw + 1024;
    float s[8];
#pragma unroll
    for (int i = 0; i < 8; ++i) s[i] = 0.f;
    const int i_ = F.tid >> 3, p = F.tid & 7;
    for (int t0 = 0; t0 < SEQ; t0 += 16) {
        const size_t rbase = (size_t)b * SEQ + t0;
        for (int e = F.tid; e < 16 * 64; e += NTHREADS) { const int tt = e >> 6, c = e & 63; const size_t idx = (rbase + tt) * 512 + h * 64 + c;
            sr[e] = zshift(Z, (int)(rbase + tt), t0 + tt, ZC_RR + h * 64 + c, mu[h * 64 + c]); sk[e] = K1[idx]; skk[e] = KK[idx]; sak[e] = AKK[idx]; sw[e] = Wd[idx]; sv[e] = VF[idx]; }
        __syncthreads();
        for (int tt = 0; tt < 16; ++tt) {
            const f32x4 ka = *(const LAS f32x4*)(skk + tt * 64 + 8 * p), kb = *(const LAS f32x4*)(skk + tt * 64 + 8 * p + 4);
            float sk_ = (s[0] * ka[0] + s[1] * ka[1]) + (s[2] * ka[2] + s[3] * ka[3]) + (s[4] * kb[0] + s[5] * kb[1]) + (s[6] * kb[2] + s[7] * kb[3]);
            sk_ += __shfl_xor(sk_, 1); sk_ += __shfl_xor(sk_, 2); sk_ += __shfl_xor(sk_, 4);
            const float vi = sv[tt * 64 + i_];
            float y = 0.f;
#pragma unroll
            for (int j = 0; j < 8; ++j) { const int o = tt * 64 + 8 * p + j; s[j] = s[j] * sw[o] - sk_ * sak[o] + vi * sk[o]; y += s[j] * sr[o]; }
            y += __shfl_xor(y, 1); y += __shfl_xor(y, 2); y += __shfl_xor(y, 4);
            if (p == 0) AKK[(rbase + tt) * 512 + h * 64 + i_] = y;
        }
        __syncthreads();
    }
}
__device__ __forceinline__ void phase_rw_post(Frame& F, int l) {
    LAUNDER(F);
    const bf16_t* Z = (const bf16_t*)(F.ws + WS_Z);
    const float* K1 = (const float*)(F.ws + WS_S0); const float* Yc = (const float*)(F.ws + WS_S2); const float* VF = (const float*)(F.ws + WS_VF);
    bf16_t* Y = (bf16_t*)(F.ws + WS_Y);
    const float* mu = INP(I_RW_MU) + l * 1792; const float* g2 = INP(I_RW_G2) + (size_t)l * 128 * 512; const float* r_k = INP(I_RW_RK) + l * 512;
    const float* lng = INP(I_RW_LNG) + l * 512; const float* lnb = INP(I_RW_LNB) + l * 512;
    const int gw = F.bid * NWAVES + F.wave, NGW = F.G * NWAVES;
    for (int it = gw; it < NTOK * 8; it += NGW) {
        const int row = it >> 3, h = it & 7, t = row % SEQ, c = h * 64 + F.lane; const size_t idx = (size_t)row * 512 + c;
        const float xg0 = sigmoidf_(zshift(Z, row, t, ZC_RG + F.lane, mu[1664 + F.lane])), xg1 = sigmoidf_(zshift(Z, row, t, ZC_RG + 64 + F.lane, mu[1664 + 64 + F.lane]));
        float g = 0.f;
        for (int j = 0; j < 64; ++j) g += __shfl(xg0, j) * g2[j * 512 + c] + __shfl(xg1, j) * g2[(64 + j) * 512 + c];
        const float y = Yc[idx]; const float m = wave_sum(y) * (1.f / 64.f); const float d = y - m; const float var = wave_sum(d * d) * (1.f / 64.f);
        float yn = d * rsqrtf(var + 64e-5f) * lng[c] + lnb[c];
        const float r = zshift(Z, row, t, ZC_RR + c, mu[c]);
        const float bonus = wave_sum(r * K1[idx] * r_k[c]) * VF[idx];
        Y[(size_t)row * 1536 + 1024 + c] = f2bf((yn + bonus) * g);
    }
}

#define SITE(N) int g_ = F.G, b_ = F.bid; unsigned char* w_ = ws; asm volatile("; gemm site " #N : "+s"(g_), "+s"(b_), "+s"(w_))
enum { PH_CONV0 = 0, PH_LNIN, PH_L0 = 2,
       LP_INPROJ = 0, LP_GDN_PREP, LP_GDN_CORE, LP_GDN_POST, LP_ML_PREP, LP_ML_CORE, LP_ML_POST, LP_RW_PREP, LP_RW_CORE, LP_RW_POST, LP_MERGE, LP_WO, LP_LN1, LP_F1, LP_F2, LP_F3, LP_LN2, LP_COUNT };
constexpr int PH_L1 = PH_L0 + LP_COUNT, PH_END = PH_L1 + LP_COUNT;


__device__ __forceinline__ void run_phase(Frame& F, const Args& args, const Args* ap, unsigned char* ws, const int ph) {
        if (ph == PH_CONV0) {
            if (F.bid == 0 && F.tid < 8) ((unsigned*)(ws + WS_CTL))[CW_CNT + F.tid] = 0u;
            phase_mod(F);
            phase_convert(F, 0, NJOBS0, 0, ap->items0);
        } else if (ph == PH_LNIN) {
            phase_ln(F, 0, INP(I_LNIN_G), INP(I_LNIN_B), 0, 0, 0, 0, 1024, false, false);
        } else {
            const int l = (ph - PH_L0) / LP_COUNT, k = (ph - PH_L0) % LP_COUNT;
            switch (k) {
            case LP_INPROJ: {
                SITE(1); pg8::StaticOrder S{(const char*)(w_ + WS_H), (const char*)(w_ + WS_WIN + (size_t)l * ZW * 1024 * 2), NTOK / 256, ZW / 256, 1024, g_, b_};
                pg8::EpiBf16 E{(bf16_t*)(w_ + WS_Z), ZW};
                pg8::gemm_phase(F.lds, 1024, S, E); } break;
            case LP_GDN_PREP: phase_gdn_sa(F, l); break;
            case LP_GDN_CORE: phase_gdn_sb(F); break;
            case LP_GDN_POST: phase_gdn_sc(F, l); break;
            case LP_ML_PREP: phase_ml_sa(F, l); break;
            case LP_ML_CORE: phase_ml_sb(F); break;
            case LP_ML_POST: phase_ml_sc(F, l); break;
            case LP_RW_PREP: phase_rw_sa(F, l); break;
            case LP_RW_CORE: phase_rw_sb(F); break;
            case LP_RW_POST: phase_rw_sc(F, l); break;
            case LP_MERGE: {
                SITE(2); pg8::StaticOrder S{(const char*)(w_ + WS_Y), (const char*)(w_ + WS_WBR + (size_t)l * 1024 * 1536 * 2), NTOK / 256, 4, 1536, g_, b_};
                pg8::EpiMerge E{(const bf16_t*)(w_ + WS_Z), (bf16_t*)(w_ + WS_H)};
                pg8::gemm_phase(F.lds, 1536, S, E); } break;
            case LP_WO: {
                SITE(3); pg8::StaticOrder S{(const char*)(w_ + WS_H), (const char*)(w_ + WS_WO + (size_t)l * 1024 * 1024 * 2), NTOK / 256, 4, 1024, g_, b_};
                pg8::EpiF32 E{(float*)(w_ + WS_YF), 1024};
                pg8::gemm_phase(F.lds, 1024, S, E); } break;
            case LP_LN1:
                if (l == 0) phase_ln(F, 1, INP(I_LN1_G), INP(I_LN1_B), 0, 2048, 0, 3072, 4096, false, false);
                else phase_ln(F, 1, INP(I_LN1_G) + 1024, INP(I_LN1_B) + 1024, 1, 2048, 1, 3072, 4096, true, false);
                break;
            case LP_F1:
                if (l == 1) { phase_moe_setup(F); phase_convert(F, NJOBS0, NJOBS, ap->items0, ap->items0 + ap->items1); }
                break;
            case LP_F2:
                if (l == 0) {
                    SITE(4); pg8::StaticOrder S{(const char*)(w_ + WS_H), (const char*)(w_ + WS_WGU), NTOK / 256, 2 * DFF / 256, 1024, g_, b_};
                    pg8::EpiSwiglu E{(bf16_t*)(w_ + WS_ACT0), DFF};
                    pg8::gemm_phase(F.lds, 1024, S, E);
                } else {
                    const int* texp = (const int*)(ws + WS_TEXP); const int nrt = texp[MOE_RT_MAX];
                    SITE(5); pg8::MoeOrder S{(const char*)(w_ + WS_MA), (const char*)(w_ + WS_MW), texp, MW_EXP_BYTES, nrt, 2 * DFFE / 256, 1024, g_, b_};
                    pg8::EpiSwiglu E{(bf16_t*)(w_ + WS_MACT), DFFE};
                    pg8::gemm_phase(F.lds, 1024, S, E);
                }
                break;
            case LP_F3:
                if (l == 0) {
                    SITE(6); pg8::StaticOrder S{(const char*)(w_ + WS_ACT0), (const char*)(w_ + WS_WD), NTOK / 256, 4, DFF, g_, b_};
                    pg8::EpiF32 E{(float*)(w_ + WS_YF), 1024};
                    pg8::gemm_phase(F.lds, DFF, S, E);
                } else {
                    const int* texp = (const int*)(ws + WS_TEXP); const int nrt = texp[MOE_RT_MAX];
                    SITE(7); pg8::MoeOrder S{(const char*)(w_ + WS_MACT), (const char*)(w_ + WS_MW + (size_t)7168 * 1024 * 2), texp, MW_EXP_BYTES, nrt, 4, DFFE, g_, b_};
                    pg8::EpiBf16 E{(bf16_t*)(w_ + WS_MY), 1024};
                    pg8::gemm_phase(F.lds, DFFE, S, E);
                }
                break;
            case LP_LN2:
                if (l == 0) phase_ln(F, 1, INP(I_LN2_G), INP(I_LN2_B), 0, 5120, 1, 0, 1024, false, false);
                else phase_ln(F, 3, INP(I_LN2_G) + 1024, INP(I_LN2_B) + 1024, 1, 5120, 0, 0, 0, false, true);
                break;
            default: break;
            }
        }
}
#define FRAME_SETUP() \
        const Args* ap = &args; \
        int tid_ = threadIdx.x; asm volatile("" : "+v"(tid_)); \
        Frame F; F.lds = (LAS unsigned char*)lds_raw; F.tid = tid_; F.lane = tid_ & 63; F.wave = __builtin_amdgcn_readfirstlane(tid_ >> 6); F.G = gridDim.x; F.bid = blockIdx.x; F.a = ap; \
        unsigned char* ws = args.ws; asm volatile("" : "+s"(ws)); F.ws = ws;

#if ONE_LAUNCH
#define PHASE(k) do { if (lo <= (k) && (k) < hi) { FRAME_SETUP(); run_phase(F, args, ap, ws, (k)); } if (lo <= (k) && (k) + 1 < hi) cg::this_grid().sync(); } while (0)
__global__ void __launch_bounds__(NTHREADS, 2) mk(Args args) {
    extern __shared__ __attribute__((aligned(16))) unsigned char lds_raw[];
    const int lo = args.ph_lo, hi = args.ph_hi;
    PHASE(0); PHASE(1); PHASE(2); PHASE(3); PHASE(4); PHASE(5); PHASE(6); PHASE(7); PHASE(8); PHASE(9); PHASE(10); PHASE(11); PHASE(12); PHASE(13); PHASE(14); PHASE(15); PHASE(16); PHASE(17); PHASE(18);
    PHASE(19); PHASE(20); PHASE(21); PHASE(22); PHASE(23); PHASE(24); PHASE(25); PHASE(26); PHASE(27); PHASE(28); PHASE(29); PHASE(30); PHASE(31); PHASE(32); PHASE(33); PHASE(34); PHASE(35);
    static_assert(PH_END == 36, "phase list");
}
#endif
template <int KIND> __global__ void __launch_bounds__(NTHREADS, 2) mk_one(Args args) {
    extern __shared__ __attribute__((aligned(16))) unsigned char lds_raw[];
    FRAME_SETUP();
    const int ph = (KIND < PH_L0) ? KIND : KIND + args.ph_lo * LP_COUNT;
    if (KIND < PH_L0) run_phase(F, args, ap, ws, KIND);
    else if (args.ph_lo == 0) run_phase(F, args, ap, ws, KIND);
    else run_phase(F, args, ap, ws, KIND + LP_COUNT);
    (void)ph;
}

static int fill_jobs(Args& a, void* const* d_in, unsigned char* ws) {
    int nj = 0, item = 0;
    auto add = [&](const float* src, bf16_t* dst, int K, int ld_src, int col0, int ncols, int ld_dst, int r0, int mode, int batch, long long sbs, long long dbs) {
        Job& J = a.jobs[nj++]; J.src = src; J.dst = dst; J.src_bs = sbs; J.dst_bs = dbs; J.K = K; J.ld_src = ld_src; J.col0 = col0; J.ncols = ncols; J.ld_dst = ld_dst; J.r0 = r0; J.mode = mode; J.batch = batch;
        J.item0 = item; J.nitems = batch * ((K + 63) / 64) * ((ncols + 31) / 32); item += J.nitems; J.pad0 = 0; J.pad1 = 0; };
    for (int l = 0; l < 2; ++l) {
        const float* w = (const float*)d_in[I_W_IN] + (size_t)l * 1024 * IN_W; bf16_t* d = (bf16_t*)(ws + WS_WIN) + (size_t)l * ZW * 1024;
        add(w, d, 1024, IN_W, 0, 2048, 1024, 0, 0, 1, 0, 0);
        add(w, d, 1024, IN_W, 2056, 1536, 1024, 2048, 0, 1, 0, 0);
        add(w, d, 1024, IN_W, 3600, 1792, 1024, 3584, 0, 1, 0, 0);
        add(w, d, 1024, IN_W, 2048, 8, 1024, 5376, 0, 1, 0, 0);
        add(w, d, 1024, IN_W, 3592, 8, 1024, 5384, 0, 1, 0, 0);
        add(w, d, 1024, IN_W, 5392, 3072, 1024, 5632, 0, 1, 0, 0);
        if (l == 1) add((const float*)d_in[I_RW_V1], d, 1024, 32, 0, 32, 1024, 5392, 0, 1, 0, 0);
        add((const float*)d_in[I_W_BR] + (size_t)l * 3 * 512 * 1024, (bf16_t*)(ws + WS_WBR) + (size_t)l * 1024 * 1536, 512, 1024, 0, 1024, 1536, 0, 0, 3, 512ll * 1024, 512);
        add((const float*)d_in[I_W_O] + (size_t)l * 1024 * 1024, (bf16_t*)(ws + WS_WO) + (size_t)l * 1024 * 1024, 1024, 1024, 0, 1024, 1024, 0, 0, 1, 0, 0);
    }
    for (int l = 0; l < 2; ++l) {
        bf16_t* d = (bf16_t*)(ws + WS_LORAT) + (size_t)l * LORAT_LAYER;
        add((const float*)d_in[I_RW_W2] + (size_t)l * 64 * 512, d, 64, 512, 0, 512, 64, 0, 0, 1, 0, 0);
        add((const float*)d_in[I_RW_A2] + (size_t)l * 64 * 512, d + 512 * 64, 64, 512, 0, 512, 64, 0, 0, 1, 0, 0);
        add((const float*)d_in[I_RW_G2] + (size_t)l * 128 * 512, d + 2 * 512 * 64, 128, 512, 0, 512, 128, 0, 0, 1, 0, 0);
        if (l == 1) add((const float*)d_in[I_RW_V2], d + 2 * 512 * 64 + 512 * 128, 32, 512, 0, 512, 32, 0, 0, 1, 0, 0);
    }
    add((const float*)d_in[I_FFN_G], (bf16_t*)(ws + WS_WGU), 1024, DFF, 0, DFF, 1024, 0, 1, 1, 0, 0);
    add((const float*)d_in[I_FFN_U], (bf16_t*)(ws + WS_WGU), 1024, DFF, 0, DFF, 1024, 128, 1, 1, 0, 0);
    add((const float*)d_in[I_FFN_D], (bf16_t*)(ws + WS_WD), DFF, 1024, 0, 1024, DFF, 0, 0, 1, 0, 0);
    if (nj != NJOBS0) return -1;
    a.items0 = item;
    const long long eb = (long long)(MW_EXP_BYTES / 2);
    add((const float*)d_in[I_MOE_G], (bf16_t*)(ws + WS_MW), 1024, DFFE, 0, DFFE, 1024, 0, 1, 8, 1024ll * DFFE, eb);
    add((const float*)d_in[I_MOE_U], (bf16_t*)(ws + WS_MW), 1024, DFFE, 0, DFFE, 1024, 128, 1, 8, 1024ll * DFFE, eb);
    add((const float*)d_in[I_MOE_D], (bf16_t*)(ws + WS_MW) + (size_t)7168 * 1024, DFFE, 1024, 0, 1024, DFFE, 0, 0, 8, (long long)DFFE * 1024, eb);
    if (nj != NJOBS) return -1;
    a.items1 = item - a.items0;
    return 0;
}

template <int KIND> static void launch_kind(Args& a, int layer, int grid, hipStream_t stream) {
    static bool attr = false;
    if (!attr) { (void)hipFuncSetAttribute((const void*)mk_one<KIND>, hipFuncAttributeMaxDynamicSharedMemorySize, LDS_BYTES); attr = true; }
    a.ph_lo = layer; a.ph_hi = layer + 1;
    hipLaunchKernelGGL(mk_one<KIND>, dim3(grid), dim3(NTHREADS), LDS_BYTES, stream, a);
}
template <int K0, int K1> struct LaunchRange { static void run(Args& a, int layer, int grid, hipStream_t stream) {
    if (!(layer == 0 && K0 == PH_L0 + LP_F1)) launch_kind<K0>(a, layer, grid, stream);
    LaunchRange<K0 + 1, K1>::run(a, layer, grid, stream); } };
template <int K1> struct LaunchRange<K1, K1> { static void run(Args&, int, int, hipStream_t) {} };
static void launch_all_phases(Args& a, int grid, hipStream_t stream) {
    launch_kind<PH_CONV0>(a, 0, grid, stream);
    launch_kind<PH_LNIN>(a, 0, grid, stream);
    for (int l = 0; l < 2; ++l) LaunchRange<PH_L0, PH_L0 + LP_COUNT>::run(a, l, grid, stream);
}

extern "C" void kernel_launch(void* const* d_in, const int* in_sizes, int n_in, void* d_out, int out_size, void* d_ws, size_t ws_size, hipStream_t stream) {
    static int grid = 0;
    if (grid == 0) {
        if (n_in != 43 || out_size != NTOK * D || ws_size < WS_END) { fprintf(stderr, "kernel_launch: unexpected shapes n_in %d out %d ws %zu (need %zu)\n", n_in, out_size, ws_size, (size_t)WS_END); grid = -1; return; }
        int dev = 0, cus = 0, per_cu = 0;
        (void)hipGetDevice(&dev); (void)hipDeviceGetAttribute(&cus, hipDeviceAttributeMultiprocessorCount, dev); (void)per_cu;
#if ONE_LAUNCH
        if (hipFuncSetAttribute((const void*)mk, hipFuncAttributeMaxDynamicSharedMemorySize, LDS_BYTES) != hipSuccess) { fprintf(stderr, "hipFuncSetAttribute failed\n"); grid = -1; return; }
        (void)hipOccupancyMaxActiveBlocksPerMultiprocessor(&per_cu, (const void*)mk, NTHREADS, LDS_BYTES);
        if (per_cu < 1) { fprintf(stderr, "occupancy query says %d\n", per_cu); per_cu = 1; }
        (void)hipGetLastError();
#endif
        grid = cus;
    }
    if (grid < 0) return;
    Args a{};
    for (int i = 0; i < 43; ++i) a.in[i] = (const float*)d_in[i];
    a.out = (float*)d_out; a.ws = (unsigned char*)d_ws;
    if (fill_jobs(a, d_in, (unsigned char*)d_ws) != 0) { fprintf(stderr, "job table mismatch\n"); return; }
#if ONE_LAUNCH
    a.ph_lo = 0; a.ph_hi = PH_END;
    void* kargs[] = {&a};
    hipError_t e = hipLaunchCooperativeKernel((const void*)mk, dim3(grid), dim3(NTHREADS), kargs, LDS_BYTES, stream);
    if (e != hipSuccess) fprintf(stderr, "cooperative launch failed: %s\n", hipGetErrorString(e));
#else
    launch_all_phases(a, grid, stream);
#endif
}
```

```cpp
#include <hip/hip_runtime.h>
#include <hip/hip_cooperative_groups.h>
#include <cstdio>
#include <cstdint>
namespace cg = cooperative_groups;

#ifndef ONE_LAUNCH
#define ONE_LAUNCH 1
#endif

#define LAS __attribute__((address_space(3)))
typedef unsigned short bf16_t;
typedef short bf16x8 __attribute__((ext_vector_type(8)));
typedef float f32x4 __attribute__((ext_vector_type(4)));
typedef float f32x2 __attribute__((ext_vector_type(2)));
typedef unsigned u32x4 __attribute__((ext_vector_type(4)));
typedef unsigned u32x2 __attribute__((ext_vector_type(2)));

constexpr int NTOK = 16384, D = 1024, SEQ = 8192, NB = 2;
constexpr int IN_W = 8464;
constexpr int ZW = 8704;
constexpr int ZC_GQ = 0, ZC_GK = 512, ZC_GV = 1024, ZC_GZ = 1536, ZC_MQ = 2048, ZC_MK = 2304, ZC_MV = 2560, ZC_MO = 3072,
              ZC_RR = 3584, ZC_RK = 4096, ZC_RV = 4608, ZC_RW = 5120, ZC_RA = 5184, ZC_RG = 5248, ZC_GA = 5376, ZC_GB = 5380,
              ZC_MI = 5384, ZC_MF = 5388, ZC_XV = 5392, ZC_GATE = 5632;
constexpr int DFF = 2816, DFFE = 3584, NEXP = 8;
constexpr int MOE_ROWS_MAX = 32768 + NEXP * 256;
constexpr int MOE_RT_MAX = MOE_ROWS_MAX / 256;
constexpr float DN_ALPHA = 1.4142135623730951f;
constexpr float LN_EPS = 1e-5f;

constexpr size_t MB = 1ull << 20;
constexpr size_t WS_CTL = 0;
constexpr size_t WS_MOD = 64 * 1024;
constexpr size_t WS_TOPE = 256 * 1024;
constexpr size_t WS_TOPG = 384 * 1024;
constexpr size_t WS_TOPP = 512 * 1024;
constexpr size_t WS_WIN = 1 * MB;
constexpr size_t WS_WBR = 35 * MB;
constexpr size_t WS_WO = 41 * MB;
constexpr size_t WS_WGU = 45 * MB;
constexpr size_t WS_WD = 56 * MB;
constexpr size_t WS_H = 62 * MB;
constexpr size_t WS_VF = 94 * MB;
constexpr size_t WS_Y = 126 * MB;
constexpr size_t WS_Z = 174 * MB;
constexpr size_t WS_S = 446 * MB;
constexpr size_t WS_YF = WS_S;
constexpr size_t WS_S0 = WS_S, WS_S1 = WS_S + 32 * MB, WS_S2 = WS_S + 64 * MB, WS_S3 = WS_S + 96 * MB, WS_S4 = WS_H;
constexpr size_t WS_ACT0 = WS_Z;
constexpr size_t WS_MACT = 1 * MB;
constexpr size_t WS_MW = 240 * MB;
constexpr size_t WS_MA = 408 * MB;
constexpr size_t WS_MY = 476 * MB;
constexpr size_t WS_LORAT = WS_S + 115 * MB;
constexpr size_t LORAT_LAYER = 512 * (64 + 64 + 128 + 32);
constexpr size_t WS_END = 544 * MB;
constexpr size_t MW_EXP_BYTES = (size_t)(7168 + 3584) * 1024 * 2;

constexpr int CW_CNT = 0;
constexpr size_t WS_BAR = 8192;
constexpr size_t CTL_ZERO_BYTES = 8192 + 3456 * 4;

__device__ __forceinline__ float bf2f(bf16_t b) { return __uint_as_float(((unsigned)b) << 16); }
__device__ __forceinline__ bf16_t f2bf(float f) { unsigned u = __float_as_uint(f); u += 0x7FFFu + ((u >> 16) & 1u); return (bf16_t)(u >> 16); }
__device__ __forceinline__ unsigned pk2(float lo, float hi) { return (unsigned)f2bf(lo) | ((unsigned)f2bf(hi) << 16); }
__device__ __forceinline__ unsigned cvt_pk_bf16(float lo, float hi) { unsigned r; asm volatile("v_cvt_pk_bf16_f32 %0, %1, %2" : "=v"(r) : "v"(lo), "v"(hi)); return r; }
__device__ __forceinline__ float sigmoidf_(float x) { return 1.f / (1.f + __expf(-x)); }
__device__ __forceinline__ float siluf_(float x) { return x / (1.f + __expf(-x)); }
__device__ __forceinline__ float softplusf_(float x) { return x > 20.f ? x : log1pf(__expf(x)); }
__device__ __forceinline__ float wave_sum(float v) {
#pragma unroll
    for (int o = 1; o < 64; o <<= 1) v += __shfl_xor(v, o);
    return v;
}

struct Job { const float* src; bf16_t* dst; long long src_bs, dst_bs; int K, ld_src, col0, ncols, ld_dst, r0, mode, batch, item0, nitems, pad0, pad1; };
constexpr int NJOBS0 = 27, NJOBS1 = 3, NJOBS = NJOBS0 + NJOBS1;
struct Args {
    const float* in[43];
    float* out;
    unsigned char* ws;
    Job jobs[NJOBS];
    int items0, items1;
    int ph_lo, ph_hi;
};
enum { I_X = 0, I_C, I_LNIN_G, I_LNIN_B, I_ADA_W, I_ADA_B, I_W_IN, I_GDN_CONV, I_GDN_ALOG, I_GDN_DTB, I_GDN_NG, I_ML_BI, I_ML_BF, I_ML_NG,
       I_RW_MU, I_RW_W0, I_RW_W2, I_RW_A0, I_RW_A2, I_RW_G2, I_RW_KK, I_RW_KA, I_RW_RK, I_RW_LNG, I_RW_LNB, I_RW_V1, I_RW_MUV1, I_RW_V0, I_RW_V2,
       I_W_BR, I_W_O, I_LN1_G, I_LN1_B, I_LN2_G, I_LN2_B, I_FFN_G, I_FFN_U, I_FFN_D, I_MOE_R, I_MOE_RB, I_MOE_G, I_MOE_U, I_MOE_D };

namespace pg8 {
constexpr int BM = 256, BK = 64, HALF = 128, HTB = HALF * BK * 2, STAGE_BYTES = 8 * HTB, NXCD = 8, WGM = 8;
__host__ __device__ __forceinline__ int lds_byte(int r, int c) { const int st = (r >> 4) * 2 + (c >> 5), rr = r & 15, cc = c & 31, ob = rr * 64 + cc * 2; return st * 1024 + (ob ^ (((ob >> 9) & 1) << 5)); }
__host__ __device__ __forceinline__ void stage_rc(int b, int& R, int& C) { const int st = b / 1024, sb = b % 1024, swz = sb ^ (((sb >> 9) & 1) << 5); R = (st >> 1) * 16 + swz / 64; C = (st & 1) * 32 + (swz % 64) / 2; }
__host__ __device__ __forceinline__ int perm32(int rho) { const int n = rho >> 4, i = rho & 15; return 8 * (i >> 2) + 4 * n + (i & 3); }

struct Unit { const char* a; const char* b; int pm, pn; };

__device__ __forceinline__ bool static_tile(int i, int G, int c, int nM, int nN, int& pm, int& pn) {
    const int nwg = nM * nN; const long L = (long)i * G + c; if (L >= nwg) return false;
    int wgid = (int)L; { const int q = nwg / NXCD, r = nwg % NXCD, xcd = wgid % NXCD, off = wgid / NXCD; wgid = (xcd < r ? xcd * (q + 1) : r * (q + 1) + (xcd - r) * q) + off; }
    const int nig = WGM * nN, gid = wgid / nig, fm = gid * WGM, gsz = (nM - fm) < WGM ? (nM - fm) : WGM;
    pm = fm + ((wgid % nig) % gsz); pn = (wgid % nig) / gsz; return true;
}
struct StaticOrder {
    const char* A; const char* Bt; int nM, nN, K, G, c;
    __device__ __forceinline__ bool next(int i, Unit& u) const {
        int pm, pn; if (!static_tile(i, G, c, nM, nN, pm, pn)) return false;
        u.pm = pm; u.pn = pn; u.a = A + (size_t)pm * BM * K * 2; u.b = Bt + (size_t)pn * BM * K * 2; return true;
    }
};
struct MoeOrder {
    const char* A; const char* W; const int* tile_exp; size_t wexp_bytes; int nM, nN, K, G, c;
    __device__ __forceinline__ bool next(int i, Unit& u) const {
        int pm, pn; if (!static_tile(i, G, c, nM, nN, pm, pn)) return false;
        const int e = tile_exp[pm];
        u.pm = pm; u.pn = pn; u.a = A + (size_t)pm * BM * K * 2; u.b = W + (size_t)e * wexp_bytes + (size_t)pn * BM * K * 2; return true;
    }
};

struct EpiBf16 {
    static constexpr bool PERM = true, HAS_MID = false;
    bf16_t* O; int ldc;
    __device__ __forceinline__ void mid(f32x4 (&)[2][2][4][2], const Unit&, int, int, int, int, int) const {}
    __device__ __forceinline__ void operator()(const f32x4 (&acc)[2][2][4][2], const Unit& u, int wr, int wc, int fr, int fq) const {
        const int row0 = u.pm * BM + wr * 64 + fr, col0 = u.pn * BM + wc * 32 + 8 * fq;
#pragma unroll
        for (int ai = 0; ai < 2; ++ai)
#pragma unroll
            for (int m = 0; m < 4; ++m) { bf16_t* rowp = O + (size_t)(row0 + ai * HALF + m * 16) * ldc + col0;
#pragma unroll
                for (int bj = 0; bj < 2; ++bj) { const f32x4 v0 = acc[ai][bj][m][0], v1 = acc[ai][bj][m][1];
                    u32x4 w; w.x = cvt_pk_bf16(v0[0], v0[1]); w.y = cvt_pk_bf16(v0[2], v0[3]); w.z = cvt_pk_bf16(v1[0], v1[1]); w.w = cvt_pk_bf16(v1[2], v1[3]);
                    *(u32x4*)(rowp + bj * HALF) = w; } }
    }
};
struct EpiSwiglu {
    static constexpr bool PERM = true, HAS_MID = false;
    bf16_t* O; int ldc;
    __device__ __forceinline__ void mid(f32x4 (&)[2][2][4][2], const Unit&, int, int, int, int, int) const {}
    __device__ __forceinline__ void operator()(const f32x4 (&acc)[2][2][4][2], const Unit& u, int wr, int wc, int fr, int fq) const {
        const int row0 = u.pm * BM + wr * 64 + fr, col0 = u.pn * HALF + wc * 32 + 8 * fq;
#pragma unroll
        for (int ai = 0; ai < 2; ++ai)
#pragma unroll
            for (int m = 0; m < 4; ++m) { bf16_t* rowp = O + (size_t)(row0 + ai * HALF + m * 16) * ldc + col0;
                float r[8];
#pragma unroll
                for (int n = 0; n < 2; ++n)
#pragma unroll
                    for (int j = 0; j < 4; ++j) { const float g = acc[ai][0][m][n][j], uu = acc[ai][1][m][n][j]; r[n * 4 + j] = g * uu * __builtin_amdgcn_rcpf(1.f + __expf(-g)); }
                u32x4 w; w.x = cvt_pk_bf16(r[0], r[1]); w.y = cvt_pk_bf16(r[2], r[3]); w.z = cvt_pk_bf16(r[4], r[5]); w.w = cvt_pk_bf16(r[6], r[7]);
                *(u32x4*)rowp = w; }
    }
};
struct EpiF32 {
    static constexpr bool PERM = false, HAS_MID = false;
    float* C; int ldc;
    __device__ __forceinline__ void mid(f32x4 (&)[2][2][4][2], const Unit&, int, int, int, int, int) const {}
    __device__ __forceinline__ void operator()(const f32x4 (&acc)[2][2][4][2], const Unit& u, int wr, int wc, int fr, int fq) const {
        const int row0 = u.pm * BM + wr * 64 + fr, col0 = u.pn * BM + wc * 32 + 4 * fq;
#pragma unroll
        for (int ai = 0; ai < 2; ++ai)
#pragma unroll
            for (int m = 0; m < 4; ++m) { float* rowp = C + (size_t)(row0 + ai * HALF + m * 16) * ldc + col0;
#pragma unroll
                for (int bj = 0; bj < 2; ++bj)
#pragma unroll
                    for (int n = 0; n < 2; ++n) *(f32x4*)(rowp + bj * HALF + n * 16) = acc[ai][bj][m][n]; }
    }
};
struct EpiMerge {
    static constexpr bool PERM = false, HAS_MID = true;
    const bf16_t* Z; bf16_t* O;
    __device__ __forceinline__ static float ez(bf16_t zb) { float z = bf2f(zb); z = fminf(fmaxf(z, -30.f), 30.f); return __expf(-z); }
    __device__ __forceinline__ void mid(f32x4 (&acc)[2][2][4][2], const Unit& u, int t, int wr, int wc, int fr, int fq) const {
        if (t != 8 && t != 16) return;
        const int gi = (t >> 3);
        const int row0 = u.pm * BM + wr * 64 + fr, col0 = u.pn * BM + wc * 32 + 4 * fq;
#pragma unroll
        for (int ai = 0; ai < 2; ++ai)
#pragma unroll
            for (int m = 0; m < 4; ++m) { const bf16_t* zr = Z + (size_t)(row0 + ai * HALF + m * 16) * ZW + ZC_GATE + col0;
#pragma unroll
                for (int bj = 0; bj < 2; ++bj)
#pragma unroll
                    for (int n = 0; n < 2; ++n) { const unsigned short* p0 = zr + (gi - 1) * 1024 + bj * HALF + n * 16; const unsigned short* p1 = zr + gi * 1024 + bj * HALF + n * 16;
                        const u32x2 a = *(const u32x2*)p0, b = *(const u32x2*)p1;
                        const bf16_t za[4] = {(bf16_t)(a.x & 0xffff), (bf16_t)(a.x >> 16), (bf16_t)(a.y & 0xffff), (bf16_t)(a.y >> 16)};
                        const bf16_t zb[4] = {(bf16_t)(b.x & 0xffff), (bf16_t)(b.x >> 16), (bf16_t)(b.y & 0xffff), (bf16_t)(b.y >> 16)};
#pragma unroll
                        for (int j = 0; j < 4; ++j) acc[ai][bj][m][n][j] *= (1.f + ez(zb[j])) * __builtin_amdgcn_rcpf(1.f + ez(za[j])); }
                asm volatile("" ::: "memory"); }
    }
    __device__ __forceinline__ void operator()(const f32x4 (&acc)[2][2][4][2], const Unit& u, int wr, int wc, int fr, int fq) const {
        const int row0 = u.pm * BM + wr * 64 + fr, col0 = u.pn * BM + wc * 32 + 4 * fq;
#pragma unroll
        for (int ai = 0; ai < 2; ++ai)
#pragma unroll
            for (int m = 0; m < 4; ++m) { const size_t r = (size_t)(row0 + ai * HALF + m * 16); const bf16_t* zr = Z + r * ZW + ZC_GATE + 2048 + col0; bf16_t* orow = O + r * 1024 + col0;
#pragma unroll
                for (int bj = 0; bj < 2; ++bj)
#pragma unroll
                    for (int n = 0; n < 2; ++n) { const u32x2 b = *(const u32x2*)(zr + bj * HALF + n * 16);
                        const bf16_t zb[4] = {(bf16_t)(b.x & 0xffff), (bf16_t)(b.x >> 16), (bf16_t)(b.y & 0xffff), (bf16_t)(b.y >> 16)};
                        float v[4];
#pragma unroll
                        for (int j = 0; j < 4; ++j) v[j] = acc[ai][bj][m][n][j] * __builtin_amdgcn_rcpf(1.f + ez(zb[j]));
                        u32x2 w; w.x = cvt_pk_bf16(v[0], v[1]); w.y = cvt_pk_bf16(v[2], v[3]); *(u32x2*)(orow + bj * HALF + n * 16) = w; }
                asm volatile("" ::: "memory"); }
    }
};

template <class Epi, class Sched>
__device__ __forceinline__ void gemm_phase(LAS unsigned char* lds, const int K, const Sched& S, const Epi& E) {
    int tid_ = threadIdx.x; asm volatile("" : "+v"(tid_));
    const int tid = tid_, wid = __builtin_amdgcn_readfirstlane(tid >> 6), lane = tid & 63, wr = wid >> 2, wc = wid & 3, fr = lane & 15, fq = lane >> 4;
    const int nt = K / BK;
    unsigned voffA[2], voffB[2];
#pragma unroll
    for (int i = 0; i < 2; ++i) { int R, C; stage_rc(tid * 16 + i * 8192, R, C); const int Rb = Epi::PERM ? ((R & ~31) + perm32(R & 31)) : R;
        voffA[i] = (unsigned)(R * K + C) * 2u; voffB[i] = (unsigned)(Rb * K + C) * 2u; }
    const size_t kstep = (size_t)(BK * 2);
    const size_t hstep = (size_t)HALF * K * 2;
    const unsigned ldsw = (unsigned)wid * 1024u;
    const int aoff = lds_byte(wr * 64 + fr, fq * 8), boff = lds_byte(wc * 32 + fr, fq * 8);
#define PG8_SA(b, h) (((b) * 2 + (h)) * HTB)
#define PG8_SB(b, h) ((4 + (b) * 2 + (h)) * HTB)
#define PG8_STAGE(bufoff, gbase, voff) do { _Pragma("unroll") for (int _i = 0; _i < 2; ++_i) \
        __builtin_amdgcn_global_load_lds((const unsigned*)((const char*)(gbase) + (voff)[_i]), (LAS unsigned*)(lds + (bufoff) + ldsw + _i * 8192), 16, 0, 0); } while (0)
#define PG8_LDA(dst, b, h) do { _Pragma("unroll") for (int m = 0; m < 4; ++m) _Pragma("unroll") for (int k = 0; k < 2; ++k) dst[m][k] = *(const LAS bf16x8*)(lds + PG8_SA(b, h) + aoff + m * 2048 + k * 1024); } while (0)
#define PG8_LDB(dst, b, h) do { _Pragma("unroll") for (int n = 0; n < 2; ++n) _Pragma("unroll") for (int k = 0; k < 2; ++k) dst[n][k] = *(const LAS bf16x8*)(lds + PG8_SB(b, h) + boff + n * 2048 + k * 1024); } while (0)
#define PG8_MMA(ai, bj, At, Bt) do { __builtin_amdgcn_s_setprio(1); _Pragma("unroll") for (int m = 0; m < 4; ++m) _Pragma("unroll") for (int n = 0; n < 2; ++n) _Pragma("unroll") for (int k = 0; k < 2; ++k) \
        acc[ai][bj][m][n] = __builtin_amdgcn_mfma_f32_16x16x32_bf16(Bt[n][k], At[m][k], acc[ai][bj][m][n], 0, 0, 0); __builtin_amdgcn_s_setprio(0); } while (0)
#define PG8_WAIT_V(n) asm volatile("s_waitcnt vmcnt(" #n ")" ::: "memory")
#define PG8_WAIT_L(n) asm volatile("s_waitcnt lgkmcnt(" #n ")" ::: "memory")
#define PG8_BAR __builtin_amdgcn_s_barrier()
#define PG8_SCHED __builtin_amdgcn_sched_barrier(0)
    Unit cur, nxt; int ui = 0;
    if (!S.next(0, cur)) return;
    f32x4 acc[2][2][4][2];
#pragma unroll
    for (int a = 0; a < 2; ++a)
#pragma unroll
        for (int b = 0; b < 2; ++b)
#pragma unroll
            for (int m = 0; m < 4; ++m)
#pragma unroll
                for (int n = 0; n < 2; ++n) acc[a][b][m][n] = (f32x4){0.f, 0.f, 0.f, 0.f};
    bf16x8 At[4][2], B0[2][2], B1[2][2];
    const char* cA = cur.a; const char* cB = cur.b;
    PG8_STAGE(PG8_SB(0, 0), cB, voffB); PG8_STAGE(PG8_SA(0, 0), cA, voffA); PG8_STAGE(PG8_SB(0, 1), cB + hstep, voffB); PG8_STAGE(PG8_SA(0, 1), cA + hstep, voffA);
    if (wr == 1) PG8_BAR;
    PG8_WAIT_V(4); PG8_BAR;
    PG8_STAGE(PG8_SB(1, 0), cB + kstep, voffB); PG8_STAGE(PG8_SA(1, 0), cA + kstep, voffA); PG8_STAGE(PG8_SB(1, 1), cB + hstep + kstep, voffB);
    PG8_WAIT_V(6); PG8_BAR;
    for (;;) {
        const bool has_next = S.next(ui + 1, nxt);
        const char* nA = has_next ? nxt.a : cA; const char* nB = has_next ? nxt.b : cB;
        for (int t = 0; t < nt; t += 2) {
            const bool last = (t == nt - 2);
            const char* a1 = cA + (size_t)(t + 1) * kstep;
            const char* a2 = last ? nA : cA + (size_t)(t + 2) * kstep; const char* b2 = last ? nB : cB + (size_t)(t + 2) * kstep;
            const char* a3 = a2 + kstep; const char* b3 = b2 + kstep;
            if constexpr (Epi::HAS_MID) E.mid(acc, cur, t, wr, wc, fr, fq);
            PG8_LDB(B0, 0, 0); PG8_SCHED; PG8_LDA(At, 0, 0); PG8_STAGE(PG8_SA(1, 1), a1 + hstep, voffA);
            PG8_WAIT_L(8); PG8_BAR; PG8_WAIT_L(0); PG8_MMA(0, 0, At, B0); PG8_BAR; PG8_SCHED;
            PG8_LDB(B1, 0, 1); PG8_STAGE(PG8_SB(0, 0), b2, voffB);
            PG8_BAR; PG8_WAIT_L(0); PG8_MMA(0, 1, At, B1); PG8_BAR;
            PG8_LDA(At, 0, 1); PG8_STAGE(PG8_SA(0, 0), a2, voffA);
            PG8_BAR; PG8_WAIT_L(0); PG8_MMA(1, 0, At, B0); PG8_BAR; PG8_SCHED;
            PG8_STAGE(PG8_SB(0, 1), b2 + hstep, voffB);
            PG8_WAIT_V(6); PG8_BAR; PG8_MMA(1, 1, At, B1); PG8_BAR;
            PG8_LDB(B0, 1, 0); PG8_SCHED; PG8_LDA(At, 1, 0); PG8_STAGE(PG8_SA(0, 1), a2 + hstep, voffA);
            PG8_WAIT_L(8); PG8_BAR; PG8_WAIT_L(0); PG8_MMA(0, 0, At, B0); PG8_BAR; PG8_SCHED;
            PG8_LDB(B1, 1, 1); PG8_STAGE(PG8_SB(1, 0), b3, voffB);
            PG8_BAR; PG8_WAIT_L(0); PG8_MMA(0, 1, At, B1); PG8_BAR;
            PG8_LDA(At, 1, 1); PG8_STAGE(PG8_SA(1, 0), a3, voffA);
            PG8_BAR; PG8_WAIT_L(0); PG8_MMA(1, 0, At, B0); PG8_BAR; PG8_SCHED;
            PG8_STAGE(PG8_SB(1, 1), b3 + hstep, voffB);
            PG8_WAIT_V(6); PG8_BAR; PG8_MMA(1, 1, At, B1); PG8_BAR;
        }
        E(acc, cur, wr, wc, fr, fq);
        if (!has_next) break;
#pragma unroll
        for (int a = 0; a < 2; ++a)
#pragma unroll
            for (int b = 0; b < 2; ++b)
#pragma unroll
                for (int m = 0; m < 4; ++m)
#pragma unroll
                    for (int n = 0; n < 2; ++n) acc[a][b][m][n] = (f32x4){0.f, 0.f, 0.f, 0.f};
        cur = nxt; cA = nA; cB = nB; ++ui;
    }
    PG8_WAIT_V(0);
    if (wr == 0) PG8_BAR;
    PG8_BAR;
#undef PG8_SA
#undef PG8_SB
#undef PG8_STAGE
#undef PG8_LDA
#undef PG8_LDB
#undef PG8_MMA
#undef PG8_WAIT_V
#undef PG8_WAIT_L
#undef PG8_BAR
#undef PG8_SCHED
}
}

constexpr int NWAVES = 8, NTHREADS = NWAVES * 64;
constexpr int LDS_BYTES = pg8::STAGE_BYTES + 64;
struct Frame {
    LAS unsigned char* lds;
    int tid, lane, wave, G, bid;
    const Args* a;
    unsigned char* ws;
};
__device__ __forceinline__ const float* lp_(const float* p) { asm volatile("" : "+s"(p)); return p; }
#define INP(i) lp_(F.a->in[i])
#define LAUNDER(F) asm volatile("" : "+v"((F).lane), "+v"((F).tid))

__device__ __forceinline__ void conv_item(const Job& J, int local, LAS float* scr, int lane) {
    const int nkb = (J.K + 63) / 64, nnb = (J.ncols + 31) / 32, per = nkb * nnb;
    const int bi = local / per, rem = local % per, kb = rem / nnb, nb = rem % nnb, k0 = 64 * kb, n0 = 32 * nb;
    const float* W = J.src + (size_t)bi * J.src_bs; bf16_t* WT = J.dst + (size_t)bi * J.dst_bs;
    const int cl = n0 + (lane & 31); const bool okc = cl < J.ncols;
#pragma unroll 8
    for (int i = 0; i < 32; ++i) { const int kk = 2 * i + (lane >> 5); scr[kk * 33 + (lane & 31)] = (okc && k0 + kk < J.K) ? W[(size_t)(k0 + kk) * J.ld_src + J.col0 + cl] : 0.f; }
    asm volatile("s_waitcnt lgkmcnt(0)" ::: "memory");
    const int c = lane & 7;
#pragma unroll
    for (int j = 0; j < 4; ++j) { const int n = (lane >> 3) + 8 * j; const LAS float* s = scr + (8 * c) * 33 + n; const int cc = n0 + n;
        if (cc < J.ncols && k0 + 8 * c < J.K) { const int drow = J.r0 + (J.mode ? ((cc >> 7) * 256 + (cc & 127)) : cc);
            u32x4 o; o.x = pk2(s[0 * 33], s[1 * 33]); o.y = pk2(s[2 * 33], s[3 * 33]); o.z = pk2(s[4 * 33], s[5 * 33]); o.w = pk2(s[6 * 33], s[7 * 33]);
            *(u32x4*)(WT + (size_t)drow * J.ld_dst + k0 + 8 * c) = o; } }
    asm volatile("s_waitcnt lgkmcnt(0)" ::: "memory");
}
__device__ __forceinline__ void phase_convert(Frame& F, int j0, int j1, int it0, int nitems) {
    LAUNDER(F);
    LAS float* scr = (LAS float*)(F.lds + F.wave * 8704);
    const int gw = F.bid * NWAVES + F.wave, NGW = F.G * NWAVES;
    for (int it = it0 + gw; it < nitems; it += NGW) {
        int j = j0;
        while (j + 1 < j1 && it >= F.a->jobs[j + 1].item0) ++j;
        conv_item(F.a->jobs[j], it - F.a->jobs[j].item0, scr, F.lane);
    }
}

__device__ __forceinline__ void phase_mod(Frame& F) {
    LAUNDER(F);
    float* mod = (float*)(F.ws + WS_MOD);
    LAS float* red = (LAS float*)(F.lds + 72 * 1024);
    const float* cvec = INP(I_C);
    for (int item = F.bid; item < 2 * 96; item += F.G) {
        const int l = item / 96, n0 = (item % 96) * 64;
        const float* W = INP(I_ADA_W) + (size_t)l * 1024 * 6144 + n0 + F.lane;
        float a0 = 0.f, a1 = 0.f;
        const int kbeg = F.wave * 128;
#pragma unroll 8
        for (int k = kbeg; k < kbeg + 128; ++k) { const float w = W[(size_t)k * 6144]; a0 += siluf_(cvec[k]) * w; a1 += siluf_(cvec[1024 + k]) * w; }
        red[(F.wave * 2 + 0) * 64 + F.lane] = a0; red[(F.wave * 2 + 1) * 64 + F.lane] = a1;
        __syncthreads();
        if (F.tid < 128) { const int b = F.tid >> 6, ln = F.tid & 63; float s = 0.f;
#pragma unroll
            for (int w = 0; w < 8; ++w) s += red[(w * 2 + b) * 64 + ln];
            mod[(size_t)(l * 2 + b) * 6144 + n0 + ln] = s + INP(I_ADA_B)[l * 6144 + n0 + ln]; }
        __syncthreads();
    }
}

__device__ __forceinline__ void phase_ln(Frame& F, int kind, const float* lg, const float* lb, int gt_layer, int gt_off, int h_layer, int sh_off, int sc_off, bool route, bool last) {
    LAUNDER(F);
    const float* mod = (const float*)(F.ws + WS_MOD);
    float* X = F.a->out;
    const float* YF = (const float*)(F.ws + WS_YF);
    bf16_t* H = (bf16_t*)(F.ws + WS_H);
    const int gw = F.bid * NWAVES + F.wave, NGW = F.G * NWAVES;
    for (int row = gw; row < NTOK; row += NGW) {
        const int b = row / SEQ;
        f32x4 v[4];
        if (kind == 0) {
            const f32x4* xr = (const f32x4*)(INP(I_X) + (size_t)row * D) + F.lane;
#pragma unroll
            for (int j = 0; j < 4; ++j) v[j] = xr[64 * j];
        } else {
            const f32x4* xr = (const f32x4*)(X + (size_t)row * D) + F.lane;
            const f32x4* gt = (const f32x4*)(mod + (size_t)(gt_layer * 2 + b) * 6144 + gt_off) + F.lane;
            if (kind == 1) {
                const f32x4* yr = (const f32x4*)(YF + (size_t)row * D) + F.lane;
#pragma unroll
                for (int j = 0; j < 4; ++j) v[j] = DN_ALPHA * xr[64 * j] + (1.f + gt[64 * j]) * yr[64 * j];
            } else {
                const int2 rr = ((const int2*)(F.ws + WS_TOPP))[row];
                const float2 gg = ((const float2*)(F.ws + WS_TOPG))[row];
                const bf16_t* ym = (const bf16_t*)(F.ws + WS_MY);
                const u32x2* y0 = (const u32x2*)(ym + (size_t)rr.x * D) + F.lane; const u32x2* y1 = (const u32x2*)(ym + (size_t)rr.y * D) + F.lane;
#pragma unroll
                for (int j = 0; j < 4; ++j) { const u32x2 p = y0[64 * j], q = y1[64 * j];
                    f32x4 y; y[0] = gg.x * __uint_as_float(p.x << 16) + gg.y * __uint_as_float(q.x << 16); y[1] = gg.x * __uint_as_float(p.x & 0xffff0000u) + gg.y * __uint_as_float(q.x & 0xffff0000u);
                    y[2] = gg.x * __uint_as_float(p.y << 16) + gg.y * __uint_as_float(q.y << 16); y[3] = gg.x * __uint_as_float(p.y & 0xffff0000u) + gg.y * __uint_as_float(q.y & 0xffff0000u);
                    v[j] = DN_ALPHA * xr[64 * j] + (1.f + gt[64 * j]) * y; }
            }
        }
        float s = 0.f;
#pragma unroll
        for (int j = 0; j < 4; ++j) s += (v[j][0] + v[j][1]) + (v[j][2] + v[j][3]);
        const float mean = wave_sum(s) * (1.f / D); float s2 = 0.f;
#pragma unroll
        for (int j = 0; j < 4; ++j) { v[j] = v[j] - mean; s2 += (v[j][0] * v[j][0] + v[j][1] * v[j][1]) + (v[j][2] * v[j][2] + v[j][3] * v[j][3]); }
        const float rstd = 1.f / sqrtf(wave_sum(s2) * (1.f / D) + LN_EPS);
        const f32x4* g4 = (const f32x4*)lg + F.lane; const f32x4* b4 = (const f32x4*)lb + F.lane;
        f32x4* xo = (f32x4*)(X + (size_t)row * D) + F.lane;
#pragma unroll
        for (int j = 0; j < 4; ++j) { v[j] = v[j] * rstd * g4[64 * j] + b4[64 * j]; xo[64 * j] = v[j]; }
        if (!last) {
            const f32x4* sh = (const f32x4*)(mod + (size_t)(h_layer * 2 + b) * 6144 + sh_off) + F.lane; const f32x4* sc = (const f32x4*)(mod + (size_t)(h_layer * 2 + b) * 6144 + sc_off) + F.lane;
            u32x2* ho = (u32x2*)(H + (size_t)row * D) + F.lane;
#pragma unroll
            for (int j = 0; j < 4; ++j) { v[j] = v[j] * (1.f + sc[64 * j]) + sh[64 * j]; u32x2 w; w.x = pk2(v[j][0], v[j][1]); w.y = pk2(v[j][2], v[j][3]); ho[64 * j] = w; }
            if (route) {
                const float* rw = INP(I_MOE_R); float lg8[8];
#pragma unroll
                for (int e = 0; e < 8; ++e) lg8[e] = 0.f;
#pragma unroll
                for (int j = 0; j < 4; ++j)
#pragma unroll
                    for (int q = 0; q < 4; ++q) { const int c = 4 * F.lane + 256 * j + q; const f32x4 w0 = *(const f32x4*)(rw + c * 8), w1 = *(const f32x4*)(rw + c * 8 + 4); const float hv = v[j][q];
                        lg8[0] += hv * w0[0]; lg8[1] += hv * w0[1]; lg8[2] += hv * w0[2]; lg8[3] += hv * w0[3]; lg8[4] += hv * w1[0]; lg8[5] += hv * w1[1]; lg8[6] += hv * w1[2]; lg8[7] += hv * w1[3]; asm volatile("" ::: "memory"); }
#pragma unroll
                for (int e = 0; e < 8; ++e) lg8[e] = wave_sum(lg8[e]) + INP(I_MOE_RB)[e];
                int e0 = 0; float l0 = lg8[0];
#pragma unroll
                for (int e = 1; e < 8; ++e) if (lg8[e] > l0) { l0 = lg8[e]; e0 = e; }
                int e1 = -1; float l1 = -3.0e38f;
#pragma unroll
                for (int e = 0; e < 8; ++e) if (e != e0 && lg8[e] > l1) { l1 = lg8[e]; e1 = e; }
                if (F.lane == 0) {
                    const float g0 = 1.f / (1.f + __expf(l1 - l0));
                    unsigned* cnt = (unsigned*)(F.ws + WS_CTL) + CW_CNT;
                    const int p0 = (int)atomicAdd(cnt + e0, 1u), p1 = (int)atomicAdd(cnt + e1, 1u);
                    ((int2*)(F.ws + WS_TOPE))[row] = make_int2(e0, e1); ((float2*)(F.ws + WS_TOPG))[row] = make_float2(g0, 1.f - g0); ((int2*)(F.ws + WS_TOPP))[row] = make_int2(p0, p1);
                }
            }
        }
    }
}

constexpr size_t WS_TEXP = 640 * 1024;
__device__ __forceinline__ void phase_moe_setup(Frame& F) {
    LAUNDER(F);
    const unsigned* cnt = (const unsigned*)(F.ws + WS_CTL) + CW_CNT;
    int pstart[8]; int tot = 0;
#pragma unroll
    for (int e = 0; e < 8; ++e) { pstart[e] = tot; tot += ((int)cnt[e] + 255) / 256 * 256; }
    int* texp = (int*)(F.ws + WS_TEXP);
    if (F.bid == 0 && F.tid < MOE_RT_MAX + 1) {
        if (F.tid == MOE_RT_MAX) texp[MOE_RT_MAX] = tot / 256;
        else { int e = 0;
#pragma unroll
            for (int q = 1; q < 8; ++q) if (F.tid * 256 >= pstart[q]) e = q;
            texp[F.tid] = e; }
    }
    const bf16_t* H = (const bf16_t*)(F.ws + WS_H); bf16_t* MA = (bf16_t*)(F.ws + WS_MA);
    const int gw = F.bid * NWAVES + F.wave, NGW = F.G * NWAVES;
    for (int row = gw; row < NTOK; row += NGW) {
        const int2 ee = ((const int2*)(F.ws + WS_TOPE))[row]; int2 pp = ((const int2*)(F.ws + WS_TOPP))[row];
        int r0 = pp.x, r1 = pp.y;
#pragma unroll
        for (int e = 0; e < 8; ++e) { if (ee.x == e) r0 += pstart[e]; if (ee.y == e) r1 += pstart[e]; }
        const u32x4* src = (const u32x4*)(H + (size_t)row * D) + F.lane;
        const u32x4 a = src[0], b = src[64];
        u32x4* d0 = (u32x4*)(MA + (size_t)r0 * D) + F.lane; u32x4* d1 = (u32x4*)(MA + (size_t)r1 * D) + F.lane;
        d0[0] = a; d0[64] = b; d1[0] = a; d1[64] = b;
        if (F.lane == 0) ((int2*)(F.ws + WS_TOPP))[row] = make_int2(r0, r1);
    }
}

__device__ __forceinline__ float capf_(float t) { return 15.f * tanhf(t * (1.f / 15.f)); }
__device__ __forceinline__ const LAS bf16x8* vec8_ptr(const LAS bf16_t*) { return nullptr; }
__device__ __forceinline__ const LAS bf16x8* vec8_ptr(LAS bf16_t*) { return nullptr; }
__device__ __forceinline__ const bf16x8* vec8_ptr(const bf16_t*) { return nullptr; }
template <int K, class PA, class PB> __device__ __forceinline__ f32x4 mma_tile(PA A, int lda, PB Bt, int ldb, int m0, int n0, f32x4 acc, int lane) {
    const int r = lane & 15, q = lane >> 4;
#pragma unroll
    for (int k0 = 0; k0 < K; k0 += 32) {
        const bf16x8 a = *(decltype(vec8_ptr(A)))(A + (m0 + r) * lda + k0 + 8 * q);
        const bf16x8 b = *(decltype(vec8_ptr(Bt)))(Bt + (n0 + r) * ldb + k0 + 8 * q);
        acc = __builtin_amdgcn_mfma_f32_16x16x32_bf16(a, b, acc, 0, 0, 0);
    }
    return acc;
}
__device__ __forceinline__ u32x2 pack4(f32x4 v) { u32x2 w; w.x = pk2(v[0], v[1]); w.y = pk2(v[2], v[3]); return w; }
__device__ __forceinline__ f32x4 unpack4(u32x2 w) { f32x4 v; v[0] = __uint_as_float(w.x << 16); v[1] = __uint_as_float(w.x & 0xffff0000u); v[2] = __uint_as_float(w.y << 16); v[3] = __uint_as_float(w.y & 0xffff0000u); return v; }
__device__ __forceinline__ float wave_incl_scan(float x, int lane) {
#pragma unroll
    for (int o = 1; o < 64; o <<= 1) { const float y = __shfl_up(x, o); if (lane >= o) x += y; }
    return x;
}

constexpr size_t WS_MLB = WS_S + 97 * MB;
constexpr size_t WS_MLT = WS_S + 113 * MB;
constexpr size_t WS_MLN = WS_S + 114 * MB;
__device__ __forceinline__ void ml_gates(Frame& F, int l, int h, int row0, LAS float* bc, LAS float* li) {
    if (F.wave == 0) {
        const bf16_t* Z = (const bf16_t*)(F.ws + WS_Z) + (size_t)(row0 + F.lane) * ZW;
        const float ip = bf2f(Z[ZC_MI + h]) + INP(I_ML_BI)[l * 4 + h], fp = bf2f(Z[ZC_MF + h]) + INP(I_ML_BF)[l * 4 + h];
        const float lf = -softplusf_(-capf_(fp));
        bc[F.lane] = wave_incl_scan(lf, F.lane); li[F.lane] = capf_(ip);
    }
}
__device__ __forceinline__ void ml_sa_item(Frame& F, int l, int item) {
    const int bh = item >> 7, c = item & 127, b = bh >> 2, h = bh & 3, row0 = b * SEQ + c * 64;
    LAS float* bc = (LAS float*)F.lds; LAS float* li = bc + 64;
    LAS bf16_t* KwT = (LAS bf16_t*)(F.lds + 1024); LAS bf16_t* VT = (LAS bf16_t*)(F.lds + 10240);
    const bf16_t* Z = (const bf16_t*)(F.ws + WS_Z);
    ml_gates(F, l, h, row0, bc, li);
    __syncthreads();
    {
        const int t = F.tid & 63, u = F.tid >> 6; const bf16_t* zr = Z + (size_t)(row0 + t) * ZW;
        const float ew = __expf(bc[63] - bc[t] + li[t]) * 0.125f;
        const u32x4 kq = *(const u32x4*)(zr + ZC_MK + h * 64 + 8 * u);
        const unsigned kw[4] = {kq.x, kq.y, kq.z, kq.w};
#pragma unroll
        for (int j = 0; j < 4; ++j) { KwT[(8 * u + 2 * j) * 72 + t] = f2bf(__uint_as_float(kw[j] << 16) * ew); KwT[(8 * u + 2 * j + 1) * 72 + t] = f2bf(__uint_as_float(kw[j] & 0xffff0000u) * ew); }
#pragma unroll
        for (int p = 0; p < 2; ++p) { const u32x4 vq = *(const u32x4*)(zr + ZC_MV + h * 128 + 64 * p + 8 * u); const unsigned vw[4] = {vq.x, vq.y, vq.z, vq.w};
#pragma unroll
            for (int j = 0; j < 4; ++j) { VT[(64 * p + 8 * u + 2 * j) * 72 + t] = (bf16_t)(vw[j] & 0xffff); VT[(64 * p + 8 * u + 2 * j + 1) * 72 + t] = (bf16_t)(vw[j] >> 16); } }
    }
    __syncthreads();
    bf16_t* BT = (bf16_t*)(F.ws + WS_MLB) + (size_t)item * 128 * 64;
    {
        const int mt = F.wave & 3, q = F.lane >> 4, cl = F.lane & 15;
#pragma unroll
        for (int j = 0; j < 4; ++j) { const int nt = 4 * (F.wave >> 2) + j;
            const f32x4 acc = mma_tile<64>(KwT, 72, VT, 72, 16 * mt, 16 * nt, (f32x4){0.f, 0.f, 0.f, 0.f}, F.lane);
            *(u32x2*)(BT + (size_t)(16 * nt + cl) * 64 + 16 * mt + 4 * q) = pack4(acc); }
    }
    if (F.wave == 0) {
        float s = 0.f;
#pragma unroll
        for (int j = 0; j < 8; ++j) { const bf16x8 v8 = *(const LAS bf16x8*)(KwT + F.lane * 72 + 8 * j);
#pragma unroll
            for (int e = 0; e < 8; ++e) s += bf2f((bf16_t)v8[e]); }
        float* tb = (float*)(F.ws + WS_MLT) + (size_t)item * 66; tb[F.lane] = s; if (F.lane == 0) tb[64] = __expf(bc[63]);
    }
    __syncthreads();
}
__device__ __forceinline__ void ml_scan(Frame& F, int vblk, int nblk) {
    const float* tb = (const float*)(F.ws + WS_MLT);
    if (vblk >= 0) {
        const int bh = vblk >> 1, e0 = (vblk & 1) * 4096 + F.tid * 8;
        bf16_t* base = (bf16_t*)(F.ws + WS_MLB) + (size_t)bh * 128 * 8192 + e0;
        float C[8];
#pragma unroll
        for (int j = 0; j < 8; ++j) C[j] = 0.f;
#pragma unroll 4
        for (int c = 0; c < 128; ++c) {
            u32x4* p = (u32x4*)(base + (size_t)c * 8192); const u32x4 bv = *p; const float gl = tb[(size_t)(bh * 128 + c) * 66 + 64];
            u32x4 o; o.x = pk2(C[0], C[1]); o.y = pk2(C[2], C[3]); o.z = pk2(C[4], C[5]); o.w = pk2(C[6], C[7]); *p = o;
            const unsigned w[4] = {bv.x, bv.y, bv.z, bv.w};
#pragma unroll
            for (int j = 0; j < 4; ++j) { C[2 * j] = gl * C[2 * j] + __uint_as_float(w[j] << 16); C[2 * j + 1] = gl * C[2 * j + 1] + __uint_as_float(w[j] & 0xffff0000u); }
        }
    }
    if (nblk >= 0 && F.tid < 512) {
        const int bh = F.tid >> 6, k = F.tid & 63; float n = 0.f; float* N = (float*)(F.ws + WS_MLN);
        for (int c = 0; c < 128; ++c) { const size_t it = (size_t)(bh * 128 + c); N[it * 64 + k] = n; n = tb[it * 66 + 64] * n + tb[it * 66 + k]; }
    }
}
__device__ __forceinline__ void ml_sc_item(Frame& F, int l, int item) {
    const int bh = item >> 7, c = item & 127, b = bh >> 2, h = bh & 3, row0 = b * SEQ + c * 64;
    LAS float* bc = (LAS float*)F.lds; LAS float* li = bc + 64; LAS float* den = bc + 128; LAS float* nn = bc + 192; LAS float* ssq = bc + 256;
    LAS bf16_t* Qt = (LAS bf16_t*)(F.lds + 2048); LAS bf16_t* Qd = (LAS bf16_t*)(F.lds + 11264); LAS bf16_t* Kt = (LAS bf16_t*)(F.lds + 20480);
    LAS bf16_t* VT = (LAS bf16_t*)(F.lds + 29696); LAS bf16_t* CT = (LAS bf16_t*)(F.lds + 48128); LAS bf16_t* P = (LAS bf16_t*)(F.lds + 66560);
    const bf16_t* Z = (const bf16_t*)(F.ws + WS_Z);
    ml_gates(F, l, h, row0, bc, li);
    if (F.tid < 64) { den[F.tid] = 0.f; nn[F.tid] = ((const float*)(F.ws + WS_MLN))[(size_t)item * 64 + F.tid]; }
    __syncthreads();
    {
        const int t = F.tid & 63, u = F.tid >> 6; const bf16_t* zr = Z + (size_t)(row0 + t) * ZW; const float ed = __expf(bc[t]);
        const u32x4 qq = *(const u32x4*)(zr + ZC_MQ + h * 64 + 8 * u), kq = *(const u32x4*)(zr + ZC_MK + h * 64 + 8 * u);
        *(u32x4*)(Qt + t * 72 + 8 * u) = qq;
        const unsigned qw[4] = {qq.x, qq.y, qq.z, qq.w}, kw[4] = {kq.x, kq.y, kq.z, kq.w}; u32x4 qd, ks; unsigned* qdp = (unsigned*)&qd; unsigned* ksp = (unsigned*)&ks;
#pragma unroll
        for (int j = 0; j < 4; ++j) { qdp[j] = pk2(__uint_as_float(qw[j] << 16) * ed, __uint_as_float(qw[j] & 0xffff0000u) * ed); ksp[j] = pk2(__uint_as_float(kw[j] << 16) * 0.125f, __uint_as_float(kw[j] & 0xffff0000u) * 0.125f); }
        *(u32x4*)(Qd + t * 72 + 8 * u) = qd; *(u32x4*)(Kt + t * 72 + 8 * u) = ks;
#pragma unroll
        for (int p = 0; p < 2; ++p) { const u32x4 vq = *(const u32x4*)(zr + ZC_MV + h * 128 + 64 * p + 8 * u); const unsigned vw[4] = {vq.x, vq.y, vq.z, vq.w};
#pragma unroll
            for (int j = 0; j < 4; ++j) { VT[(64 * p + 8 * u + 2 * j) * 72 + t] = (bf16_t)(vw[j] & 0xffff); VT[(64 * p + 8 * u + 2 * j + 1) * 72 + t] = (bf16_t)(vw[j] >> 16); } }
        const bf16_t* ct = (const bf16_t*)(F.ws + WS_MLB) + (size_t)item * 128 * 64;
#pragma unroll
        for (int p = 0; p < 2; ++p) { const int e = F.tid + 512 * p, rr = e >> 3, cc = (e & 7) * 8; *(u32x4*)(CT + rr * 72 + cc) = *(const u32x4*)(ct + rr * 64 + cc); }
    }
    __syncthreads();
    {
        const int q = F.lane >> 4, cl = F.lane & 15;
#pragma unroll
        for (int j = 0; j < 2; ++j) { const int tile = F.wave * 2 + j, mt = tile & 3, nt = tile >> 2;
            f32x4 acc = mma_tile<64>(Kt, 72, Qt, 72, 16 * mt, 16 * nt, (f32x4){0.f, 0.f, 0.f, 0.f}, F.lane);
            const int t = 16 * nt + cl; const float bt = bc[t]; float part = 0.f;
#pragma unroll
            for (int r = 0; r < 4; ++r) { const int sidx = 16 * mt + 4 * q + r; const float v = (sidx <= t) ? acc[r] * __expf(bt - bc[sidx] + li[sidx]) : 0.f; const float vr = bf2f(f2bf(v)); acc[r] = vr; part += vr; }
            *(u32x2*)(P + t * 72 + 16 * mt + 4 * q) = pack4(acc);
            part += __shfl_xor(part, 16); part += __shfl_xor(part, 32);
            if (q == 0) atomicAdd((float*)(den + t), part);
        }
    }
    __syncthreads();
    if (F.tid < 64) {
        float d = 0.f;
#pragma unroll
        for (int j = 0; j < 8; ++j) { const bf16x8 v8 = *(const LAS bf16x8*)(Qd + F.tid * 72 + 8 * j);
#pragma unroll
            for (int e = 0; e < 8; ++e) d += bf2f((bf16_t)v8[e]) * nn[8 * j + e]; }
        den[F.tid] += d;
    }
    const int nt = F.wave >> 1, q = F.lane >> 4, cl = F.lane & 15, t = 16 * nt + cl;
    f32x4 acc[4];
#pragma unroll
    for (int j = 0; j < 4; ++j) { const int mt = 4 * (F.wave & 1) + j;
        acc[j] = mma_tile<64>(CT, 72, Qd, 72, 16 * mt, 16 * nt, (f32x4){0.f, 0.f, 0.f, 0.f}, F.lane);
        acc[j] = mma_tile<64>(VT, 72, P, 72, 16 * mt, 16 * nt, acc[j], F.lane); }
    __syncthreads();
    {
        const float dinv = 1.f / fmaxf(fabsf(den[t]), 1.f); float sq = 0.f;
#pragma unroll
        for (int j = 0; j < 4; ++j) { acc[j] = acc[j] * dinv; sq += (acc[j][0] * acc[j][0] + acc[j][1] * acc[j][1]) + (acc[j][2] * acc[j][2] + acc[j][3] * acc[j][3]); }
        sq += __shfl_xor(sq, 16); sq += __shfl_xor(sq, 32);
        if (q == 0) ssq[t * 2 + (F.wave & 1)] = sq;
    }
    __syncthreads();
    {
        const float rms = rsqrtf((ssq[t * 2] + ssq[t * 2 + 1]) * (1.f / 128.f) + 1e-6f);
        const float* ng = INP(I_ML_NG) + l * 512 + h * 128; bf16_t* Y = (bf16_t*)(F.ws + WS_Y) + (size_t)(row0 + t) * 1536 + 512 + h * 128; const bf16_t* zo = Z + (size_t)(row0 + t) * ZW + ZC_MO + h * 128;
#pragma unroll
        for (int j = 0; j < 4; ++j) { const int v0 = 16 * (4 * (F.wave & 1) + j) + 4 * q; const f32x4 g4 = *(const f32x4*)(ng + v0); const f32x4 o4 = unpack4(*(const u32x2*)(zo + v0));
            f32x4 y;
#pragma unroll
            for (int r = 0; r < 4; ++r) y[r] = acc[j][r] * rms * g4[r] * sigmoidf_(o4[r]);
            *(u32x2*)(Y + v0) = pack4(y); }
    }
    __syncthreads();
}
__device__ __forceinline__ void phase_ml_sa(Frame& F, int l) { LAUNDER(F); for (int item = F.bid; item < 1024; item += F.G) ml_sa_item(F, l, item); }
__device__ __forceinline__ void phase_ml_sb(Frame& F) { LAUNDER(F); if (F.bid < 16) ml_scan(F, F.bid, -1); else if (F.bid == 16) ml_scan(F, -1, 0); }
__device__ __forceinline__ void phase_ml_sc(Frame& F, int l) { LAUNDER(F); for (int item = F.bid; item < 1024; item += F.G) ml_sc_item(F, l, item); }


constexpr size_t WS_RWM = WS_S0;
constexpr size_t WS_RWS = WS_S0 + 16 * MB;
constexpr size_t WS_RWR = WS_S0 + 32 * MB;
constexpr size_t WS_RWY = WS_S0 + 48 * MB;
constexpr size_t WS_RWG = WS_S0 + 64 * MB;
constexpr size_t WS_RWB = WS_S0 + 64 * MB + 512 * 1024;
__device__ __forceinline__ void tri_inv_inplace(LAS float* N, int ld, int lane) {
    for (int B = 0; B < 4; ++B) {
        float acc[16];
#pragma unroll
        for (int r = 0; r < 16; ++r) acc[r] = (16 * B + r == lane) ? 1.f : 0.f;
        for (int Jc = 0; Jc < B; ++Jc) {
            float tj[16];
#pragma unroll
            for (int e = 0; e < 16; ++e) tj[e] = N[(16 * Jc + e) * ld + lane];
#pragma unroll
            for (int r = 0; r < 16; ++r) {
#pragma unroll
                for (int e4 = 0; e4 < 4; ++e4) { const f32x4 n4 = *(const LAS f32x4*)(N + (16 * B + r) * ld + 16 * Jc + 4 * e4);
                    acc[r] += (n4[0] * tj[4 * e4] + n4[1] * tj[4 * e4 + 1]) + (n4[2] * tj[4 * e4 + 2] + n4[3] * tj[4 * e4 + 3]); } }
        }
        float tb[16];
#pragma unroll
        for (int r = 0; r < 16; ++r) { float a = acc[r];
#pragma unroll
            for (int e = 0; e < r; ++e) a += N[(16 * B + r) * ld + 16 * B + e] * tb[e];
            tb[r] = a; }
        asm volatile("" ::: "memory");
#pragma unroll
        for (int r = 0; r < 16; ++r) N[(16 * B + r) * ld + lane] = tb[r];
        asm volatile("" ::: "memory");
    }
}
__device__ __forceinline__ float zsh(const bf16_t* zr, int t, int col, float mu) { const float cur = bf2f(zr[col]); const float prev = t > 0 ? bf2f(zr[col - ZW]) : 0.f; return cur + mu * (prev - cur); }

__device__ __forceinline__ void rw_sa_item(Frame& F, int l, int item) {
    const int bh = item >> 7, c = item & 127, b = bh >> 3, h = bh & 7, row0 = b * SEQ + c * 64, tq0 = c * 64;
    LAS bf16_t* RAW = (LAS bf16_t*)F.lds; LAS bf16_t* XW = (LAS bf16_t*)(F.lds + 24960); LAS bf16_t* XA = (LAS bf16_t*)(F.lds + 34176); LAS bf16_t* XV = (LAS bf16_t*)(F.lds + 43392);
    LAS float* KKP = (LAS float*)(F.lds + 48640); LAS float* BPP = (LAS float*)(F.lds + 49664); LAS float* HT = (LAS float*)(F.lds + 50688);
    LAS float* AF = (LAS float*)F.lds; LAS bf16_t* LAK = (LAS bf16_t*)(F.lds + 17408); LAS bf16_t* QRB = (LAS bf16_t*)(F.lds + 26624); LAS bf16_t* QRK = (LAS bf16_t*)(F.lds + 35840); LAS bf16_t* TT = (LAS bf16_t*)(F.lds + 45056);
    LAS bf16_t* ALB = (LAS bf16_t*)(F.lds + 54272); LAS bf16_t* BEH = ALB + 4608; LAS bf16_t* KH = BEH + 4608; LAS bf16_t* RB = KH + 4608; LAS bf16_t* ALBT = RB + 4608; LAS bf16_t* VT = ALBT + 4608; LAS bf16_t* BEET = VT + 4608; LAS bf16_t* KET = BEET + 4608;
    LAS bf16_t* XT = ALB; LAS bf16_t* WUT = BEH; LAS bf16_t* U0T = KH;
    const bf16_t* Z = (const bf16_t*)(F.ws + WS_Z);
    const float* mu = INP(I_RW_MU) + l * 1792;
    const bf16_t* lorat = (const bf16_t*)(F.ws + WS_LORAT) + (size_t)l * LORAT_LAYER;
    const int q = F.lane >> 4, cl = F.lane & 15;
    for (int e = F.tid; e < 65 * 24; e += NTHREADS) { const int rr = e / 24, pc = e % 24, g = pc >> 3, cc = (pc & 7) * 8;
        u32x4 v = (u32x4){0u, 0u, 0u, 0u};
        if (rr > 0 || tq0 > 0) v = *(const u32x4*)(Z + (size_t)(row0 + rr - 1) * ZW + (g == 0 ? ZC_RR : (g == 1 ? ZC_RK : ZC_RV)) + h * 64 + cc);
        *(u32x4*)(RAW + rr * 192 + g * 64 + cc) = v; }
    {
        const int t = F.tid & 63, u = F.tid >> 6; const bf16_t* zr = Z + (size_t)(row0 + t) * ZW; const int tt = tq0 + t;
        u32x4 w; unsigned* wp = (unsigned*)&w;
#pragma unroll
        for (int j = 0; j < 4; ++j) wp[j] = pk2(tanhf(zsh(zr, tt, ZC_RW + 8 * u + 2 * j, mu[1536 + 8 * u + 2 * j])), tanhf(zsh(zr, tt, ZC_RW + 8 * u + 2 * j + 1, mu[1536 + 8 * u + 2 * j + 1])));
        *(u32x4*)(XW + t * 72 + 8 * u) = w;
#pragma unroll
        for (int j = 0; j < 4; ++j) wp[j] = pk2(zsh(zr, tt, ZC_RA + 8 * u + 2 * j, mu[1600 + 8 * u + 2 * j]), zsh(zr, tt, ZC_RA + 8 * u + 2 * j + 1, mu[1600 + 8 * u + 2 * j + 1]));
        *(u32x4*)(XA + t * 72 + 8 * u) = w;
        if (l == 1 && u < 4) { const float* muv = INP(I_RW_MUV1);
#pragma unroll
            for (int j = 0; j < 4; ++j) wp[j] = pk2(zsh(zr, tt, ZC_XV + 8 * u + 2 * j, muv[8 * u + 2 * j]), zsh(zr, tt, ZC_XV + 8 * u + 2 * j + 1, muv[8 * u + 2 * j + 1]));
            *(u32x4*)(XV + t * 40 + 8 * u) = w; }
    }
    __syncthreads();
    const int nt = F.wave & 3, th = F.wave >> 2, ch = 16 * nt + cl, gch = h * 64 + ch;
    float lwv[2][4], av[2][4], kv[2][4], vv[2][4], rv[2][4], kpv[2][4], kkv[2][4];
    {
        const float w0 = INP(I_RW_W0)[l * 512 + gch], a0 = INP(I_RW_A0)[l * 512 + gch], k_k = INP(I_RW_KK)[l * 512 + gch], k_a = INP(I_RW_KA)[l * 512 + gch], r_k = INP(I_RW_RK)[l * 512 + gch];
        const float mur = mu[gch], muk = mu[512 + gch], muv_ = mu[1024 + gch];
        const float v0 = (l == 1) ? INP(I_RW_V0)[gch] : 0.f;
        bf16_t* VFp = (bf16_t*)(F.ws + WS_VF);
        float kk2[2][4], bp[2][4];
#pragma unroll
        for (int j = 0; j < 2; ++j) { const int mt = 2 * th + j;
            const f32x4 LW = mma_tile<64>(XW, 72, lorat + (size_t)(h * 64) * 64, 64, 16 * mt, 16 * nt, (f32x4){0.f, 0.f, 0.f, 0.f}, F.lane);
            const f32x4 LA = mma_tile<64>(XA, 72, lorat + 512 * 64 + (size_t)(h * 64) * 64, 64, 16 * mt, 16 * nt, (f32x4){0.f, 0.f, 0.f, 0.f}, F.lane);
            f32x4 LV = (f32x4){0.f, 0.f, 0.f, 0.f};
            if (l == 1) LV = mma_tile<32>(XV, 40, lorat + 2 * 512 * 64 + 512 * 128 + (size_t)(h * 64) * 32, 32, 16 * mt, 16 * nt, LV, F.lane);
#pragma unroll
            for (int r = 0; r < 4; ++r) { const int t = 16 * mt + 4 * q + r;
                const float rc = bf2f(RAW[(t + 1) * 192 + ch]), rp = bf2f(RAW[t * 192 + ch]), kc = bf2f(RAW[(t + 1) * 192 + 64 + ch]), kp_ = bf2f(RAW[t * 192 + 64 + ch]), vc = bf2f(RAW[(t + 1) * 192 + 128 + ch]), vp = bf2f(RAW[t * 192 + 128 + ch]);
                const float rr = rc + mur * (rp - rc), kk_ = kc + muk * (kp_ - kc); float vx = vc + muv_ * (vp - vc);
                lwv[j][r] = -__expf(-softplusf_(-(w0 + LW[r])) - 0.5f);
                const float a = sigmoidf_(a0 + LA[r]);
                if (l == 1) { const float vf = bf2f(VFp[(size_t)(row0 + t) * 512 + gch]); vx = vx + (vf - vx) * sigmoidf_(v0 + LV[r]); }
                VFp[(size_t)(row0 + t) * 512 + gch] = f2bf(vx);
                const float kkr = kk_ * k_k, kp = kk_ * (1.f + (a - 1.f) * k_a);
                av[j][r] = a; kv[j][r] = kk_; vv[j][r] = vx; rv[j][r] = rr; kpv[j][r] = kp; kkv[j][r] = kkr; kk2[j][r] = kkr * kkr; bp[j][r] = rr * kp * r_k; }
        }
#pragma unroll
        for (int j = 0; j < 2; ++j)
#pragma unroll
            for (int r = 0; r < 4; ++r) { float x = kk2[j][r], y = bp[j][r];
#pragma unroll
                for (int o = 1; o < 16; o <<= 1) { x += __shfl_xor(x, o); y += __shfl_xor(y, o); }
                if (cl == 0) { const int t = 16 * (2 * th + j) + 4 * q + r; KKP[t * 4 + nt] = x; BPP[t * 4 + nt] = y; } }
    }
    float cum[2][4]; float halftot;
    {
        float base = 0.f;
#pragma unroll
        for (int j = 0; j < 2; ++j) {
            float p0 = lwv[j][0], p1 = p0 + lwv[j][1], p2 = p1 + lwv[j][2], p3 = p2 + lwv[j][3];
            const float s1 = __shfl_up(p3, 16), s2 = __shfl_up(p3, 32), s3 = __shfl_up(p3, 48);
            const float excl = (q >= 1 ? s1 : 0.f) + (q >= 2 ? s2 : 0.f) + (q >= 3 ? s3 : 0.f);
            float tot = p3; tot += __shfl_xor(tot, 16); tot += __shfl_xor(tot, 32);
            cum[j][0] = base + excl + p0; cum[j][1] = base + excl + p1; cum[j][2] = base + excl + p2; cum[j][3] = base + excl + p3;
            base += tot; }
        halftot = base;
        if (q == 0) HT[th * 64 + ch] = halftot;
    }
    __syncthreads();
    {
        const float lwl = HT[ch] + HT[64 + ch]; const float hb = th ? HT[ch] : 0.f;
        if (th == 0 && q == 0) ((float*)(F.ws + WS_RWG))[(size_t)item * 64 + ch] = __expf(lwl);
#pragma unroll
        for (int j = 0; j < 2; ++j) { const int mt = 2 * th + j; f32x4 albT, vT, beeT, keT;
#pragma unroll
            for (int r = 0; r < 4; ++r) { const int t = 16 * mt + 4 * q + r;
                const float nrm = rsqrtf((KKP[t * 4] + KKP[t * 4 + 1]) + (KKP[t * 4 + 2] + KKP[t * 4 + 3]) + 1e-6f);
                const float kk = kkv[j][r] * nrm, lwi = cum[j][r] + hb, lwe = lwi - lwv[j][r], be = kk * av[j][r];
                const float ei = __expf(lwi), en = __expf(-lwi), ee = __expf(lwl - lwi);
                const float alb = -kk * __expf(lwe);
                ALB[t * 72 + ch] = f2bf(alb); BEH[t * 72 + ch] = f2bf(be * en); KH[t * 72 + ch] = f2bf(kpv[j][r] * en); RB[t * 72 + ch] = f2bf(rv[j][r] * ei);
                albT[r] = alb; vT[r] = vv[j][r]; beeT[r] = be * ee; keT[r] = kpv[j][r] * ee; }
            const int t0 = 16 * mt + 4 * q;
            *(u32x2*)(ALBT + ch * 72 + t0) = pack4(albT); *(u32x2*)(VT + ch * 72 + t0) = pack4(vT); *(u32x2*)(BEET + ch * 72 + t0) = pack4(beeT); *(u32x2*)(KET + ch * 72 + t0) = pack4(keT); }
        if (F.tid < 64) ((float*)(F.ws + WS_RWB))[(size_t)(row0 + F.tid) * 8 + h] = (BPP[F.tid * 4] + BPP[F.tid * 4 + 1]) + (BPP[F.tid * 4 + 2] + BPP[F.tid * 4 + 3]);
    }
    __syncthreads();
#pragma unroll
    for (int k2 = 0; k2 < 2; ++k2) { const int tile = F.wave * 2 + k2, mt = tile & 3, n2 = tile >> 2;
        const int i = 16 * n2 + cl, j0 = 16 * mt + 4 * q;
        f32x4 lab = mma_tile<64>(BEH, 72, ALB, 72, 16 * mt, 16 * n2, (f32x4){0.f, 0.f, 0.f, 0.f}, F.lane);
        f32x4 lak = mma_tile<64>(KH, 72, ALB, 72, 16 * mt, 16 * n2, (f32x4){0.f, 0.f, 0.f, 0.f}, F.lane);
        f32x4 qrb = mma_tile<64>(BEH, 72, RB, 72, 16 * mt, 16 * n2, (f32x4){0.f, 0.f, 0.f, 0.f}, F.lane);
        f32x4 qrk = mma_tile<64>(KH, 72, RB, 72, 16 * mt, 16 * n2, (f32x4){0.f, 0.f, 0.f, 0.f}, F.lane);
#pragma unroll
        for (int r = 0; r < 4; ++r) { const int j = j0 + r; if (!(i > j)) { lab[r] = 0.f; lak[r] = 0.f; } if (!(i >= j)) { qrb[r] = 0.f; qrk[r] = 0.f; } }
        *(f32x4*)(AF + i * 68 + j0) = lab; *(u32x2*)(LAK + i * 72 + j0) = pack4(lak); *(u32x2*)(QRB + i * 72 + j0) = pack4(qrb); *(u32x2*)(QRK + i * 72 + j0) = pack4(qrk); }
    __syncthreads();
    if (F.wave == 0) tri_inv_inplace(AF, 68, F.lane);
    else for (int tile = F.wave - 1; tile < 16; tile += 7) { const int mt = tile & 3, n2 = tile >> 2;
        const f32x4 x = mma_tile<64>(LAK, 72, VT, 72, 16 * mt, 16 * n2, (f32x4){0.f, 0.f, 0.f, 0.f}, F.lane);
        *(u32x2*)(XT + (16 * n2 + cl) * 72 + 16 * mt + 4 * q) = pack4(x); }
    __syncthreads();
    {
        const int i = F.tid >> 3, j0 = (F.tid & 7) * 8; const f32x4 a = *(const LAS f32x4*)(AF + i * 68 + j0), bq = *(const LAS f32x4*)(AF + i * 68 + j0 + 4);
        u32x4 w; w.x = pk2(a[0], a[1]); w.y = pk2(a[2], a[3]); w.z = pk2(bq[0], bq[1]); w.w = pk2(bq[2], bq[3]); *(u32x4*)(TT + i * 72 + j0) = w;
    }
    __syncthreads();
#pragma unroll
    for (int k2 = 0; k2 < 2; ++k2) { const int tile = F.wave * 2 + k2, mt = tile & 3, n2 = tile >> 2;
        const f32x4 wu = mma_tile<64>(TT, 72, ALBT, 72, 16 * mt, 16 * n2, (f32x4){0.f, 0.f, 0.f, 0.f}, F.lane);
        const f32x4 u0 = mma_tile<64>(TT, 72, XT, 72, 16 * mt, 16 * n2, (f32x4){0.f, 0.f, 0.f, 0.f}, F.lane);
        *(u32x2*)(WUT + (16 * n2 + cl) * 72 + 16 * mt + 4 * q) = pack4(wu); *(u32x2*)(U0T + (16 * n2 + cl) * 72 + 16 * mt + 4 * q) = pack4(u0); }
    __syncthreads();
    bf16_t* gM = (bf16_t*)(F.ws + WS_RWM) + (size_t)item * 4096; bf16_t* gS = (bf16_t*)(F.ws + WS_RWS) + (size_t)item * 4096; bf16_t* gR = (bf16_t*)(F.ws + WS_RWR) + (size_t)item * 4096; bf16_t* gY = (bf16_t*)(F.ws + WS_RWY) + (size_t)item * 4096;
#pragma unroll
    for (int k2 = 0; k2 < 2; ++k2) { const int tile = F.wave * 2 + k2, mt = tile & 3, n2 = tile >> 2; const int col = 16 * n2 + cl, r0 = 16 * mt + 4 * q;
        f32x4 x = mma_tile<64>(WUT, 72, QRB, 72, 16 * mt, 16 * n2, (f32x4){0.f, 0.f, 0.f, 0.f}, F.lane);
        x = x + unpack4(*(const LAS u32x2*)(RB + col * 72 + r0));
        *(u32x2*)(gR + col * 64 + r0) = pack4(x);
        x = mma_tile<64>(U0T, 72, QRB, 72, 16 * mt, 16 * n2, (f32x4){0.f, 0.f, 0.f, 0.f}, F.lane);
        x = mma_tile<64>(VT, 72, QRK, 72, 16 * mt, 16 * n2, x, F.lane);
        *(u32x2*)(gY + col * 64 + r0) = pack4(x);
        x = mma_tile<64>(WUT, 72, BEET, 72, 16 * mt, 16 * n2, (f32x4){0.f, 0.f, 0.f, 0.f}, F.lane);
        *(u32x2*)(gM + col * 64 + 32 * (mt >> 1) + 8 * q + 4 * (mt & 1)) = pack4(x);
        x = mma_tile<64>(BEET, 72, U0T, 72, 16 * mt, 16 * n2, (f32x4){0.f, 0.f, 0.f, 0.f}, F.lane);
        x = mma_tile<64>(KET, 72, VT, 72, 16 * mt, 16 * n2, x, F.lane);
        *(u32x2*)(gS + col * 64 + r0) = pack4(x); }
    __syncthreads();
}
__device__ __forceinline__ void rw_scan_wave(Frame& F, int bh, int sl) {
    const int q = F.lane >> 4, cl = F.lane & 15, v = 16 * sl + cl;
    const bf16_t* gM = (const bf16_t*)(F.ws + WS_RWM) + (size_t)bh * 128 * 4096; bf16_t* gS = (bf16_t*)(F.ws + WS_RWS) + (size_t)bh * 128 * 4096; const float* gG = (const float*)(F.ws + WS_RWG) + (size_t)bh * 128 * 64;
    f32x4 S[4];
#pragma unroll
    for (int m = 0; m < 4; ++m) S[m] = (f32x4){0.f, 0.f, 0.f, 0.f};
    bf16x8 A[4][2]; u32x2 Bs[4]; f32x4 G[4];
#define RW_LOAD(c_) do { const bf16_t* m_ = gM + (size_t)(c_) * 4096; const bf16_t* s_ = gS + (size_t)(c_) * 4096; const float* g_ = gG + (size_t)(c_) * 64; \
        _Pragma("unroll") for (int m = 0; m < 4; ++m) { A[m][0] = *(const bf16x8*)(m_ + (16 * m + cl) * 64 + 8 * q); A[m][1] = *(const bf16x8*)(m_ + (16 * m + cl) * 64 + 32 + 8 * q); \
            Bs[m] = *(const u32x2*)(s_ + v * 64 + 16 * m + 4 * q); G[m] = *(const f32x4*)(g_ + 16 * m + 4 * q); } } while (0)
    RW_LOAD(0);
    for (int c = 0; c < 128; ++c) {
        bf16x8 cA[4][2]; u32x2 cB[4]; f32x4 cG[4];
#pragma unroll
        for (int m = 0; m < 4; ++m) { cA[m][0] = A[m][0]; cA[m][1] = A[m][1]; cB[m] = Bs[m]; cG[m] = G[m]; }
        if (c + 1 < 128) RW_LOAD(c + 1);
        bf16x8 Bop[2];
#pragma unroll
        for (int ks = 0; ks < 2; ++ks) { u32x4 w; w.x = pk2(S[2 * ks][0], S[2 * ks][1]); w.y = pk2(S[2 * ks][2], S[2 * ks][3]); w.z = pk2(S[2 * ks + 1][0], S[2 * ks + 1][1]); w.w = pk2(S[2 * ks + 1][2], S[2 * ks + 1][3]); Bop[ks] = *(bf16x8*)&w; }
        bf16_t* so = gS + (size_t)c * 4096 + v * 64 + 4 * q;
#pragma unroll
        for (int m = 0; m < 4; ++m) { u32x2 w; w.x = ((const unsigned*)&Bop[m >> 1])[2 * (m & 1)]; w.y = ((const unsigned*)&Bop[m >> 1])[2 * (m & 1) + 1]; *(u32x2*)(so + 16 * m) = w; }
#pragma unroll
        for (int m = 0; m < 4; ++m) { f32x4 acc = cG[m] * S[m] + unpack4(cB[m]);
            acc = __builtin_amdgcn_mfma_f32_16x16x32_bf16(cA[m][0], Bop[0], acc, 0, 0, 0); acc = __builtin_amdgcn_mfma_f32_16x16x32_bf16(cA[m][1], Bop[1], acc, 0, 0, 0); S[m] = acc; }
    }
#undef RW_LOAD
}
__device__ __forceinline__ void rw_sc_item(Frame& F, int l, int item) {
    const int bh = item >> 7, c = item & 127, b = bh >> 3, h = bh & 7, row0 = b * SEQ + c * 64, tq0 = c * 64;
    LAS bf16_t* ST = (LAS bf16_t*)F.lds; LAS bf16_t* RP = (LAS bf16_t*)(F.lds + 9216); LAS bf16_t* XG = (LAS bf16_t*)(F.lds + 18432); LAS float* red = (LAS float*)(F.lds + 18432 + 17408);
    const bf16_t* Z = (const bf16_t*)(F.ws + WS_Z); const float* mu = INP(I_RW_MU) + l * 1792;
    const bf16_t* g2t = (const bf16_t*)(F.ws + WS_LORAT) + (size_t)l * LORAT_LAYER + 2 * 512 * 64 + (size_t)(h * 64) * 128;
    const bf16_t* gS = (const bf16_t*)(F.ws + WS_RWS) + (size_t)item * 4096; const bf16_t* gR = (const bf16_t*)(F.ws + WS_RWR) + (size_t)item * 4096; const bf16_t* gY = (const bf16_t*)(F.ws + WS_RWY) + (size_t)item * 4096;
    { const int rr = F.tid >> 3, cc = (F.tid & 7) * 8; *(u32x4*)(ST + rr * 72 + cc) = *(const u32x4*)(gS + rr * 64 + cc); *(u32x4*)(RP + rr * 72 + cc) = *(const u32x4*)(gR + rr * 64 + cc);
      const int t = F.tid & 63, u = F.tid >> 6; const bf16_t* zr = Z + (size_t)(row0 + t) * ZW; const int tt = tq0 + t;
#pragma unroll
      for (int p = 0; p < 2; ++p) { u32x4 w; unsigned* wp = (unsigned*)&w;
#pragma unroll
          for (int j = 0; j < 4; ++j) { const int cg = 16 * u + 8 * p + 2 * j; wp[j] = pk2(sigmoidf_(zsh(zr, tt, ZC_RG + cg, mu[1664 + cg])), sigmoidf_(zsh(zr, tt, ZC_RG + cg + 1, mu[1664 + cg + 1]))); }
          *(u32x4*)(XG + t * 136 + 16 * u + 8 * p) = w; } }
    __syncthreads();
    const int n2 = F.wave >> 1, vh = F.wave & 1, q = F.lane >> 4, cl = F.lane & 15, i = 16 * n2 + cl;
    f32x4 y[2], g[2];
#pragma unroll
    for (int j = 0; j < 2; ++j) { const int mt = 2 * vh + j;
        y[j] = mma_tile<64>(ST, 72, RP, 72, 16 * mt, 16 * n2, unpack4(*(const u32x2*)(gY + i * 64 + 16 * mt + 4 * q)), F.lane);
        g[j] = mma_tile<128>(g2t, 128, XG, 136, 16 * mt, 16 * n2, (f32x4){0.f, 0.f, 0.f, 0.f}, F.lane); }
    float s = (y[0][0] + y[0][1]) + (y[0][2] + y[0][3]) + (y[1][0] + y[1][1]) + (y[1][2] + y[1][3]);
    s += __shfl_xor(s, 16); s += __shfl_xor(s, 32);
    if (q == 0) red[i * 2 + vh] = s;
    __syncthreads();
    const float mean = (red[i * 2] + red[i * 2 + 1]) * (1.f / 64.f);
    float s2 = 0.f;
#pragma unroll
    for (int j = 0; j < 2; ++j)
#pragma unroll
        for (int r = 0; r < 4; ++r) { y[j][r] -= mean; s2 += y[j][r] * y[j][r]; }
    s2 += __shfl_xor(s2, 16); s2 += __shfl_xor(s2, 32);
    __syncthreads();
    if (q == 0) red[i * 2 + vh] = s2;
    __syncthreads();
    const float rstd = rsqrtf((red[i * 2] + red[i * 2 + 1]) * (1.f / 64.f) + 64e-5f);
    const float bonus = ((const float*)(F.ws + WS_RWB))[(size_t)(row0 + i) * 8 + h];
    const bf16_t* VFp = (const bf16_t*)(F.ws + WS_VF) + (size_t)(row0 + i) * 512 + h * 64; bf16_t* Y = (bf16_t*)(F.ws + WS_Y) + (size_t)(row0 + i) * 1536 + 1024 + h * 64;
#pragma unroll
    for (int j = 0; j < 2; ++j) { const int v0 = 16 * (2 * vh + j) + 4 * q; const f32x4 lg = *(const f32x4*)(INP(I_RW_LNG) + l * 512 + h * 64 + v0), lb = *(const f32x4*)(INP(I_RW_LNB) + l * 512 + h * 64 + v0); const f32x4 vv = unpack4(*(const u32x2*)(VFp + v0));
        f32x4 o;
#pragma unroll
        for (int r = 0; r < 4; ++r) o[r] = (y[j][r] * rstd * lg[r] + lb[r] + bonus * vv[r]) * g[j][r];
        *(u32x2*)(Y + v0) = pack4(o); }
    __syncthreads();
}
__device__ __forceinline__ void phase_rw_sa(Frame& F, int l) { LAUNDER(F); for (int item = F.bid; item < 2048; item += F.G) rw_sa_item(F, l, item); }
__device__ __forceinline__ void phase_rw_sb(Frame& F) { LAUNDER(F); if (F.bid >= 32 && F.bid < 96 && F.wave == 0) rw_scan_wave(F, (F.bid - 32) >> 2, (F.bid - 32) & 3); }
__device__ __forceinline__ void phase_rw_sc(Frame& F, int l) { LAUNDER(F); for (int item = F.bid; item < 2048; item += F.G) rw_sc_item(F, l, item); }


constexpr size_t WS_GDM = WS_H;
constexpr size_t WS_GDS = WS_S + 65 * MB;
constexpr size_t WS_GDR = WS_VF + 16 * MB;
constexpr size_t WS_GDG = WS_LORAT + 640 * 1024;
__device__ __forceinline__ size_t ws_gdo(int l) { return WS_WIN + (size_t)l * ZW * 1024 * 2; }
typedef float f32x16 __attribute__((ext_vector_type(16)));

__device__ __forceinline__ void gdn_sa_item(Frame& F, int l, int item) {
    const int bh = item >> 7, c = item & 127, b = bh >> 2, h = bh & 3, row0 = b * SEQ + c * 64, tq0 = c * 64;
    LAS bf16_t* Qt = (LAS bf16_t*)F.lds; LAS bf16_t* KdT = (LAS bf16_t*)(F.lds + 17408); LAS bf16_t* QKM = (LAS bf16_t*)(F.lds + 35840); LAS bf16_t* KgT = (LAS bf16_t*)(F.lds + 45056); LAS bf16_t* VT = (LAS bf16_t*)(F.lds + 63488);
    LAS bf16_t* TPP = (LAS bf16_t*)(F.lds + 81920); LAS bf16_t* Kt = (LAS bf16_t*)(F.lds + 91136); LAS float* AF = (LAS float*)(F.lds + 108544); LAS bf16_t* WT = (LAS bf16_t*)(F.lds + 91136); LAS bf16_t* UT = (LAS bf16_t*)(F.lds + 109568);
    LAS float* G = (LAS float*)(F.lds + 128000); LAS float* BETA = (LAS float*)(F.lds + 128256); LAS float* SSQ = (LAS float*)(F.lds + 81920);
    const bf16_t* Z = (const bf16_t*)(F.ws + WS_Z);
    const int q = F.lane >> 4, cl = F.lane & 15;
    const int t = F.lane, p = F.wave, tt = tq0 + t;
    float g_t, beta_t, gl;
    {
        const bf16_t* zr = Z + (size_t)(row0 + t) * ZW;
        const float a = bf2f(zr[ZC_GA + h]), bb = bf2f(zr[ZC_GB + h]);
        const float graw = -__expf(INP(I_GDN_ALOG)[l * 4 + h]) * softplusf_(a + INP(I_GDN_DTB)[l * 4 + h]);
        g_t = wave_incl_scan(graw, t); beta_t = sigmoidf_(bb); gl = __shfl(g_t, 63);
        if (p == 0) { G[t] = g_t; BETA[t] = beta_t; if (t == 0) ((float*)(F.ws + WS_GDG))[item] = __expf(gl); }
    }
    float xq[16], xk[16], xv[16];
    {
        const float* cw = INP(I_GDN_CONV) + (size_t)l * 4 * 1536 + h * 128 + 16 * p;
#pragma unroll
        for (int g = 0; g < 3; ++g) {
            float acc[16];
#pragma unroll
            for (int e = 0; e < 16; ++e) acc[e] = 0.f;
#pragma unroll
            for (int j = 0; j < 4; ++j) {
                if (tt - 3 + j >= 0) { const bf16_t* zp = Z + (size_t)(row0 + t - 3 + j) * ZW + (g == 0 ? ZC_GQ : (g == 1 ? ZC_GK : ZC_GV)) + h * 128 + 16 * p;
                    const u32x4 lo = *(const u32x4*)zp, hi = *(const u32x4*)(zp + 8); const unsigned w[8] = {lo.x, lo.y, lo.z, lo.w, hi.x, hi.y, hi.z, hi.w};
#pragma unroll
                    for (int e = 0; e < 8; ++e) { acc[2 * e] += cw[j * 1536 + g * 512 + 2 * e] * __uint_as_float(w[e] << 16); acc[2 * e + 1] += cw[j * 1536 + g * 512 + 2 * e + 1] * __uint_as_float(w[e] & 0xffff0000u); } } }
#pragma unroll
            for (int e = 0; e < 16; ++e) { const float y = siluf_(acc[e]); if (g == 0) xq[e] = y; else if (g == 1) xk[e] = y; else xv[e] = y; }
        }
        float sq = 0.f, sk = 0.f;
#pragma unroll
        for (int e = 0; e < 16; ++e) { sq += xq[e] * xq[e]; sk += xk[e] * xk[e]; }
        SSQ[t * 8 + p] = sq; SSQ[512 + t * 8 + p] = sk;
    }
    __syncthreads();
    {
        float sq = 0.f, sk = 0.f;
#pragma unroll
        for (int e = 0; e < 8; ++e) { sq += SSQ[t * 8 + e]; sk += SSQ[512 + t * 8 + e]; }
        const float rq = rsqrtf(sq + 1e-6f) * 0.08838834764831845f, rk = rsqrtf(sk + 1e-6f);
        const float eg = __expf(g_t), ed = __expf(gl - g_t);
        u32x4 w0, w1; unsigned* p0 = (unsigned*)&w0; unsigned* p1 = (unsigned*)&w1;
#pragma unroll
        for (int e = 0; e < 4; ++e) { p0[e] = pk2(xq[2 * e] * rq, xq[2 * e + 1] * rq); p1[e] = pk2(xq[8 + 2 * e] * rq, xq[8 + 2 * e + 1] * rq); }
        *(u32x4*)(Qt + t * 136 + 16 * p) = w0; *(u32x4*)(Qt + t * 136 + 16 * p + 8) = w1;
#pragma unroll
        for (int e = 0; e < 4; ++e) { p0[e] = pk2(xk[2 * e] * rk, xk[2 * e + 1] * rk); p1[e] = pk2(xk[8 + 2 * e] * rk, xk[8 + 2 * e + 1] * rk); }
        *(u32x4*)(Kt + t * 136 + 16 * p) = w0; *(u32x4*)(Kt + t * 136 + 16 * p + 8) = w1;
#pragma unroll
        for (int e = 0; e < 16; ++e) { const float kn = xk[e] * rk; KgT[(16 * p + e) * 72 + t] = f2bf(kn * eg); KdT[(16 * p + e) * 72 + t] = f2bf(kn * ed); VT[(16 * p + e) * 72 + t] = f2bf(xv[e]); }
    }
    __syncthreads();
#pragma unroll
    for (int k2 = 0; k2 < 2; ++k2) { const int tile = F.wave * 2 + k2, mt = tile & 3, n2 = tile >> 2; const int i = 16 * n2 + cl, j0 = 16 * mt + 4 * q;
        f32x4 kk = mma_tile<128>(Kt, 136, Kt, 136, 16 * mt, 16 * n2, (f32x4){0.f, 0.f, 0.f, 0.f}, F.lane);
        f32x4 qk = mma_tile<128>(Kt, 136, Qt, 136, 16 * mt, 16 * n2, (f32x4){0.f, 0.f, 0.f, 0.f}, F.lane);
        const float gi = G[i], bi = BETA[i];
#pragma unroll
        for (int r = 0; r < 4; ++r) { const int j = j0 + r; const float d = __expf(gi - G[j]); kk[r] = (i > j) ? -bi * kk[r] * d : 0.f; qk[r] = (i >= j) ? qk[r] * d : 0.f; }
        *(f32x4*)(AF + i * 68 + j0) = kk; *(u32x2*)(QKM + i * 72 + j0) = pack4(qk); }
    __syncthreads();
    if (F.wave == 0) tri_inv_inplace(AF, 68, F.lane);
    __syncthreads();
    {
        const int i = F.tid >> 3, j0 = (F.tid & 7) * 8; const f32x4 a = *(const LAS f32x4*)(AF + i * 68 + j0), bq = *(const LAS f32x4*)(AF + i * 68 + j0 + 4);
        u32x4 w; w.x = pk2(a[0] * BETA[j0], a[1] * BETA[j0 + 1]); w.y = pk2(a[2] * BETA[j0 + 2], a[3] * BETA[j0 + 3]); w.z = pk2(bq[0] * BETA[j0 + 4], bq[1] * BETA[j0 + 5]); w.w = pk2(bq[2] * BETA[j0 + 6], bq[3] * BETA[j0 + 7]);
        *(u32x4*)(TPP + i * 72 + j0) = w;
    }
    __syncthreads();
    {
        f32x4 wv[4], uv[4];
#pragma unroll
        for (int mt = 0; mt < 4; ++mt) { wv[mt] = mma_tile<64>(TPP, 72, KgT, 72, 16 * mt, 16 * F.wave, (f32x4){0.f, 0.f, 0.f, 0.f}, F.lane); uv[mt] = mma_tile<64>(TPP, 72, VT, 72, 16 * mt, 16 * F.wave, (f32x4){0.f, 0.f, 0.f, 0.f}, F.lane); }
#pragma unroll
        for (int mt = 0; mt < 4; ++mt) { *(u32x2*)(WT + (16 * F.wave + cl) * 72 + 16 * mt + 4 * q) = pack4(wv[mt]); *(u32x2*)(UT + (16 * F.wave + cl) * 72 + 16 * mt + 4 * q) = pack4(uv[mt]); }
    }
    __syncthreads();
    bf16_t* gM = (bf16_t*)(F.ws + WS_GDM) + (size_t)item * 16384; bf16_t* gS = (bf16_t*)(F.ws + WS_GDS) + (size_t)item * 16384; bf16_t* gR = (bf16_t*)(F.ws + WS_GDR) + (size_t)item * 8192; bf16_t* gO = (bf16_t*)(F.ws + ws_gdo(l)) + (size_t)item * 8192;
#pragma unroll
    for (int mt = 0; mt < 8; ++mt) { const int n2 = F.wave, col = 16 * n2 + cl;
        f32x4 x = mma_tile<64>(WT, 72, KdT, 72, 16 * mt, 16 * n2, (f32x4){0.f, 0.f, 0.f, 0.f}, F.lane);
        *(u32x2*)(gM + col * 128 + 16 * mt + 8 * (q & 1) + 4 * (q >> 1)) = pack4(-x);
        x = mma_tile<64>(KdT, 72, UT, 72, 16 * mt, 16 * n2, (f32x4){0.f, 0.f, 0.f, 0.f}, F.lane);
        *(u32x2*)(gS + col * 128 + 16 * mt + 4 * q) = pack4(x); }
#pragma unroll
    for (int k2 = 0; k2 < 4; ++k2) { const int tile = F.wave * 4 + k2, mt = tile & 7, n2 = tile >> 3; const int i = 16 * n2 + cl, r0 = 16 * mt + 4 * q;
        f32x4 x = mma_tile<64>(WT, 72, QKM, 72, 16 * mt, 16 * n2, (f32x4){0.f, 0.f, 0.f, 0.f}, F.lane);
        x = unpack4(*(const LAS u32x2*)(Qt + i * 136 + r0)) * __expf(G[i]) - x;
        *(u32x2*)(gR + i * 128 + r0) = pack4(x);
        x = mma_tile<64>(UT, 72, QKM, 72, 16 * mt, 16 * n2, (f32x4){0.f, 0.f, 0.f, 0.f}, F.lane);
        *(u32x2*)(gO + i * 128 + r0) = pack4(x); }
    __syncthreads();
}
__device__ __forceinline__ void gdn_scan_block(Frame& F, int bh) {
    const bf16_t* gM = (const bf16_t*)(F.ws + WS_GDM) + (size_t)bh * 128 * 16384; bf16_t* gS = (bf16_t*)(F.ws + WS_GDS) + (size_t)bh * 128 * 16384; const float* gG = (const float*)(F.ws + WS_GDG) + bh * 128;
    LAS bf16_t* MB0 = (LAS bf16_t*)F.lds; LAS bf16_t* MB1 = (LAS bf16_t*)(F.lds + 34816);
    const int col = F.lane & 31, h2 = F.lane >> 5, v = 32 * F.wave + col;
    f32x16 S[4];
#pragma unroll
    for (int m = 0; m < 4; ++m)
#pragma unroll
        for (int r = 0; r < 16; ++r) S[m][r] = 0.f;
    u32x4 st[4];
#pragma unroll
    for (int k = 0; k < 4; ++k) { const int e = F.tid + 512 * k; st[k] = *(const u32x4*)(gM + (e >> 4) * 128 + (e & 15) * 8); }
#pragma unroll
    for (int k = 0; k < 4; ++k) { const int e = F.tid + 512 * k; *(u32x4*)(MB0 + (e >> 4) * 136 + (e & 15) * 8) = st[k]; }
    __syncthreads();
    for (int c = 0; c < 128; ++c) {
        LAS bf16_t* MB = (c & 1) ? MB1 : MB0; LAS bf16_t* MBn = (c & 1) ? MB0 : MB1;
        if (c + 1 < 128) {
#pragma unroll
            for (int k = 0; k < 4; ++k) { const int e = F.tid + 512 * k; st[k] = *(const u32x4*)(gM + (size_t)(c + 1) * 16384 + (e >> 4) * 128 + (e & 15) * 8); } }
        if (F.wave < 4) {
            const float gl = gG[c];
            bf16_t* sp = gS + (size_t)c * 16384 + (size_t)v * 128;
            bf16x8 Bop[4][2]; f32x16 Sn[4];
#pragma unroll
            for (int T = 0; T < 4; ++T) {
#pragma unroll
                for (int sI = 0; sI < 2; ++sI) { u32x4 w; w.x = pk2(S[T][8 * sI], S[T][8 * sI + 1]); w.y = pk2(S[T][8 * sI + 2], S[T][8 * sI + 3]); w.z = pk2(S[T][8 * sI + 4], S[T][8 * sI + 5]); w.w = pk2(S[T][8 * sI + 6], S[T][8 * sI + 7]); Bop[T][sI] = *(bf16x8*)&w; }
#pragma unroll
                for (int g = 0; g < 4; ++g) { u32x2* ad = (u32x2*)(sp + 32 * T + 8 * g + 4 * h2); const f32x4 bv = unpack4(*ad);
                    u32x2 o; o.x = ((const unsigned*)&Bop[T][g >> 1])[2 * (g & 1)]; o.y = ((const unsigned*)&Bop[T][g >> 1])[2 * (g & 1) + 1]; *ad = o;
#pragma unroll
                    for (int r = 0; r < 4; ++r) Sn[T][4 * g + r] = gl * S[T][4 * g + r] + bv[r]; } }
#pragma unroll
            for (int mt = 0; mt < 4; ++mt) {
#pragma unroll
                for (int ks = 0; ks < 8; ++ks) { const bf16x8 a = *(const LAS bf16x8*)(MB + (32 * mt + col) * 136 + 16 * ks + 8 * h2);
                    Sn[mt] = __builtin_amdgcn_mfma_f32_32x32x16_bf16(a, Bop[ks >> 1][ks & 1], Sn[mt], 0, 0, 0); } }
#pragma unroll
            for (int m = 0; m < 4; ++m) S[m] = Sn[m];
        }
        if (c + 1 < 128) {
#pragma unroll
            for (int k = 0; k < 4; ++k) { const int e = F.tid + 512 * k; *(u32x4*)(MBn + (e >> 4) * 136 + (e & 15) * 8) = st[k]; } }
        __syncthreads();
    }
}
__device__ __forceinline__ void gdn_sc_item(Frame& F, int l, int item) {
    const int bh = item >> 7, c = item & 127, b = bh >> 2, h = bh & 3, row0 = b * SEQ + c * 64;
    LAS bf16_t* ST = (LAS bf16_t*)F.lds; LAS bf16_t* RP = (LAS bf16_t*)(F.lds + 34816); LAS float* red = (LAS float*)(F.lds + 34816 + 17408);
    const bf16_t* gS = (const bf16_t*)(F.ws + WS_GDS) + (size_t)item * 16384; const bf16_t* gR = (const bf16_t*)(F.ws + WS_GDR) + (size_t)item * 8192; const bf16_t* gO = (const bf16_t*)(F.ws + ws_gdo(l)) + (size_t)item * 8192;
#pragma unroll
    for (int k = 0; k < 4; ++k) { const int e = F.tid + 512 * k; *(u32x4*)(ST + (e >> 4) * 136 + (e & 15) * 8) = *(const u32x4*)(gS + (e >> 4) * 128 + (e & 15) * 8); }
#pragma unroll
    for (int k = 0; k < 2; ++k) { const int e = F.tid + 512 * k; *(u32x4*)(RP + (e >> 4) * 136 + (e & 15) * 8) = *(const u32x4*)(gR + (e >> 4) * 128 + (e & 15) * 8); }
    __syncthreads();
    const int n2 = F.wave >> 1, vh = F.wave & 1, q = F.lane >> 4, cl = F.lane & 15, i = 16 * n2 + cl;
    f32x4 o[4]; float sq = 0.f;
#pragma unroll
    for (int j = 0; j < 4; ++j) { const int mt = 4 * vh + j;
        o[j] = mma_tile<128>(ST, 136, RP, 136, 16 * mt, 16 * n2, unpack4(*(const u32x2*)(gO + i * 128 + 16 * mt + 4 * q)), F.lane);
        sq += (o[j][0] * o[j][0] + o[j][1] * o[j][1]) + (o[j][2] * o[j][2] + o[j][3] * o[j][3]); }
    sq += __shfl_xor(sq, 16); sq += __shfl_xor(sq, 32);
    if (q == 0) red[i * 2 + vh] = sq;
    __syncthreads();
    const float rms = rsqrtf((red[i * 2] + red[i * 2 + 1]) * (1.f / 128.f) + 1e-6f);
    const bf16_t* zg = (const bf16_t*)(F.ws + WS_Z) + (size_t)(row0 + i) * ZW + ZC_GZ + h * 128; bf16_t* Y = (bf16_t*)(F.ws + WS_Y) + (size_t)(row0 + i) * 1536 + h * 128; const float* ng = INP(I_GDN_NG) + l * 128;
#pragma unroll
    for (int j = 0; j < 4; ++j) { const int v0 = 16 * (4 * vh + j) + 4 * q; const f32x4 g4 = *(const f32x4*)(ng + v0); const f32x4 z4 = unpack4(*(const u32x2*)(zg + v0)); f32x4 y;
#pragma unroll
        for (int r = 0; r < 4; ++r) y[r] = o[j][r] * rms * g4[r] * siluf_(z4[r]);
        *(u32x2*)(Y + v0) = pack4(y); }
    __syncthreads();
}
__device__ __forceinline__ void phase_gdn_sa(Frame& F, int l) { LAUNDER(F); for (int item = F.bid; item < 1024; item += F.G) gdn_sa_item(F, l, item); }
__device__ __forceinline__ void phase_gdn_sb(Frame& F) { LAUNDER(F); if (F.bid >= 100 && F.bid < 108) gdn_scan_block(F, F.bid - 100); }
__device__ __forceinline__ void phase_gdn_sc(Frame& F, int l) { LAUNDER(F); for (int item = F.bid; item < 1024; item += F.G) gdn_sc_item(F, l, item); }

#define SITE(N) int g_ = F.G, b_ = F.bid; unsigned char* w_ = ws; asm volatile("; gemm site " #N : "+s"(g_), "+s"(b_), "+s"(w_))
#define XB_TMO      128
#define XB_XCNT(j)  (256  + 64 * (j))
#define XB_XSUB(j)  (1280 + 64 * (j))
#define XB_XGEN(j)  (2304 + 64 * (j))
#define XB_TOP      3328
#define XB_TOPGEN   3392
#define XCD_BAR_WORDS 3456
#define XB_SPIN_CAP (1u << 20)
__device__ __forceinline__ unsigned xb_ld(unsigned* p)              { return __hip_atomic_load(p, __ATOMIC_RELAXED, __HIP_MEMORY_SCOPE_AGENT); }
__device__ __forceinline__ unsigned xb_add(unsigned* p, unsigned v) { return __hip_atomic_fetch_add(p, v, __ATOMIC_RELAXED, __HIP_MEMORY_SCOPE_AGENT); }
__device__ __forceinline__ unsigned xb_xcc_id() { return (unsigned)__builtin_amdgcn_s_getreg((3 << 11) | 20) & 0xFu; }
#define XB_SPIN(cond, bar) do { unsigned _sp = 0; while (cond) { __builtin_amdgcn_s_sleep(1); \
    if ((++_sp & 255u) == 0u) { if (xb_ld(&(bar)[XB_TMO])) break; if (_sp > XB_SPIN_CAP) { atomicAdd(&(bar)[XB_TMO], 1u); break; } } } } while (0)
struct XcdBarrier { unsigned* bar; unsigned x; volatile LAS unsigned* st; };
__device__ __forceinline__ XcdBarrier xcd_barrier_post(unsigned* bar, volatile LAS unsigned* st) {
    XcdBarrier b; b.bar = bar; b.x = xb_xcc_id(); b.st = st;
    if (threadIdx.x == 0) (void)xb_add(&bar[XB_XCNT(b.x)], 1u);
    return b;
}
__device__ __forceinline__ void xcd_barrier_complete(unsigned* bar, unsigned x, unsigned& nloc, unsigned& nx) {
    const unsigned G = gridDim.x * gridDim.y * gridDim.z;
    unsigned sum, cnt, mine, sp = 0u;
    for (;;) {
        sum = 0u; cnt = 0u; mine = 0u;
#pragma unroll
        for (unsigned j = 0; j < 16; ++j) { const unsigned c = xb_ld(&bar[XB_XCNT(j)]); sum += c; cnt += (c > 0u) ? 1u : 0u; mine = (j == x) ? c : mine; }
        if (sum == G) break;
        __builtin_amdgcn_s_sleep(1);
        if ((++sp & 255u) == 0u) { if (xb_ld(&bar[XB_TMO])) break; if (sp > XB_SPIN_CAP) { atomicAdd(&bar[XB_TMO], 1u); break; } }
    }
    nloc = mine > 0u ? mine : 1u; nx = cnt > 0u ? cnt : 1u;
}
__device__ __forceinline__ void xcd_barrier(const XcdBarrier& b) {
    asm volatile("s_waitcnt vmcnt(0)" ::: "memory");
    __syncthreads();
    if (threadIdx.x == 0) {
        unsigned* bar = b.bar;
        __builtin_amdgcn_s_waitcnt(0);
        unsigned nloc = b.st[0], nx = b.st[1];
        if (nloc == 0u) { xcd_barrier_complete(bar, b.x, nloc, nx); b.st[0] = nloc; b.st[1] = nx; }
        const unsigned old = xb_add(&bar[XB_XSUB(b.x)], 1u);
        const unsigned gen = old / nloc;
        if (old + 1u == (gen + 1u) * nloc) {
            __builtin_amdgcn_fence(__ATOMIC_RELEASE, "agent");
            asm volatile("s_waitcnt vmcnt(0)" ::: "memory");
            const unsigned og = xb_add(&bar[XB_TOP], 1u);
            const unsigned tg = og / nx;
            if (og + 1u == (tg + 1u) * nx) xb_add(&bar[XB_TOPGEN], 1u);
            else XB_SPIN(xb_ld(&bar[XB_TOPGEN]) == tg, bar);
            __builtin_amdgcn_fence(__ATOMIC_ACQUIRE, "agent");
            xb_add(&bar[XB_XGEN(b.x)], 1u);
            asm volatile("s_waitcnt vmcnt(0)" ::: "memory");
        } else {
            XB_SPIN(xb_ld(&bar[XB_XGEN(b.x)]) == gen, bar);
            __builtin_amdgcn_fence(__ATOMIC_ACQUIRE, "agent");
            asm volatile("s_waitcnt vmcnt(0)" ::: "memory");
        }
    }
    __syncthreads();
}

enum { PH_CONV0 = 0, PH_LNIN, PH_INPROJ0, PH_SA0, PH_SB0, PH_SC0, PH_MERGE0, PH_WO0, PH_LN1_0, PH_FFN1, PH_FFN2, PH_LN2_0,
       PH_INPROJ1, PH_SA1, PH_SB1, PH_SC1, PH_MERGE1, PH_WO1, PH_LN1_1, PH_MOESET, PH_MOE1, PH_MOE2, PH_LN2_1, PH_END };

__device__ __forceinline__ void phase_sa(Frame& F, int l) {
    LAUNDER(F);
    for (int item = F.bid; item < 1024; item += F.G) gdn_sa_item(F, l, item);
    for (int item = F.bid; item < 2048; item += F.G) rw_sa_item(F, l, item);
    for (int item = F.bid; item < 1024; item += F.G) ml_sa_item(F, l, item);
}
__device__ __forceinline__ void phase_sb(Frame& F) {
    LAUNDER(F);
    if (F.bid < 16) ml_scan(F, F.bid, -1); else if (F.bid == 16) ml_scan(F, -1, 0);
    else if (F.bid >= 32 && F.bid < 96) { if (F.wave == 0) rw_scan_wave(F, (F.bid - 32) >> 2, (F.bid - 32) & 3); }
    else if (F.bid >= 100 && F.bid < 108) gdn_scan_block(F, F.bid - 100);
}
__device__ __forceinline__ void phase_sc(Frame& F, int l) {
    LAUNDER(F);
    for (int item = F.bid; item < 1024; item += F.G) gdn_sc_item(F, l, item);
    for (int item = F.bid; item < 2048; item += F.G) rw_sc_item(F, l, item);
    for (int item = F.bid; item < 1024; item += F.G) ml_sc_item(F, l, item);
}

__device__ __forceinline__ void run_phase(Frame& F, const Args* ap, unsigned char* ws, const int ph) {
    const int l = (ph >= PH_INPROJ1) ? 1 : 0;
    switch (ph) {
    case PH_CONV0:
        phase_mod(F);
        phase_convert(F, 0, NJOBS0, 0, ap->items0);
        break;
    case PH_LNIN: phase_ln(F, 0, INP(I_LNIN_G), INP(I_LNIN_B), 0, 0, 0, 0, 1024, false, false); break;
    case PH_INPROJ0: case PH_INPROJ1: {
        SITE(1); pg8::StaticOrder S{(const char*)(w_ + WS_H), (const char*)(w_ + WS_WIN + (size_t)l * ZW * 1024 * 2), NTOK / 256, ZW / 256, 1024, g_, b_};
        pg8::EpiBf16 E{(bf16_t*)(w_ + WS_Z), ZW};
        pg8::gemm_phase(F.lds, 1024, S, E); } break;
    case PH_SA0: case PH_SA1: phase_sa(F, l); break;
    case PH_SB0: case PH_SB1: phase_sb(F); break;
    case PH_SC0: case PH_SC1: phase_sc(F, l); break;
    case PH_MERGE0: case PH_MERGE1: {
        SITE(2); pg8::StaticOrder S{(const char*)(w_ + WS_Y), (const char*)(w_ + WS_WBR + (size_t)l * 1024 * 1536 * 2), NTOK / 256, 4, 1536, g_, b_};
        pg8::EpiMerge E{(const bf16_t*)(w_ + WS_Z), (bf16_t*)(w_ + WS_H)};
        pg8::gemm_phase(F.lds, 1536, S, E); } break;
    case PH_WO0: case PH_WO1: {
        SITE(3); pg8::StaticOrder S{(const char*)(w_ + WS_H), (const char*)(w_ + WS_WO + (size_t)l * 1024 * 1024 * 2), NTOK / 256, 4, 1024, g_, b_};
        pg8::EpiF32 E{(float*)(w_ + WS_YF), 1024};
        pg8::gemm_phase(F.lds, 1024, S, E); } break;
    case PH_LN1_0: phase_ln(F, 1, INP(I_LN1_G), INP(I_LN1_B), 0, 2048, 0, 3072, 4096, false, false); break;
    case PH_LN1_1: phase_ln(F, 1, INP(I_LN1_G) + 1024, INP(I_LN1_B) + 1024, 1, 2048, 1, 3072, 4096, true, false); break;
    case PH_FFN1: {
        SITE(4); pg8::StaticOrder S{(const char*)(w_ + WS_H), (const char*)(w_ + WS_WGU), NTOK / 256, 2 * DFF / 256, 1024, g_, b_};
        pg8::EpiSwiglu E{(bf16_t*)(w_ + WS_ACT0), DFF};
        pg8::gemm_phase(F.lds, 1024, S, E); } break;
    case PH_FFN2: {
        SITE(6); pg8::StaticOrder S{(const char*)(w_ + WS_ACT0), (const char*)(w_ + WS_WD), NTOK / 256, 4, DFF, g_, b_};
        pg8::EpiF32 E{(float*)(w_ + WS_YF), 1024};
        pg8::gemm_phase(F.lds, DFF, S, E); } break;
    case PH_LN2_0: phase_ln(F, 1, INP(I_LN2_G), INP(I_LN2_B), 0, 5120, 1, 0, 1024, false, false); break;
    case PH_MOESET: phase_moe_setup(F); phase_convert(F, NJOBS0, NJOBS, ap->items0, ap->items0 + ap->items1); break;
    case PH_MOE1: {
        const int* texp = (const int*)(ws + WS_TEXP); const int nrt = texp[MOE_RT_MAX];
        SITE(5); pg8::MoeOrder S{(const char*)(w_ + WS_MA), (const char*)(w_ + WS_MW), texp, MW_EXP_BYTES, nrt, 2 * DFFE / 256, 1024, g_, b_};
        pg8::EpiSwiglu E{(bf16_t*)(w_ + WS_MACT), DFFE};
        pg8::gemm_phase(F.lds, 1024, S, E); } break;
    case PH_MOE2: {
        const int* texp = (const int*)(ws + WS_TEXP); const int nrt = texp[MOE_RT_MAX];
        SITE(7); pg8::MoeOrder S{(const char*)(w_ + WS_MACT), (const char*)(w_ + WS_MW + (size_t)7168 * 1024 * 2), texp, MW_EXP_BYTES, nrt, 4, DFFE, g_, b_};
        pg8::EpiBf16 E{(bf16_t*)(w_ + WS_MY), 1024};
        pg8::gemm_phase(F.lds, DFFE, S, E); } break;
    case PH_LN2_1: phase_ln(F, 3, INP(I_LN2_G) + 1024, INP(I_LN2_B) + 1024, 1, 5120, 0, 0, 0, false, true); break;
    default: break;
    }
}
#define FRAME_SETUP() \
        const Args* ap = &args; \
        int tid_ = threadIdx.x; asm volatile("" : "+v"(tid_)); \
        Frame F; F.lds = (LAS unsigned char*)lds_raw; F.tid = tid_; F.lane = tid_ & 63; F.wave = __builtin_amdgcn_readfirstlane(tid_ >> 6); F.G = gridDim.x; F.bid = blockIdx.x; F.a = ap; \
        unsigned char* ws = args.ws; F.ws = ws;

#define PHASE(k) do { { FRAME_SETUP(); run_phase(F, ap, ws, (k)); } if ((k) + 1 < PH_END) { if ((k) == 0) cg::this_grid().sync(); else xcd_barrier(xbar); } } while (0)
__global__ void __launch_bounds__(NTHREADS, 2) mk(Args args) {
    extern __shared__ __attribute__((aligned(16))) unsigned char lds_raw[];
    volatile LAS unsigned* xst = (volatile LAS unsigned*)((LAS unsigned char*)lds_raw + LDS_BYTES - 64);
    if (threadIdx.x < 4) xst[threadIdx.x] = 0u;
    __syncthreads();
    const XcdBarrier xbar = xcd_barrier_post((unsigned*)(args.ws + WS_BAR), xst);
    PHASE(0); PHASE(1); PHASE(2); PHASE(3); PHASE(4); PHASE(5); PHASE(6); PHASE(7); PHASE(8); PHASE(9); PHASE(10); PHASE(11);
    PHASE(12); PHASE(13); PHASE(14); PHASE(15); PHASE(16); PHASE(17); PHASE(18); PHASE(19); PHASE(20); PHASE(21); PHASE(22);
    static_assert(PH_END == 23, "phase list");
}

static int fill_jobs(Args& a, void* const* d_in, unsigned char* ws) {
    int nj = 0, item = 0;
    auto add = [&](const float* src, bf16_t* dst, int K, int ld_src, int col0, int ncols, int ld_dst, int r0, int mode, int batch, long long sbs, long long dbs) {
        Job& J = a.jobs[nj++]; J.src = src; J.dst = dst; J.src_bs = sbs; J.dst_bs = dbs; J.K = K; J.ld_src = ld_src; J.col0 = col0; J.ncols = ncols; J.ld_dst = ld_dst; J.r0 = r0; J.mode = mode; J.batch = batch;
        J.item0 = item; J.nitems = batch * ((K + 63) / 64) * ((ncols + 31) / 32); item += J.nitems; J.pad0 = 0; J.pad1 = 0; };
    for (int l = 0; l < 2; ++l) {
        const float* w = (const float*)d_in[I_W_IN] + (size_t)l * 1024 * IN_W; bf16_t* d = (bf16_t*)(ws + WS_WIN) + (size_t)l * ZW * 1024;
        add(w, d, 1024, IN_W, 0, 2048, 1024, 0, 0, 1, 0, 0);
        add(w, d, 1024, IN_W, 2056, 1536, 1024, 2048, 0, 1, 0, 0);
        add(w, d, 1024, IN_W, 3600, 1792, 1024, 3584, 0, 1, 0, 0);
        add(w, d, 1024, IN_W, 2048, 8, 1024, 5376, 0, 1, 0, 0);
        add(w, d, 1024, IN_W, 3592, 8, 1024, 5384, 0, 1, 0, 0);
        add(w, d, 1024, IN_W, 5392, 3072, 1024, 5632, 0, 1, 0, 0);
        if (l == 1) add((const float*)d_in[I_RW_V1], d, 1024, 32, 0, 32, 1024, 5392, 0, 1, 0, 0);
        add((const float*)d_in[I_W_BR] + (size_t)l * 3 * 512 * 1024, (bf16_t*)(ws + WS_WBR) + (size_t)l * 1024 * 1536, 512, 1024, 0, 1024, 1536, 0, 0, 3, 512ll * 1024, 512);
        add((const float*)d_in[I_W_O] + (size_t)l * 1024 * 1024, (bf16_t*)(ws + WS_WO) + (size_t)l * 1024 * 1024, 1024, 1024, 0, 1024, 1024, 0, 0, 1, 0, 0);
    }
    for (int l = 0; l < 2; ++l) {
        bf16_t* d = (bf16_t*)(ws + WS_LORAT) + (size_t)l * LORAT_LAYER;
        add((const float*)d_in[I_RW_W2] + (size_t)l * 64 * 512, d, 64, 512, 0, 512, 64, 0, 0, 1, 0, 0);
        add((const float*)d_in[I_RW_A2] + (size_t)l * 64 * 512, d + 512 * 64, 64, 512, 0, 512, 64, 0, 0, 1, 0, 0);
        add((const float*)d_in[I_RW_G2] + (size_t)l * 128 * 512, d + 2 * 512 * 64, 128, 512, 0, 512, 128, 0, 0, 1, 0, 0);
        if (l == 1) add((const float*)d_in[I_RW_V2], d + 2 * 512 * 64 + 512 * 128, 32, 512, 0, 512, 32, 0, 0, 1, 0, 0);
    }
    add((const float*)d_in[I_FFN_G], (bf16_t*)(ws + WS_WGU), 1024, DFF, 0, DFF, 1024, 0, 1, 1, 0, 0);
    add((const float*)d_in[I_FFN_U], (bf16_t*)(ws + WS_WGU), 1024, DFF, 0, DFF, 1024, 128, 1, 1, 0, 0);
    add((const float*)d_in[I_FFN_D], (bf16_t*)(ws + WS_WD), DFF, 1024, 0, 1024, DFF, 0, 0, 1, 0, 0);
    if (nj != NJOBS0) return -1;
    a.items0 = item;
    const long long eb = (long long)(MW_EXP_BYTES / 2);
    add((const float*)d_in[I_MOE_G], (bf16_t*)(ws + WS_MW), 1024, DFFE, 0, DFFE, 1024, 0, 1, 8, 1024ll * DFFE, eb);
    add((const float*)d_in[I_MOE_U], (bf16_t*)(ws + WS_MW), 1024, DFFE, 0, DFFE, 1024, 128, 1, 8, 1024ll * DFFE, eb);
    add((const float*)d_in[I_MOE_D], (bf16_t*)(ws + WS_MW) + (size_t)7168 * 1024, DFFE, 1024, 0, 1024, DFFE, 0, 0, 8, (long long)DFFE * 1024, eb);
    if (nj != NJOBS) return -1;
    a.items1 = item - a.items0;
    return 0;
}

extern "C" void kernel_launch(void* const* d_in, const int* in_sizes, int n_in, void* d_out, int out_size, void* d_ws, size_t ws_size, hipStream_t stream) {
    static int grid = 0;
    if (grid == 0) {
        if (n_in != 43 || out_size != NTOK * D || ws_size < WS_END) { fprintf(stderr, "kernel_launch: unexpected shapes n_in %d out %d ws %zu (need %zu)\n", n_in, out_size, ws_size, (size_t)WS_END); grid = -1; return; }
        int dev = 0, cus = 0, per_cu = 0;
        (void)hipGetDevice(&dev); (void)hipDeviceGetAttribute(&cus, hipDeviceAttributeMultiprocessorCount, dev); (void)per_cu;
        if (hipFuncSetAttribute((const void*)mk, hipFuncAttributeMaxDynamicSharedMemorySize, LDS_BYTES) != hipSuccess) { fprintf(stderr, "hipFuncSetAttribute failed\n"); grid = -1; return; }
        (void)hipOccupancyMaxActiveBlocksPerMultiprocessor(&per_cu, (const void*)mk, NTHREADS, LDS_BYTES);
        if (per_cu < 1) { fprintf(stderr, "occupancy query says %d\n", per_cu); per_cu = 1; }
        (void)hipGetLastError();
        grid = cus;
    }
    if (grid < 0) return;
    Args a{};
    for (int i = 0; i < 43; ++i) a.in[i] = (const float*)d_in[i];
    a.out = (float*)d_out; a.ws = (unsigned char*)d_ws;
    if (fill_jobs(a, d_in, (unsigned char*)d_ws) != 0) { fprintf(stderr, "job table mismatch\n"); return; }
    a.ph_lo = 0; a.ph_hi = PH_END;
    if (hipMemsetAsync((char*)d_ws + WS_CTL, 0, CTL_ZERO_BYTES, stream) != hipSuccess) { fprintf(stderr, "memset failed\n"); return; }
    void* kargs[] = {&a};
    hipError_t e = hipLaunchCooperativeKernel((const void*)mk, dim3(grid), dim3(NTHREADS), kargs, LDS_BYTES, stream);
    if (e != hipSuccess) fprintf(stderr, "cooperative launch failed: %s\n", hipGetErrorString(e));
}
```

```cpp
#include <hip/hip_runtime.h>
#include <hip/hip_cooperative_groups.h>
#include <cstdio>
#include <cstdint>
namespace cg = cooperative_groups;

#ifndef ONE_LAUNCH
#define ONE_LAUNCH 1
#endif

#define LAS __attribute__((address_space(3)))
typedef unsigned short bf16_t;
typedef short bf16x8 __attribute__((ext_vector_type(8)));
typedef float f32x4 __attribute__((ext_vector_type(4)));
typedef float f32x2 __attribute__((ext_vector_type(2)));
typedef unsigned u32x4 __attribute__((ext_vector_type(4)));
typedef unsigned u32x2 __attribute__((ext_vector_type(2)));

constexpr int NTOK = 16384, D = 1024, SEQ = 8192, NB = 2;
constexpr int IN_W = 8464;
constexpr int NW = 8704;
constexpr int ZW = 5632;
constexpr int ZC_GQ = 0, ZC_GK = 512, ZC_GV = 1024, ZC_GZ = 1536, ZC_MQ = 2048, ZC_MK = 2304, ZC_MV = 2560, ZC_MO = 3072,
              ZC_RR = 3584, ZC_RK = 4096, ZC_RV = 4608, ZC_RW = 5120, ZC_RA = 5184, ZC_RG = 5248, ZC_GA = 5376, ZC_GB = 5380,
              ZC_MI = 5384, ZC_MF = 5388, ZC_XV = 5392, ZC_GATE = 5632;
constexpr int DFF = 2816, DFFE = 3584, NEXP = 8;
constexpr int MOE_ROWS_MAX = 32768 + NEXP * 256;
constexpr int MOE_RT_MAX = MOE_ROWS_MAX / 256;
constexpr float DN_ALPHA = 1.4142135623730951f;
constexpr float LN_EPS = 1e-5f;

constexpr size_t MB = 1ull << 20;
constexpr size_t WS_CTL = 0;
constexpr size_t WS_MOD = 64 * 1024;
constexpr size_t WS_TOPE = 256 * 1024;
constexpr size_t WS_TOPG = 384 * 1024;
constexpr size_t WS_TOPP = 512 * 1024;
constexpr size_t WS_WIN = 1 * MB;
constexpr size_t WS_WBR = 35 * MB;
constexpr size_t WS_WO = 41 * MB;
constexpr size_t WS_WGU = 45 * MB;
constexpr size_t WS_WD = 56 * MB;
constexpr size_t WS_H = 62 * MB;
constexpr size_t WS_VF = 94 * MB;
constexpr size_t WS_Y = 126 * MB;
constexpr size_t WS_Z = 174 * MB;
constexpr size_t WS_GATE = 350 * MB;
constexpr size_t WS_S = 446 * MB;
constexpr size_t WS_YF = WS_S;
constexpr size_t WS_S0 = WS_S, WS_S1 = WS_S + 32 * MB, WS_S2 = WS_S + 64 * MB, WS_S3 = WS_S + 96 * MB, WS_S4 = WS_H;
constexpr size_t WS_ACT0 = WS_Z;
constexpr size_t WS_MACT = 1 * MB;
constexpr size_t WS_MW = 240 * MB;
constexpr size_t WS_MA = 408 * MB;
constexpr size_t WS_MY = 476 * MB;
constexpr size_t WS_LORAT = WS_S + 115 * MB;
constexpr size_t LORAT_LAYER = 512 * (64 + 64 + 128 + 32);
constexpr size_t WS_END = 544 * MB;
constexpr size_t MW_EXP_BYTES = (size_t)(7168 + 3584) * 1024 * 2;

constexpr int CW_CNT = 0;
constexpr int CW_Q = 64;
constexpr int CW_GSA = 192;
constexpr int CW_FLG = 256;
constexpr size_t WS_TS = 4096;
constexpr size_t WS_BAR = 8192;
constexpr size_t CTL_ZERO_BYTES = 8192 + 3456 * 4;

__device__ __forceinline__ float bf2f(bf16_t b) { return __uint_as_float(((unsigned)b) << 16); }
__device__ __forceinline__ bf16_t f2bf(float f) { unsigned u = __float_as_uint(f); u += 0x7FFFu + ((u >> 16) & 1u); return (bf16_t)(u >> 16); }
typedef __bf16 bf16v2_ __attribute__((ext_vector_type(2)));
__device__ __forceinline__ unsigned pk2(float lo, float hi) { const f32x2 v = {lo, hi}; const bf16v2_ r = __builtin_convertvector(v, bf16v2_); return *(const unsigned*)&r; }

__device__ __forceinline__ unsigned cvt_pk_bf16(float lo, float hi) { return pk2(lo, hi); }
__device__ __forceinline__ bf16_t f2bfh(float f) { return (bf16_t)(pk2(f, 0.f) & 0xffffu); }
__device__ __forceinline__ u32x2 pack4(f32x4 v) { u32x2 w; w.x = pk2(v[0], v[1]); w.y = pk2(v[2], v[3]); return w; }
__device__ __forceinline__ f32x4 unpack4(u32x2 w) { f32x4 v; v[0] = __uint_as_float(w.x << 16); v[1] = __uint_as_float(w.x & 0xffff0000u); v[2] = __uint_as_float(w.y << 16); v[3] = __uint_as_float(w.y & 0xffff0000u); return v; }
__device__ __forceinline__ float sigmoidf_(float x) { return __builtin_amdgcn_rcpf(1.f + __expf(-x)); }
__device__ __forceinline__ float siluf_(float x) { return x * __builtin_amdgcn_rcpf(1.f + __expf(-x)); }
__device__ __forceinline__ float softplusf_(float x) { return fmaxf(x, 0.f) + __logf(1.f + __expf(-fabsf(x))); }
__device__ __forceinline__ float tanhf_(float x) { return 1.f - 2.f * __builtin_amdgcn_rcpf(1.f + __expf(2.f * x)); }
__device__ __forceinline__ float wave_sum(float v) {
#pragma unroll
    for (int o = 1; o < 64; o <<= 1) v += __shfl_xor(v, o);
    return v;
}

struct Job { const float* src; bf16_t* dst; long long src_bs, dst_bs; int K, ld_src, col0, ncols, ld_dst, r0, mode, batch, item0, nitems, pad0, pad1; };
constexpr int NJOBS0 = 27, NJOBS1 = 3, NJOBS = NJOBS0 + NJOBS1;
struct Args {
    const float* in[43];
    float* out;
    unsigned char* ws;
    Job jobs[NJOBS];
    int items0, items1;
    int l1_lo, l1_end, ff_lo, busyA, busyB, pad2_;
    int cg_seam0, pad_;
};
enum { I_X = 0, I_C, I_LNIN_G, I_LNIN_B, I_ADA_W, I_ADA_B, I_W_IN, I_GDN_CONV, I_GDN_ALOG, I_GDN_DTB, I_GDN_NG, I_ML_BI, I_ML_BF, I_ML_NG,
       I_RW_MU, I_RW_W0, I_RW_W2, I_RW_A0, I_RW_A2, I_RW_G2, I_RW_KK, I_RW_KA, I_RW_RK, I_RW_LNG, I_RW_LNB, I_RW_V1, I_RW_MUV1, I_RW_V0, I_RW_V2,
       I_W_BR, I_W_O, I_LN1_G, I_LN1_B, I_LN2_G, I_LN2_B, I_FFN_G, I_FFN_U, I_FFN_D, I_MOE_R, I_MOE_RB, I_MOE_G, I_MOE_U, I_MOE_D };

namespace pg8 {
constexpr int BM = 256, BK = 64, HALF = 128, HTB = HALF * BK * 2, STAGE_BYTES = 8 * HTB, NXCD = 8, WGM = 8;
__host__ __device__ __forceinline__ int lds_byte(int r, int c) { const int st = (r >> 4) * 2 + (c >> 5), rr = r & 15, cc = c & 31, ob = rr * 64 + cc * 2; return st * 1024 + (ob ^ (((ob >> 9) & 1) << 5)); }
__host__ __device__ __forceinline__ void stage_rc(int b, int& R, int& C) { const int st = b / 1024, sb = b % 1024, swz = sb ^ (((sb >> 9) & 1) << 5); R = (st >> 1) * 16 + swz / 64; C = (st & 1) * 32 + (swz % 64) / 2; }
__host__ __device__ __forceinline__ int perm32(int rho) { const int n = rho >> 4, i = rho & 15; return 8 * (i >> 2) + 4 * n + (i & 3); }

struct Unit { const char* a; const char* b; int pm, pn, nt, part; };

__device__ __forceinline__ void tile_map(int L, int nM, int nN, int& pm, int& pn) {
    const int nwg = nM * nN;
    int wgid = L; { const int q = nwg / NXCD, r = nwg % NXCD, xcd = wgid % NXCD, off = wgid / NXCD; wgid = (xcd < r ? xcd * (q + 1) : r * (q + 1) + (xcd - r) * q) + off; }
    const int nig = WGM * nN, gid = wgid / nig, fm = gid * WGM, gsz = (nM - fm) < WGM ? (nM - fm) : WGM;
    pm = fm + ((wgid % nig) % gsz); pn = (wgid % nig) / gsz;
}
__device__ __forceinline__ bool static_tile(int i, int G, int c, int nM, int nN, int& pm, int& pn) {
    const int nwg = nM * nN; const long L = (long)i * G + c; if (L >= nwg) return false;
    tile_map((int)L, nM, nN, pm, pn); return true;
}
struct StaticOrder {
    static constexpr bool SPLIT = false;
    const char* A; const char* Bt; int nM, nN, K, G, c;
    __device__ __forceinline__ bool next(int i, Unit& u) const {
        int pm, pn; if (!static_tile(i, G, c, nM, nN, pm, pn)) return false;
        u.pm = pm; u.pn = pn; u.a = A + (size_t)pm * BM * K * 2; u.b = Bt + (size_t)pn * BM * K * 2; return true;
    }
};
struct MoeOrder {
    static constexpr bool SPLIT = false;
    const char* A; const char* W; const int* tile_exp; size_t wexp_bytes; int nM, nN, K, G, c;
    __device__ __forceinline__ bool next(int i, Unit& u) const {
        int pm, pn; if (!static_tile(i, G, c, nM, nN, pm, pn)) return false;
        const int e = tile_exp[pm];
        u.pm = pm; u.pn = pn; u.a = A + (size_t)pm * BM * K * 2; u.b = W + (size_t)e * wexp_bytes + (size_t)pn * BM * K * 2; return true;
    }
};

__host__ __device__ __forceinline__ void moe2_split(int nM, int G, int& R, int& S) {
    const int left = (G % 4 == 0) ? (nM * 4) % G : 0; R = left / 4; S = 1;
    if (left > 0) { if (left * 7 <= G) S = 7; else if (left * 4 <= G) S = 4; else if (left * 2 <= G) S = 2; }
    if (S == 1) R = 0;
}
struct MoeSplitOrder {
    static constexpr bool SPLIT = true;
    const char* A; const char* W; const int* tile_exp; size_t wexp_bytes; int nM, nN, K, G, c, R, S;
    __device__ __forceinline__ bool next(int i, Unit& u) const {
        const int nMp = nM - R, full = nMp * 4; const long L = (long)i * G + c;
        int pm, pn, s = 0, part = -1;
        if (L < full) tile_map((int)L, nMp, 4, pm, pn);
        else { const int idx = (int)(L - full); if (idx >= 4 * R * S) return false; const int U = idx / S; s = idx - U * S; part = idx; pn = U / R; pm = nMp + (U - pn * R); }
        const int e = tile_exp[pm]; const int ksub = K / S;
        u.pm = pm; u.pn = pn; u.part = part; u.nt = (part < 0) ? K / BK : ksub / BK;
        u.a = A + (size_t)pm * BM * K * 2 + (size_t)s * ksub * 2; u.b = W + (size_t)e * wexp_bytes + (size_t)pn * BM * K * 2 + (size_t)s * ksub * 2; return true;
    }
};

struct EpiBf16 {
    static constexpr bool PERM = true, HAS_MID = false;
    bf16_t* O; int ldc;
    __device__ __forceinline__ void mid(f32x4 (&)[2][2][4][2], const Unit&, int, int, int, int, int) const {}
    __device__ __forceinline__ void operator()(const f32x4 (&acc)[2][2][4][2], const Unit& u, int wr, int wc, int fr, int fq) const {
        const int row0 = u.pm * BM + wr * 64 + fr, col0 = u.pn * BM + wc * 32 + 8 * fq;
#pragma unroll
        for (int ai = 0; ai < 2; ++ai)
#pragma unroll
            for (int m = 0; m < 4; ++m) { bf16_t* rowp = O + (size_t)(row0 + ai * HALF + m * 16) * ldc + col0;
#pragma unroll
                for (int bj = 0; bj < 2; ++bj) { const f32x4 v0 = acc[ai][bj][m][0], v1 = acc[ai][bj][m][1];
                    u32x4 w; w.x = cvt_pk_bf16(v0[0], v0[1]); w.y = cvt_pk_bf16(v0[2], v0[3]); w.z = cvt_pk_bf16(v1[0], v1[1]); w.w = cvt_pk_bf16(v1[2], v1[3]);
                    *(u32x4*)(rowp + bj * HALF) = w; } }
    }
};
struct EpiMoe2 {
    static constexpr bool PERM = true, HAS_MID = false;
    bf16_t* O; float* P;
    __device__ __forceinline__ void mid(f32x4 (&)[2][2][4][2], const Unit&, int, int, int, int, int) const {}
    __device__ __forceinline__ void operator()(const f32x4 (&acc)[2][2][4][2], const Unit& u, int wr, int wc, int fr, int fq) const {
        if (u.part < 0) {
            const int row0 = u.pm * BM + wr * 64 + fr, col0 = u.pn * BM + wc * 32 + 8 * fq;
#pragma unroll
            for (int ai = 0; ai < 2; ++ai)
#pragma unroll
                for (int m = 0; m < 4; ++m) { bf16_t* rowp = O + (size_t)(row0 + ai * HALF + m * 16) * 1024 + col0;
#pragma unroll
                    for (int bj = 0; bj < 2; ++bj) { const f32x4 v0 = acc[ai][bj][m][0], v1 = acc[ai][bj][m][1];
                        u32x4 w; w.x = cvt_pk_bf16(v0[0], v0[1]); w.y = cvt_pk_bf16(v0[2], v0[3]); w.z = cvt_pk_bf16(v1[0], v1[1]); w.w = cvt_pk_bf16(v1[2], v1[3]);
                        *(u32x4*)(rowp + bj * HALF) = w; } }
        } else {
            float* pt = P + (size_t)u.part * 65536 + (wr * 64 + fr) * 256 + wc * 32 + 8 * fq;
#pragma unroll
            for (int ai = 0; ai < 2; ++ai)
#pragma unroll
                for (int m = 0; m < 4; ++m)
#pragma unroll
                    for (int bj = 0; bj < 2; ++bj)
#pragma unroll
                        for (int n = 0; n < 2; ++n) *(f32x4*)(pt + (ai * HALF + m * 16) * 256 + bj * HALF + 4 * n) = acc[ai][bj][m][n];
        }
    }
};
struct EpiSwiglu {
    static constexpr bool PERM = true, HAS_MID = false;
    bf16_t* O; int ldc;
    __device__ __forceinline__ void mid(f32x4 (&)[2][2][4][2], const Unit&, int, int, int, int, int) const {}
    __device__ __forceinline__ void operator()(const f32x4 (&acc)[2][2][4][2], const Unit& u, int wr, int wc, int fr, int fq) const {
        const int row0 = u.pm * BM + wr * 64 + fr, col0 = u.pn * HALF + wc * 32 + 8 * fq;
#pragma unroll
        for (int ai = 0; ai < 2; ++ai)
#pragma unroll
            for (int m = 0; m < 4; ++m) { bf16_t* rowp = O + (size_t)(row0 + ai * HALF + m * 16) * ldc + col0;
                float r[8];
#pragma unroll
                for (int n = 0; n < 2; ++n)
#pragma unroll
                    for (int j = 0; j < 4; ++j) { const float g = acc[ai][0][m][n][j], uu = acc[ai][1][m][n][j]; r[n * 4 + j] = g * uu * __builtin_amdgcn_rcpf(1.f + __expf(-g)); }
                u32x4 w; w.x = cvt_pk_bf16(r[0], r[1]); w.y = cvt_pk_bf16(r[2], r[3]); w.z = cvt_pk_bf16(r[4], r[5]); w.w = cvt_pk_bf16(r[6], r[7]);
                *(u32x4*)rowp = w; }
    }
};
struct EpiF32 {
    static constexpr bool PERM = false, HAS_MID = false;
    float* C; int ldc;
    __device__ __forceinline__ void mid(f32x4 (&)[2][2][4][2], const Unit&, int, int, int, int, int) const {}
    __device__ __forceinline__ void operator()(const f32x4 (&acc)[2][2][4][2], const Unit& u, int wr, int wc, int fr, int fq) const {
        const int row0 = u.pm * BM + wr * 64 + fr, col0 = u.pn * BM + wc * 32 + 4 * fq;
#pragma unroll
        for (int ai = 0; ai < 2; ++ai)
#pragma unroll
            for (int m = 0; m < 4; ++m) { float* rowp = C + (size_t)(row0 + ai * HALF + m * 16) * ldc + col0;
#pragma unroll
                for (int bj = 0; bj < 2; ++bj)
#pragma unroll
                    for (int n = 0; n < 2; ++n) *(f32x4*)(rowp + bj * HALF + n * 16) = acc[ai][bj][m][n]; }
    }
};
__device__ __forceinline__ size_t gate_frag_off(int gate, int pm, int pn, int wave, int ai, int m, int bj, int lane) {
    return ((size_t)((gate * 64 + pm) * 4 + pn) << 16) + (size_t)(((((wave * 2 + ai) * 4 + m) * 2 + bj) * 64 + lane) * 8);
}
__device__ __forceinline__ size_t gate_tile_bytes(int gate, int pm, int pn) { return ((size_t)((gate * 64 + pm) * 4 + pn) << 17); }
__device__ __forceinline__ unsigned gate_lane_bytes(int wave, int lane) { return (unsigned)(wave * 16384 + lane * 16); }
__device__ __forceinline__ constexpr unsigned gate_sub_bytes(int ai, int m, int bj) { return (unsigned)(((ai * 4 + m) * 2 + bj) * 1024); }
struct EpiZ {
    static constexpr bool PERM = true, HAS_MID = false;
    bf16_t* O; bf16_t* GT;
    __device__ __forceinline__ void mid(f32x4 (&)[2][2][4][2], const Unit&, int, int, int, int, int) const {}
    __device__ __forceinline__ void operator()(const f32x4 (&acc)[2][2][4][2], const Unit& u, int wr, int wc, int fr, int fq) const {
        const bool gate_tile = u.pn >= ZW / 256;
        const int row0 = u.pm * BM + wr * 64 + fr, col0 = u.pn * BM + wc * 32 + 8 * fq;
        const int g = (u.pn - ZW / 256) >> 2, png = (u.pn - ZW / 256) & 3, wave = wr * 4 + wc, lane = fr + 16 * fq;
#pragma unroll
        for (int ai = 0; ai < 2; ++ai)
#pragma unroll
            for (int m = 0; m < 4; ++m) {
#pragma unroll
                for (int bj = 0; bj < 2; ++bj) { const f32x4 v0 = acc[ai][bj][m][0], v1 = acc[ai][bj][m][1];
                    u32x4 w; w.x = cvt_pk_bf16(v0[0], v0[1]); w.y = cvt_pk_bf16(v0[2], v0[3]); w.z = cvt_pk_bf16(v1[0], v1[1]); w.w = cvt_pk_bf16(v1[2], v1[3]);
                    bf16_t* dst = gate_tile ? GT + gate_frag_off(g, u.pm, png, wave, ai, m, bj, lane) : O + (size_t)(row0 + ai * HALF + m * 16) * ZW + col0 + bj * HALF;
                    *(u32x4*)dst = w; } }
    }
};
struct EpiMerge {
    static constexpr bool PERM = true, HAS_MID = true;
    const bf16_t* GT; bf16_t* O;
    __device__ __forceinline__ static float ez(unsigned short zb) { float z = bf2f(zb); z = fminf(fmaxf(z, -30.f), 30.f); return __expf(-z); }
    __device__ __forceinline__ void mid(f32x4 (&acc)[2][2][4][2], const Unit& u, int t, int wr, int wc, int fr, int fq) const {
        if (t != 8 && t != 16 && t != 24) return;
        int lane = fr + 16 * fq; asm volatile("" : "+v"(lane));
        const int gi = (t >> 3), wave = wr * 4 + wc;
        const bool fin = (t == 24);
        const char* tb[2] = {(const char*)GT + gate_tile_bytes(fin ? 2 : gi - 1, u.pm, u.pn), (const char*)GT + gate_tile_bytes(fin ? 2 : gi, u.pm, u.pn)}; const unsigned lb = gate_lane_bytes(wave, lane);
#pragma unroll
        for (int ai = 0; ai < 2; ++ai)
#pragma unroll
            for (int m = 0; m < 4; ++m)
#pragma unroll
                for (int bj = 0; bj < 2; ++bj) { const unsigned off = lb + gate_sub_bytes(ai, m, bj); const u32x4 a = *(const u32x4*)(tb[0] + off), b = *(const u32x4*)(tb[1] + off);
                    const unsigned aw[4] = {a.x, a.y, a.z, a.w}, bw[4] = {b.x, b.y, b.z, b.w};
#pragma unroll
                    for (int k = 0; k < 4; ++k) {
                        const float n0 = fin ? 1.f : 1.f + ez((unsigned short)(bw[k] & 0xffff)), n1 = fin ? 1.f : 1.f + ez((unsigned short)(bw[k] >> 16));
                        acc[ai][bj][m][k >> 1][2 * (k & 1)] *= n0 * __builtin_amdgcn_rcpf(1.f + ez((unsigned short)(aw[k] & 0xffff)));
                        acc[ai][bj][m][k >> 1][2 * (k & 1) + 1] *= n1 * __builtin_amdgcn_rcpf(1.f + ez((unsigned short)(aw[k] >> 16))); }
                    if (bj) asm volatile("" ::: "memory"); }
    }
    __device__ __forceinline__ void operator()(const f32x4 (&acc)[2][2][4][2], const Unit& u, int wr, int wc, int fr, int fq) const {
        const int row0 = u.pm * BM + wr * 64 + fr, col0 = u.pn * BM + wc * 32 + 8 * fq, wave = wr * 4 + wc, lane = fr + 16 * fq;
#pragma unroll
        for (int ai = 0; ai < 2; ++ai)
#pragma unroll
            for (int m = 0; m < 4; ++m) { bf16_t* orow = O + (size_t)(row0 + ai * HALF + m * 16) * 1024 + col0;
#pragma unroll
                for (int bj = 0; bj < 2; ++bj) { u32x4 w; w.x = cvt_pk_bf16(acc[ai][bj][m][0][0], acc[ai][bj][m][0][1]); w.y = cvt_pk_bf16(acc[ai][bj][m][0][2], acc[ai][bj][m][0][3]); w.z = cvt_pk_bf16(acc[ai][bj][m][1][0], acc[ai][bj][m][1][1]); w.w = cvt_pk_bf16(acc[ai][bj][m][1][2], acc[ai][bj][m][1][3]); *(u32x4*)(orow + bj * HALF) = w; }
                asm volatile("" ::: "memory"); }
    }
};

template <class Epi, class Sched>
__device__ __forceinline__ void gemm_phase(LAS unsigned char* lds, const int K, const Sched& S, const Epi& E) {
    int tid_ = threadIdx.x; asm volatile("" : "+v"(tid_));
    const int tid = tid_, wid = __builtin_amdgcn_readfirstlane(tid >> 6), lane = tid & 63, wr = wid >> 2, wc = wid & 3, fr = lane & 15, fq = lane >> 4;
    const int nt = K / BK;
    unsigned voffA[2], voffB[2];
#pragma unroll
    for (int i = 0; i < 2; ++i) { int R, C; stage_rc(tid * 16 + i * 8192, R, C); const int Rb = Epi::PERM ? ((R & ~31) + perm32(R & 31)) : R;
        voffA[i] = (unsigned)(R * K + C) * 2u; voffB[i] = (unsigned)(Rb * K + C) * 2u; }
    const size_t kstep = (size_t)(BK * 2);
    const size_t hstep = (size_t)HALF * K * 2;
    const unsigned ldsw = (unsigned)wid * 1024u;
    const int aoff = lds_byte(wr * 64 + fr, fq * 8), boff = lds_byte(wc * 32 + fr, fq * 8);
#define PG8_SA(b, h) (((b) * 2 + (h)) * HTB)
#define PG8_SB(b, h) ((4 + (b) * 2 + (h)) * HTB)
#define PG8_STAGE(bufoff, gbase, voff) do { _Pragma("unroll") for (int _i = 0; _i < 2; ++_i) \
        __builtin_amdgcn_global_load_lds((const unsigned*)((const char*)(gbase) + (voff)[_i]), (LAS unsigned*)(lds + (bufoff) + ldsw + _i * 8192), 16, 0, 0); } while (0)
#define PG8_LDA(dst, b, h) do { _Pragma("unroll") for (int m = 0; m < 4; ++m) _Pragma("unroll") for (int k = 0; k < 2; ++k) dst[m][k] = *(const LAS bf16x8*)(lds + PG8_SA(b, h) + aoff + m * 2048 + k * 1024); } while (0)
#define PG8_LDB(dst, b, h) do { _Pragma("unroll") for (int n = 0; n < 2; ++n) _Pragma("unroll") for (int k = 0; k < 2; ++k) dst[n][k] = *(const LAS bf16x8*)(lds + PG8_SB(b, h) + boff + n * 2048 + k * 1024); } while (0)
#define PG8_MMA(ai, bj, At, Bt) do { __builtin_amdgcn_s_setprio(1); _Pragma("unroll") for (int m = 0; m < 4; ++m) _Pragma("unroll") for (int n = 0; n < 2; ++n) _Pragma("unroll") for (int k = 0; k < 2; ++k) \
        acc[ai][bj][m][n] = __builtin_amdgcn_mfma_f32_16x16x32_bf16(Bt[n][k], At[m][k], acc[ai][bj][m][n], 0, 0, 0); __builtin_amdgcn_s_setprio(0); } while (0)
#define PG8_WAIT_V(n) asm volatile("s_waitcnt vmcnt(" #n ")" ::: "memory")
#define PG8_WAIT_L(n) asm volatile("s_waitcnt lgkmcnt(" #n ")" ::: "memory")
#define PG8_BAR __builtin_amdgcn_s_barrier()
#define PG8_SCHED __builtin_amdgcn_sched_barrier(0)
    Unit cur, nxt; int ui = 0;
    if (!S.next(0, cur)) return;
    f32x4 acc[2][2][4][2];
#pragma unroll
    for (int a = 0; a < 2; ++a)
#pragma unroll
        for (int b = 0; b < 2; ++b)
#pragma unroll
            for (int m = 0; m < 4; ++m)
#pragma unroll
                for (int n = 0; n < 2; ++n) acc[a][b][m][n] = (f32x4){0.f, 0.f, 0.f, 0.f};
    bf16x8 At[4][2], B0[2][2], B1[2][2];
    const char* cA = cur.a; const char* cB = cur.b;
    PG8_STAGE(PG8_SB(0, 0), cB, voffB); PG8_STAGE(PG8_SA(0, 0), cA, voffA); PG8_STAGE(PG8_SB(0, 1), cB + hstep, voffB); PG8_STAGE(PG8_SA(0, 1), cA + hstep, voffA);
    if (wr == 1) PG8_BAR;
    PG8_WAIT_V(4); PG8_BAR;
    PG8_STAGE(PG8_SB(1, 0), cB + kstep, voffB); PG8_STAGE(PG8_SA(1, 0), cA + kstep, voffA); PG8_STAGE(PG8_SB(1, 1), cB + hstep + kstep, voffB);
    PG8_WAIT_V(6); PG8_BAR;
    for (;;) {
        const bool has_next = S.next(ui + 1, nxt);
        const char* nA = has_next ? nxt.a : cA; const char* nB = has_next ? nxt.b : cB;
        const int unt = Sched::SPLIT ? cur.nt : nt;
        for (int t = 0; t < unt; t += 2) {
            const bool last = (t == unt - 2);
            const char* a1 = cA + (size_t)(t + 1) * kstep;
            const char* a2 = last ? nA : cA + (size_t)(t + 2) * kstep; const char* b2 = last ? nB : cB + (size_t)(t + 2) * kstep;
            const char* a3 = a2 + kstep; const char* b3 = b2 + kstep;
            if constexpr (Epi::HAS_MID) E.mid(acc, cur, t, wr, wc, fr, fq);
            PG8_LDB(B0, 0, 0); PG8_SCHED; PG8_LDA(At, 0, 0); PG8_STAGE(PG8_SA(1, 1), a1 + hstep, voffA);
            PG8_WAIT_L(8); PG8_BAR; PG8_WAIT_L(0); PG8_MMA(0, 0, At, B0); PG8_BAR; PG8_SCHED;
            PG8_LDB(B1, 0, 1); PG8_STAGE(PG8_SB(0, 0), b2, voffB);
            PG8_BAR; PG8_WAIT_L(0); PG8_MMA(0, 1, At, B1); PG8_BAR;
            PG8_LDA(At, 0, 1); PG8_STAGE(PG8_SA(0, 0), a2, voffA);
            PG8_BAR; PG8_WAIT_L(0); PG8_MMA(1, 0, At, B0); PG8_BAR; PG8_SCHED;
            PG8_STAGE(PG8_SB(0, 1), b2 + hstep, voffB);
            PG8_WAIT_V(6); PG8_BAR; PG8_MMA(1, 1, At, B1); PG8_BAR;
            PG8_LDB(B0, 1, 0); PG8_SCHED; PG8_LDA(At, 1, 0); PG8_STAGE(PG8_SA(0, 1), a2 + hstep, voffA);
            PG8_WAIT_L(8); PG8_BAR; PG8_WAIT_L(0); PG8_MMA(0, 0, At, B0); PG8_BAR; PG8_SCHED;
            PG8_LDB(B1, 1, 1); PG8_STAGE(PG8_SB(1, 0), b3, voffB);
            PG8_BAR; PG8_WAIT_L(0); PG8_MMA(0, 1, At, B1); PG8_BAR;
            PG8_LDA(At, 1, 1); PG8_STAGE(PG8_SA(1, 0), a3, voffA);
            PG8_BAR; PG8_WAIT_L(0); PG8_MMA(1, 0, At, B0); PG8_BAR; PG8_SCHED;
            PG8_STAGE(PG8_SB(1, 1), b3 + hstep, voffB);
            PG8_WAIT_V(6); PG8_BAR; PG8_MMA(1, 1, At, B1); PG8_BAR;
        }
        if constexpr (Epi::HAS_MID) E.mid(acc, cur, nt, wr, wc, fr, fq);
        E(acc, cur, wr, wc, fr, fq);
        if (!has_next) break;
#pragma unroll
        for (int a = 0; a < 2; ++a)
#pragma unroll
            for (int b = 0; b < 2; ++b)
#pragma unroll
                for (int m = 0; m < 4; ++m)
#pragma unroll
                    for (int n = 0; n < 2; ++n) acc[a][b][m][n] = (f32x4){0.f, 0.f, 0.f, 0.f};
        cur = nxt; cA = nA; cB = nB; ++ui;
    }
    PG8_WAIT_V(0);
    if (wr == 0) PG8_BAR;
    PG8_BAR;
#undef PG8_SA
#undef PG8_SB
#undef PG8_STAGE
#undef PG8_LDA
#undef PG8_LDB
#undef PG8_MMA
#undef PG8_WAIT_V
#undef PG8_WAIT_L
#undef PG8_BAR
#undef PG8_SCHED
}
}

constexpr int NWAVES = 8, NTHREADS = NWAVES * 64;
constexpr int LDS_BYTES = pg8::STAGE_BYTES + 64;
struct Frame {
    LAS unsigned char* lds;
    int tid, lane, wave, G, bid;
    const Args* a;
    unsigned char* ws;
    unsigned pfv;
};
__device__ __forceinline__ const float* lp_(const float* p) { asm volatile("" : "+s"(p)); return p; }
#define INP(i) lp_(F.a->in[i])
#ifdef TS_ON
#define TS_F(F, k) do { if ((F).bid == 0 && (F).tid == 0) ((unsigned long long*)((F).ws + WS_TS))[(k)] = __builtin_amdgcn_s_memrealtime(); } while (0)
#define TS_FB(F, k, blk) do { if ((F).bid == (blk) && (F).tid == 0) ((unsigned long long*)((F).ws + WS_TS))[(k)] = __builtin_amdgcn_s_memrealtime(); } while (0)
#else
#define TS_F(F, k) do { } while (0)
#define TS_FB(F, k, blk) do { } while (0)
#endif
#define LAUNDER(F) asm volatile("" : "+v"((F).lane), "+v"((F).tid))

struct ConvIt { const float* W; bf16_t* WT; int k0, n0, K, ld_src, ncols, ld_dst, r0, mode; };
__device__ __forceinline__ ConvIt conv_decode(const Job& J, int local) {
    const int nkb = (J.K + 63) / 64, nnb = (J.ncols + 31) / 32, per = nkb * nnb;
    const int bi = local / per, rem = local % per, kb = rem / nnb, nb = rem % nnb;
    ConvIt c; c.W = J.src + (size_t)bi * J.src_bs + J.col0; c.WT = J.dst + (size_t)bi * J.dst_bs; c.k0 = 64 * kb; c.n0 = 32 * nb; c.K = J.K; c.ld_src = J.ld_src; c.ncols = J.ncols; c.ld_dst = J.ld_dst; c.r0 = J.r0; c.mode = J.mode; return c;
}
__device__ __forceinline__ void conv_load(const ConvIt& c, f32x4 (&v)[8], int lane) {
    const int r8 = lane >> 3, c4r = c.n0 + (lane & 7) * 4, c4 = c4r < c.ncols ? c4r : 0;
#pragma unroll
    for (int i = 0; i < 8; ++i) { const int kr = c.k0 + 8 * i + r8, kk = kr < c.K ? kr : c.K - 1; v[i] = *(const f32x4*)(c.W + (size_t)kk * c.ld_src + c4); }
}
__device__ __forceinline__ void conv_store(const ConvIt& c, const f32x4 (&v)[8], LAS float* scr, int lane) {
    const int r8 = lane >> 3, c4l = (lane & 7) * 4;
#pragma unroll
    for (int i = 0; i < 8; ++i) { LAS float* d = scr + (8 * i + r8) * 33 + c4l; d[0] = v[i][0]; d[1] = v[i][1]; d[2] = v[i][2]; d[3] = v[i][3]; }
    asm volatile("s_waitcnt lgkmcnt(0)" ::: "memory");
    const int cq = lane & 7;
#pragma unroll
    for (int j = 0; j < 4; ++j) { const int n = (lane >> 3) + 8 * j; const LAS float* sp = scr + (8 * cq) * 33 + n; const int cc = c.n0 + n;
        if (cc < c.ncols && c.k0 + 8 * cq < c.K) { const int drow = c.r0 + (c.mode ? ((cc >> 7) * 256 + (cc & 127)) : cc);
            u32x4 o; o.x = pk2(sp[0 * 33], sp[1 * 33]); o.y = pk2(sp[2 * 33], sp[3 * 33]); o.z = pk2(sp[4 * 33], sp[5 * 33]); o.w = pk2(sp[6 * 33], sp[7 * 33]);
            *(u32x4*)(c.WT + (size_t)drow * c.ld_dst + c.k0 + 8 * cq) = o; } }
    asm volatile("s_waitcnt lgkmcnt(0)" ::: "memory");
}
__device__ __forceinline__ void phase_convert(Frame& F, int j0, int j1, int it0, int nitems, int wrank, int NGW) {
    LAUNDER(F);
    LAS float* scr = (LAS float*)(F.lds + F.wave * 8704);
    int it = it0 + wrank; if (it >= nitems) return;
    int j = j0;
    while (j + 1 < j1 && it >= F.a->jobs[j + 1].item0) ++j;
    ConvIt cur = conv_decode(F.a->jobs[j], it - F.a->jobs[j].item0);
    f32x4 va[8], vb[8];
    conv_load(cur, va, F.lane);
    for (;;) {
        const int itn = it + NGW; const bool more = itn < nitems; ConvIt nxt = cur;
        if (more) { while (j + 1 < j1 && itn >= F.a->jobs[j + 1].item0) ++j; nxt = conv_decode(F.a->jobs[j], itn - F.a->jobs[j].item0); }
        conv_load(nxt, vb, F.lane);
        conv_store(cur, va, scr, F.lane);
        if (!more) break;
#pragma unroll
        for (int i = 0; i < 8; ++i) va[i] = vb[i];
        cur = nxt; it = itn;
    }
}

__device__ __forceinline__ void phase_mod(Frame& F) {
    LAUNDER(F);
    float* mod = (float*)(F.ws + WS_MOD);
    LAS float* sc = (LAS float*)(F.lds + 72 * 1024);
    LAS float* red = (LAS float*)(F.lds + 80 * 1024);
    const float* cvec = INP(I_C);
    const int rg = F.lane >> 4, c4 = (F.lane & 15) * 4;
    bool staged = false;
    for (int item = F.bid; item < 2 * 96; item += F.G) {
        const int l = item / 96, n0 = (item % 96) * 64;
        const float* W = INP(I_ADA_W) + (size_t)l * 1024 * 6144 + n0 + c4;
        const int kbeg = F.wave * 128 + rg;
        f32x4 w[32];
#pragma unroll
        for (int i = 0; i < 32; ++i) w[i] = *(const f32x4*)(W + (size_t)(kbeg + 4 * i) * 6144);
        float bias = 0.f;
        if (F.tid < 128) bias = INP(I_ADA_B)[l * 6144 + n0 + (F.tid & 63)];
        if (!staged) { staged = true;
#pragma unroll
            for (int k = 0; k < 4; ++k) sc[F.tid + 512 * k] = siluf_(cvec[F.tid + 512 * k]);
            __syncthreads(); }
        f32x4 a0 = (f32x4){0.f, 0.f, 0.f, 0.f}, a1 = a0;
#pragma unroll
        for (int i = 0; i < 32; ++i) { const int k = kbeg + 4 * i; a0 += sc[k] * w[i]; a1 += sc[1024 + k] * w[i]; }
#pragma unroll
        for (int u = 0; u < 4; ++u) { a0[u] += __shfl_xor(a0[u], 16); a0[u] += __shfl_xor(a0[u], 32); a1[u] += __shfl_xor(a1[u], 16); a1[u] += __shfl_xor(a1[u], 32); }
        if (rg == 0) { *(LAS f32x4*)(red + (F.wave * 2 + 0) * 64 + c4) = a0; *(LAS f32x4*)(red + (F.wave * 2 + 1) * 64 + c4) = a1; }
        __syncthreads();
        if (F.tid < 128) { const int b = F.tid >> 6, ln = F.tid & 63; float s = 0.f;
#pragma unroll
            for (int w8 = 0; w8 < 8; ++w8) s += red[(w8 * 2 + b) * 64 + ln];
            mod[(size_t)(l * 2 + b) * 6144 + n0 + ln] = s + bias; }
        __syncthreads();
    }
}

constexpr size_t WS_TEXP = 640 * 1024;
__device__ __forceinline__ void phase_ln(Frame& F, int kind, const float* lg, const float* lb, int gt_layer, int gt_off, int h_layer, int sh_off, int sc_off, bool route, bool last) {
    LAUNDER(F);
    const float* mod = (const float*)(F.ws + WS_MOD);
    float* X = F.a->out;
    const float* YF = (const float*)(F.ws + WS_YF);
    bf16_t* H = (bf16_t*)(F.ws + WS_H);
    const int gw = F.bid * NWAVES + F.wave, NGW = F.G * NWAVES;
    int nsp = 1, nsr = 0, pm_split = 1 << 30;
    if (kind == 3) { const int nrt = ((const int*)(F.ws + WS_TEXP))[MOE_RT_MAX]; pg8::moe2_split(nrt, F.G, nsr, nsp); pm_split = nrt - nsr; }
    float rb8[8];
#pragma unroll
    for (int e = 0; e < 8; ++e) rb8[e] = 0.f;
    if (route) {
        const f32x4* src = (const f32x4*)INP(I_MOE_R);
#pragma unroll
        for (int k = 0; k < 4; ++k) { const int idx = F.tid + 512 * k, c = idx >> 1, e4 = (idx & 1) * 4; const f32x4 w = src[idx];
#pragma unroll
            for (int u = 0; u < 4; ++u) ((LAS float*)F.lds)[(e4 + u) * 1024 + c] = w[u]; }
        if (F.tid < 16) ((LAS unsigned*)(F.lds + 32768))[F.tid] = 0u;
#pragma unroll
        for (int e = 0; e < 8; ++e) rb8[e] = INP(I_MOE_RB)[e];
        __syncthreads();
    }
    f32x4 G4[4], B4[4], GT[4], SH[4], SC[4];
#pragma unroll
    for (int j = 0; j < 4; ++j) { G4[j] = ((const f32x4*)lg + F.lane)[64 * j]; B4[j] = ((const f32x4*)lb + F.lane)[64 * j]; GT[j] = SH[j] = SC[j] = (f32x4){0.f, 0.f, 0.f, 0.f}; }
    int bcur = -1;
    f32x4 cX[4], nX[4]; u32x2 cA[4], nA[4], cB[4], nB[4];
    int2 rrc = make_int2(0, 0), rrn = make_int2(0, 0); float2 ggc = make_float2(0.f, 0.f), ggn = make_float2(0.f, 0.f);
#pragma unroll
    for (int j = 0; j < 4; ++j) { cX[j] = nX[j] = (f32x4){0.f, 0.f, 0.f, 0.f}; cA[j] = nA[j] = cB[j] = nB[j] = (u32x2){0u, 0u}; }
#define LN_ISSUE(row_, X_, A_, B_, rr_) do { \
        if (kind == 0) { const f32x4* xr_ = (const f32x4*)(INP(I_X) + (size_t)(row_) * D) + F.lane; _Pragma("unroll") for (int j = 0; j < 4; ++j) X_[j] = xr_[64 * j]; } \
        else { const f32x4* xr_ = (const f32x4*)(X + (size_t)(row_) * D) + F.lane; _Pragma("unroll") for (int j = 0; j < 4; ++j) X_[j] = xr_[64 * j]; \
            if (kind == 1) { const u32x2* yr_ = (const u32x2*)((const bf16_t*)YF + (size_t)(row_) * D) + F.lane; _Pragma("unroll") for (int j = 0; j < 4; ++j) A_[j] = yr_[64 * j]; } \
            else { const bf16_t* ym_ = (const bf16_t*)(F.ws + WS_MY); const u32x2* y0_ = (const u32x2*)(ym_ + (size_t)(rr_).x * D) + F.lane; const u32x2* y1_ = (const u32x2*)(ym_ + (size_t)(rr_).y * D) + F.lane; \
                _Pragma("unroll") for (int j = 0; j < 4; ++j) { A_[j] = y0_[64 * j]; B_[j] = y1_[64 * j]; } } } } while (0)
    if (kind == 3 && gw < NTOK) { rrc = ((const int2*)(F.ws + WS_TOPP))[gw]; ggc = ((const float2*)(F.ws + WS_TOPG))[gw]; if (gw + NGW < NTOK) { rrn = ((const int2*)(F.ws + WS_TOPP))[gw + NGW]; ggn = ((const float2*)(F.ws + WS_TOPG))[gw + NGW]; } }
    if (gw < NTOK) LN_ISSUE(gw, cX, cA, cB, rrc);
    for (int row = gw; row < NTOK; row += NGW) {
        const int b = row / SEQ;
        int2 rrn2 = make_int2(0, 0); float2 ggn2 = make_float2(0.f, 0.f);
        if (row + NGW < NTOK) {
            if (kind == 3 && row + 2 * NGW < NTOK) { rrn2 = ((const int2*)(F.ws + WS_TOPP))[row + 2 * NGW]; ggn2 = ((const float2*)(F.ws + WS_TOPG))[row + 2 * NGW]; }
            LN_ISSUE(row + NGW, nX, nA, nB, rrn);
        }
        if (b != bcur) { bcur = b;
            if (kind != 0) { const f32x4* gt = (const f32x4*)(mod + (size_t)(gt_layer * 2 + b) * 6144 + gt_off) + F.lane;
#pragma unroll
                for (int j = 0; j < 4; ++j) GT[j] = gt[64 * j]; }
            if (!last) { const f32x4* sh = (const f32x4*)(mod + (size_t)(h_layer * 2 + b) * 6144 + sh_off) + F.lane; const f32x4* sc = (const f32x4*)(mod + (size_t)(h_layer * 2 + b) * 6144 + sc_off) + F.lane;
#pragma unroll
                for (int j = 0; j < 4; ++j) { SH[j] = sh[64 * j]; SC[j] = sc[64 * j]; } } }
        f32x4 v[4];
        if (kind == 0) {
#pragma unroll
            for (int j = 0; j < 4; ++j) v[j] = cX[j];
        } else if (kind == 1) {
#pragma unroll
            for (int j = 0; j < 4; ++j) v[j] = DN_ALPHA * cX[j] + (1.f + GT[j]) * unpack4(cA[j]);
        } else {
            const float2 gg = ggc;
            const int rx = __builtin_amdgcn_readfirstlane(rrc.x), ry = __builtin_amdgcn_readfirstlane(rrc.y);
            if (((rx >> 8) < pm_split) & ((ry >> 8) < pm_split)) {
#pragma unroll
                for (int j = 0; j < 4; ++j) { const u32x2 p = cA[j], q = cB[j];
                    f32x4 y; y[0] = gg.x * __uint_as_float(p.x << 16) + gg.y * __uint_as_float(q.x << 16); y[1] = gg.x * __uint_as_float(p.x & 0xffff0000u) + gg.y * __uint_as_float(q.x & 0xffff0000u);
                    y[2] = gg.x * __uint_as_float(p.y << 16) + gg.y * __uint_as_float(q.y << 16); y[3] = gg.x * __uint_as_float(p.y & 0xffff0000u) + gg.y * __uint_as_float(q.y & 0xffff0000u);
                    v[j] = DN_ALPHA * cX[j] + (1.f + GT[j]) * y; }
            } else {
                const float* part = (const float*)(F.ws + WS_MA);
#pragma unroll
                for (int j = 0; j < 4; ++j) {
                    f32x4 ya, yb;
                    if ((rx >> 8) < pm_split) ya = unpack4(cA[j]);
                    else { const f32x4* pp = (const f32x4*)(part + (size_t)((j * nsr + (rx >> 8) - pm_split) * nsp) * 65536 + (rx & 255) * 256) + F.lane; f32x4 tq[7];
#pragma unroll
                        for (int q = 0; q < 7; ++q) tq[q] = (q < nsp) ? pp[(size_t)q * 16384] : (f32x4){0.f, 0.f, 0.f, 0.f};
                        ya = unpack4(pack4(((tq[0] + tq[1]) + (tq[2] + tq[3])) + ((tq[4] + tq[5]) + tq[6]))); }
                    if ((ry >> 8) < pm_split) yb = unpack4(cB[j]);
                    else { const f32x4* pp = (const f32x4*)(part + (size_t)((j * nsr + (ry >> 8) - pm_split) * nsp) * 65536 + (ry & 255) * 256) + F.lane; f32x4 tq[7];
#pragma unroll
                        for (int q = 0; q < 7; ++q) tq[q] = (q < nsp) ? pp[(size_t)q * 16384] : (f32x4){0.f, 0.f, 0.f, 0.f};
                        yb = unpack4(pack4(((tq[0] + tq[1]) + (tq[2] + tq[3])) + ((tq[4] + tq[5]) + tq[6]))); }
                    v[j] = DN_ALPHA * cX[j] + (1.f + GT[j]) * (gg.x * ya + gg.y * yb); }
            }
        }
#pragma unroll
        for (int j = 0; j < 4; ++j) { cX[j] = nX[j]; cA[j] = nA[j]; cB[j] = nB[j]; }
        rrc = rrn; ggc = ggn; rrn = rrn2; ggn = ggn2;
        float s = 0.f;
#pragma unroll
        for (int j = 0; j < 4; ++j) s += (v[j][0] + v[j][1]) + (v[j][2] + v[j][3]);
        const float mean = wave_sum(s) * (1.f / D); float s2 = 0.f;
#pragma unroll
        for (int j = 0; j < 4; ++j) { v[j] = v[j] - mean; s2 += (v[j][0] * v[j][0] + v[j][1] * v[j][1]) + (v[j][2] * v[j][2] + v[j][3] * v[j][3]); }
        const float rstd = 1.f / sqrtf(wave_sum(s2) * (1.f / D) + LN_EPS);
        f32x4* xo = (f32x4*)(X + (size_t)row * D) + F.lane;
#pragma unroll
        for (int j = 0; j < 4; ++j) { v[j] = v[j] * rstd * G4[j] + B4[j]; xo[64 * j] = v[j]; }
        if (!last) {
            u32x2* ho = (u32x2*)(H + (size_t)row * D) + F.lane;
#pragma unroll
            for (int j = 0; j < 4; ++j) { v[j] = v[j] * (1.f + SC[j]) + SH[j]; u32x2 w; w.x = pk2(v[j][0], v[j][1]); w.y = pk2(v[j][2], v[j][3]); ho[64 * j] = w; }
            if (route) {
                const LAS float* rw = (const LAS float*)F.lds; float lg8[8];
#pragma unroll
                for (int e = 0; e < 8; ++e) lg8[e] = 0.f;
#pragma unroll
                for (int j = 0; j < 4; ++j)
#pragma unroll
                    for (int e = 0; e < 8; ++e) { const f32x4 w4 = *(const LAS f32x4*)(rw + e * 1024 + 4 * F.lane + 256 * j);
                        lg8[e] += (v[j][0] * w4[0] + v[j][1] * w4[1]) + (v[j][2] * w4[2] + v[j][3] * w4[3]); }
                const bool h5 = (F.lane & 32) != 0, h4 = (F.lane & 16) != 0, h3 = (F.lane & 8) != 0;
                float a4[4], a2[2], a1;
#pragma unroll
                for (int i = 0; i < 4; ++i) a4[i] = (h5 ? lg8[i + 4] : lg8[i]) + __shfl_xor(h5 ? lg8[i] : lg8[i + 4], 32);
#pragma unroll
                for (int i = 0; i < 2; ++i) a2[i] = (h4 ? a4[i + 2] : a4[i]) + __shfl_xor(h4 ? a4[i] : a4[i + 2], 16);
                a1 = (h3 ? a2[1] : a2[0]) + __shfl_xor(h3 ? a2[0] : a2[1], 8);
                a1 += __shfl_xor(a1, 4); a1 += __shfl_xor(a1, 2); a1 += __shfl_xor(a1, 1);
#pragma unroll
                for (int e = 0; e < 8; ++e) lg8[e] = __shfl(a1, ((e >> 2) & 1) * 32 + ((e >> 1) & 1) * 16 + (e & 1) * 8) + rb8[e];
                int e0 = 0; float l0 = lg8[0];
#pragma unroll
                for (int e = 1; e < 8; ++e) if (lg8[e] > l0) { l0 = lg8[e]; e0 = e; }
                int e1 = (e0 == 0) ? 1 : 0; float l1 = -3.0e38f;
#pragma unroll
                for (int e = 0; e < 8; ++e) if (e != e0 && lg8[e] > l1) { l1 = lg8[e]; e1 = e; }
                if (F.lane == 0) {
                    const float g0 = 1.f / (1.f + __expf(l1 - l0));
                    LAS unsigned* lc = (LAS unsigned*)(F.lds + 32768);
                    const int p0 = (int)atomicAdd((unsigned*)(lc + e0), 1u), p1 = (int)atomicAdd((unsigned*)(lc + e1), 1u);
                    ((int2*)(F.ws + WS_TOPE))[row] = make_int2(e0, e1); ((float2*)(F.ws + WS_TOPG))[row] = make_float2(g0, 1.f - g0); ((int2*)(F.ws + WS_TOPP))[row] = make_int2(p0, p1);
                }
            }
        }
    }
#undef LN_ISSUE
    if (route) {
        __syncthreads();
        LAS unsigned* lc = (LAS unsigned*)(F.lds + 32768);
        if (F.tid < 8) lc[8 + F.tid] = atomicAdd((unsigned*)(F.ws + WS_CTL) + CW_CNT + F.tid, lc[F.tid]);
        __syncthreads();
        if (F.tid < 64) { const int row = F.bid * NWAVES + (F.tid & 7) + (F.tid >> 3) * NGW;
            if (row < NTOK) { const int2 ee = ((const int2*)(F.ws + WS_TOPE))[row]; int2 pp = ((int2*)(F.ws + WS_TOPP))[row]; pp.x += (int)lc[8 + ee.x]; pp.y += (int)lc[8 + ee.y]; ((int2*)(F.ws + WS_TOPP))[row] = pp; } }
    }
}

__device__ __forceinline__ void phase_moe_setup(Frame& F) {
    LAUNDER(F);
    const unsigned* cnt = (const unsigned*)(F.ws + WS_CTL) + CW_CNT;
    int pstart[8]; int tot = 0;
#pragma unroll
    for (int e = 0; e < 8; ++e) { pstart[e] = tot; tot += ((int)cnt[e] + 255) / 256 * 256; }
    int* texp = (int*)(F.ws + WS_TEXP);
    if (F.bid == 0 && F.tid < MOE_RT_MAX + 1) {
        if (F.tid == MOE_RT_MAX) texp[MOE_RT_MAX] = tot / 256;
        else { int e = 0;
#pragma unroll
            for (int q = 1; q < 8; ++q) if (F.tid * 256 >= pstart[q]) e = q;
            texp[F.tid] = e; }
    }
    const bf16_t* H = (const bf16_t*)(F.ws + WS_H); bf16_t* MA = (bf16_t*)(F.ws + WS_MA);
    const int gw = F.bid * NWAVES + F.wave, NGW = F.G * NWAVES;
    for (int base = gw; base < NTOK; base += 8 * NGW) {
        int2 ee[8], pp[8]; u32x4 va[8], vb[8];
#pragma unroll
        for (int k = 0; k < 8; ++k) { const int row = base + k * NGW;
            if (row < NTOK) { ee[k] = ((const int2*)(F.ws + WS_TOPE))[row]; pp[k] = ((const int2*)(F.ws + WS_TOPP))[row];
                const u32x4* src = (const u32x4*)(H + (size_t)row * D) + F.lane; va[k] = src[0]; vb[k] = src[64]; } }
#pragma unroll
        for (int k = 0; k < 8; ++k) { const int row = base + k * NGW;
            if (row < NTOK) { int r0 = pp[k].x, r1 = pp[k].y;
#pragma unroll
                for (int e = 0; e < 8; ++e) { if (ee[k].x == e) r0 += pstart[e]; if (ee[k].y == e) r1 += pstart[e]; }
                u32x4* d0 = (u32x4*)(MA + (size_t)r0 * D) + F.lane; u32x4* d1 = (u32x4*)(MA + (size_t)r1 * D) + F.lane;
                d0[0] = va[k]; d0[64] = vb[k]; d1[0] = va[k]; d1[64] = vb[k];
                if (F.lane == 0) ((int2*)(F.ws + WS_TOPP))[row] = make_int2(r0, r1); } }
    }
}

__device__ __forceinline__ float capf_(float t) { return 15.f * tanhf_(t * (1.f / 15.f)); }
__device__ __forceinline__ const LAS bf16x8* vec8_ptr(const LAS bf16_t*) { return nullptr; }
__device__ __forceinline__ const LAS bf16x8* vec8_ptr(LAS bf16_t*) { return nullptr; }
__device__ __forceinline__ const bf16x8* vec8_ptr(const bf16_t*) { return nullptr; }
template <int K, class PA, class PB> __device__ __forceinline__ f32x4 mma_tile(PA A, int lda, PB Bt, int ldb, int m0, int n0, f32x4 acc, int lane) {
    const int r = lane & 15, q = lane >> 4;
#pragma unroll
    for (int k0 = 0; k0 < K; k0 += 32) {
        const bf16x8 a = *(decltype(vec8_ptr(A)))(A + (m0 + r) * lda + k0 + 8 * q);
        const bf16x8 b = *(decltype(vec8_ptr(Bt)))(Bt + (n0 + r) * ldb + k0 + 8 * q);
        acc = __builtin_amdgcn_mfma_f32_16x16x32_bf16(a, b, acc, 0, 0, 0);
    }
    return acc;
}
__device__ __forceinline__ float wave_incl_scan(float x, int lane) {
#pragma unroll
    for (int o = 1; o < 64; o <<= 1) { const float y = __shfl_up(x, o); if (lane >= o) x += y; }
    return x;
}

__device__ __forceinline__ unsigned pf_load(const void* p) { unsigned v; asm volatile("global_load_dword %0, %1, off" : "=v"(v) : "v"(p) : "memory"); return v; }
__device__ __forceinline__ void pf_done(unsigned& v) { asm volatile("s_waitcnt vmcnt(0)" : "+v"(v) :: "memory"); }
__device__ __forceinline__ unsigned pf_gdn_sa(const unsigned char* ws, int item, int tid) {
    unsigned v = 0; if (item >= 1024) return v;
    const int bh = item >> 7, c = item & 127, b = bh >> 2, h = bh & 3, row0 = b * SEQ + c * 64; const bf16_t* Z = (const bf16_t*)(ws + WS_Z);
    if (tid < 402) { const int row = tid / 6, seg = tid % 6, g = seg >> 1; if (c > 0 || row >= 3) v = pf_load(Z + (size_t)(row0 - 3 + row) * ZW + (g == 0 ? ZC_GQ : (g == 1 ? ZC_GK : ZC_GV)) + h * 128 + (seg & 1) * 64); }
    else if (tid < 466) v = pf_load(Z + (size_t)(row0 + tid - 402) * ZW + ZC_GA);
    return v;
}
__device__ __forceinline__ unsigned pf_rw_sa(const unsigned char* ws, int item, int tid) {
    unsigned v = 0; if (item >= 2048) return v;
    const int bh = item >> 7, c = item & 127, b = bh >> 3, h = bh & 7, row0 = b * SEQ + c * 64; const bf16_t* Z = (const bf16_t*)(ws + WS_Z);
    const int row = tid >> 3, seg = tid & 7;
    if (c > 0 || row >= 1) { const bf16_t* zr = Z + (size_t)(row0 - 1 + row) * ZW;
        v = pf_load(seg < 3 ? zr + (seg == 0 ? ZC_RR : (seg == 1 ? ZC_RK : ZC_RV)) + h * 64 : (seg < 7 ? zr + ZC_RW + (seg - 3) * 64 : zr + ZC_XV)); }
    return v;
}
constexpr size_t WS_MLB = WS_S + 97 * MB;
constexpr size_t WS_MLT = WS_S + 113 * MB;
constexpr size_t WS_MLN = WS_S + 114 * MB;
__device__ __forceinline__ void ml_gates(Frame& F, int l, int h, int row0, LAS float* bc, LAS float* li) {
    if (F.wave == 0) {
        const bf16_t* Z = (const bf16_t*)(F.ws + WS_Z) + (size_t)(row0 + F.lane) * ZW;
        const float ip = bf2f(Z[ZC_MI + h]) + INP(I_ML_BI)[l * 4 + h], fp = bf2f(Z[ZC_MF + h]) + INP(I_ML_BF)[l * 4 + h];
        const float lf = -softplusf_(-capf_(fp));
        bc[F.lane] = wave_incl_scan(lf, F.lane); li[F.lane] = capf_(ip);
    }
}
__device__ __forceinline__ void ml_sa_item(Frame& F, int l, int item) {
    LAUNDER(F);
    const int bh = item >> 7, c = item & 127, b = bh >> 2, h = bh & 3, row0 = b * SEQ + c * 64;
    LAS float* bc = (LAS float*)F.lds; LAS float* li = bc + 64;
    LAS bf16_t* KwT = (LAS bf16_t*)(F.lds + 1024); LAS bf16_t* VT = (LAS bf16_t*)(F.lds + 10240);
    const bf16_t* Z = (const bf16_t*)(F.ws + WS_Z);
    ml_gates(F, l, h, row0, bc, li);
    __syncthreads();
    {
        const int t = F.tid & 63, u = F.tid >> 6; const bf16_t* zr = Z + (size_t)(row0 + t) * ZW;
        const float ew = __expf(bc[63] - bc[t] + li[t]) * 0.125f;
        const u32x4 kq = *(const u32x4*)(zr + ZC_MK + h * 64 + 8 * u);
        const unsigned kw[4] = {kq.x, kq.y, kq.z, kq.w};
#pragma unroll
        for (int j = 0; j < 4; ++j) { KwT[(8 * u + 2 * j) * 72 + t] = f2bfh(__uint_as_float(kw[j] << 16) * ew); KwT[(8 * u + 2 * j + 1) * 72 + t] = f2bfh(__uint_as_float(kw[j] & 0xffff0000u) * ew); }
#pragma unroll
        for (int p = 0; p < 2; ++p) { const u32x4 vq = *(const u32x4*)(zr + ZC_MV + h * 128 + 64 * p + 8 * u); const unsigned vw[4] = {vq.x, vq.y, vq.z, vq.w};
#pragma unroll
            for (int j = 0; j < 4; ++j) { VT[(64 * p + 8 * u + 2 * j) * 72 + t] = (bf16_t)(vw[j] & 0xffff); VT[(64 * p + 8 * u + 2 * j + 1) * 72 + t] = (bf16_t)(vw[j] >> 16); } }
    }
    __syncthreads();
    bf16_t* BT = (bf16_t*)(F.ws + WS_MLB) + (size_t)item * 128 * 64;
    {
        const int mt = F.wave & 3, q = F.lane >> 4, cl = F.lane & 15;
#pragma unroll
        for (int j = 0; j < 4; ++j) { const int nt = 4 * (F.wave >> 2) + j;
            const f32x4 acc = mma_tile<64>(KwT, 72, VT, 72, 16 * mt, 16 * nt, (f32x4){0.f, 0.f, 0.f, 0.f}, F.lane);
            *(u32x2*)(BT + (size_t)(16 * nt + cl) * 64 + 16 * mt + 4 * q) = pack4(acc); }
    }
    if (F.wave == 0) {
        float s = 0.f;
#pragma unroll
        for (int j = 0; j < 8; ++j) { const bf16x8 v8 = *(const LAS bf16x8*)(KwT + F.lane * 72 + 8 * j);
#pragma unroll
            for (int e = 0; e < 8; ++e) s += bf2f((bf16_t)v8[e]); }
        float* tb = (float*)(F.ws + WS_MLT) + (size_t)item * 66; tb[F.lane] = s; if (F.lane == 0) tb[64] = __expf(bc[63]);
    }
    __syncthreads();
}
__device__ __forceinline__ void ml_scan(Frame& F, int vblk, int nblk) {
    const float* tb = (const float*)(F.ws + WS_MLT);
    if (vblk >= 0) {
        const int bh = vblk >> 1, e0 = (vblk & 1) * 4096 + F.tid * 8;
        bf16_t* base = (bf16_t*)(F.ws + WS_MLB) + (size_t)bh * 128 * 8192 + e0;
        const float* glp = tb + (size_t)(bh * 128) * 66 + 64;
        float C[8];
#pragma unroll
        for (int j = 0; j < 8; ++j) C[j] = 0.f;
        u32x4 bufA[8], bufB[8]; float glA[8], glB[8];
#define ML_LOAD(buf, gl, c0) do { _Pragma("unroll") for (int k = 0; k < 8; ++k) { buf[k] = *(const u32x4*)(base + (size_t)((c0) + k) * 8192); gl[k] = glp[(size_t)((c0) + k) * 66]; } } while (0)
#define ML_STEP(buf, gl, c0) do { _Pragma("unroll") for (int k = 0; k < 8; ++k) { \
            u32x4 o; o.x = pk2(C[0], C[1]); o.y = pk2(C[2], C[3]); o.z = pk2(C[4], C[5]); o.w = pk2(C[6], C[7]); *(u32x4*)(base + (size_t)((c0) + k) * 8192) = o; \
            const unsigned w[4] = {buf[k].x, buf[k].y, buf[k].z, buf[k].w}; \
            _Pragma("unroll") for (int j = 0; j < 4; ++j) { C[2 * j] = gl[k] * C[2 * j] + __uint_as_float(w[j] << 16); C[2 * j + 1] = gl[k] * C[2 * j + 1] + __uint_as_float(w[j] & 0xffff0000u); } } } while (0)
        ML_LOAD(bufA, glA, 0);
        for (int c = 0; c < 128; c += 16) {
            ML_LOAD(bufB, glB, c + 8);
            ML_STEP(bufA, glA, c);
            if (c + 16 < 128) ML_LOAD(bufA, glA, c + 16);
            ML_STEP(bufB, glB, c + 8);
        }
#undef ML_LOAD
#undef ML_STEP
    }
    if (nblk >= 0 && F.tid < 512) {
        const int bh = F.tid >> 6, k = F.tid & 63; float n = 0.f; float* N = (float*)(F.ws + WS_MLN);
        float sv[8], gv[8];
        for (int c = 0; c < 128; c += 8) {
#pragma unroll
            for (int j = 0; j < 8; ++j) { const size_t it = (size_t)(bh * 128 + c + j); sv[j] = tb[it * 66 + k]; gv[j] = tb[it * 66 + 64]; }
#pragma unroll
            for (int j = 0; j < 8; ++j) { const size_t it = (size_t)(bh * 128 + c + j); N[it * 64 + k] = n; n = gv[j] * n + sv[j]; } }
    }
}
__device__ __forceinline__ void ml_sc_item(Frame& F, int l, int item) {
    LAUNDER(F);
    const int bh = item >> 7, c = item & 127, b = bh >> 2, h = bh & 3, row0 = b * SEQ + c * 64;
    LAS float* bc = (LAS float*)F.lds; LAS float* li = bc + 64; LAS float* den = bc + 128; LAS float* nn = bc + 192; LAS float* ssq = bc + 256; LAS float* denp = (LAS float*)(F.lds + 75776);
    LAS bf16_t* Qt = (LAS bf16_t*)(F.lds + 2048); LAS bf16_t* Qd = (LAS bf16_t*)(F.lds + 11264); LAS bf16_t* Kt = (LAS bf16_t*)(F.lds + 20480);
    LAS bf16_t* VT = (LAS bf16_t*)(F.lds + 29696); LAS bf16_t* CT = (LAS bf16_t*)(F.lds + 48128); LAS bf16_t* P = (LAS bf16_t*)(F.lds + 66560);
    const bf16_t* Z = (const bf16_t*)(F.ws + WS_Z);
    ml_gates(F, l, h, row0, bc, li);
    if (F.tid < 64) { den[F.tid] = 0.f; nn[F.tid] = ((const float*)(F.ws + WS_MLN))[(size_t)item * 64 + F.tid]; }
    __syncthreads();
    {
        const int t = F.tid & 63, u = F.tid >> 6; const bf16_t* zr = Z + (size_t)(row0 + t) * ZW; const float ed = __expf(bc[t]);
        const u32x4 qq = *(const u32x4*)(zr + ZC_MQ + h * 64 + 8 * u), kq = *(const u32x4*)(zr + ZC_MK + h * 64 + 8 * u);
        *(u32x4*)(Qt + t * 72 + 8 * u) = qq;
        const unsigned qw[4] = {qq.x, qq.y, qq.z, qq.w}, kw[4] = {kq.x, kq.y, kq.z, kq.w}; u32x4 qd, ks; unsigned* qdp = (unsigned*)&qd; unsigned* ksp = (unsigned*)&ks;
#pragma unroll
        for (int j = 0; j < 4; ++j) { qdp[j] = pk2(__uint_as_float(qw[j] << 16) * ed, __uint_as_float(qw[j] & 0xffff0000u) * ed); ksp[j] = pk2(__uint_as_float(kw[j] << 16) * 0.125f, __uint_as_float(kw[j] & 0xffff0000u) * 0.125f); }
        *(u32x4*)(Qd + t * 72 + 8 * u) = qd; *(u32x4*)(Kt + t * 72 + 8 * u) = ks;
#pragma unroll
        for (int p = 0; p < 2; ++p) { const u32x4 vq = *(const u32x4*)(zr + ZC_MV + h * 128 + 64 * p + 8 * u); const unsigned vw[4] = {vq.x, vq.y, vq.z, vq.w};
#pragma unroll
            for (int j = 0; j < 4; ++j) { VT[(64 * p + 8 * u + 2 * j) * 72 + t] = (bf16_t)(vw[j] & 0xffff); VT[(64 * p + 8 * u + 2 * j + 1) * 72 + t] = (bf16_t)(vw[j] >> 16); } }
        const bf16_t* ct = (const bf16_t*)(F.ws + WS_MLB) + (size_t)item * 128 * 64;
#pragma unroll
        for (int p = 0; p < 2; ++p) { const int e = F.tid + 512 * p, rr = e >> 3, cc = (e & 7) * 8; *(u32x4*)(CT + rr * 72 + cc) = *(const u32x4*)(ct + rr * 64 + cc); }
    }
    __syncthreads();
    {
        const int q = F.lane >> 4, cl = F.lane & 15;
#pragma unroll
        for (int j = 0; j < 2; ++j) { const int tile = F.wave * 2 + j, mt = tile & 3, nt = tile >> 2;
            f32x4 acc = mma_tile<64>(Kt, 72, Qt, 72, 16 * mt, 16 * nt, (f32x4){0.f, 0.f, 0.f, 0.f}, F.lane);
            const int t = 16 * nt + cl; const float bt = bc[t]; float part = 0.f;
#pragma unroll
            for (int r = 0; r < 4; ++r) { const int sidx = 16 * mt + 4 * q + r; const float v = (sidx <= t) ? acc[r] * __expf(bt - bc[sidx] + li[sidx]) : 0.f; const float vr = bf2f(f2bfh(v)); acc[r] = vr; part += vr; }
            *(u32x2*)(P + t * 72 + 16 * mt + 4 * q) = pack4(acc);
            part += __shfl_xor(part, 16); part += __shfl_xor(part, 32);
            if (q == 0) denp[t * 4 + mt] = part;
        }
    }
    __syncthreads();
    if (F.tid < 64) {
        float d = 0.f;
#pragma unroll
        for (int j = 0; j < 8; ++j) { const bf16x8 v8 = *(const LAS bf16x8*)(Qd + F.tid * 72 + 8 * j);
#pragma unroll
            for (int e = 0; e < 8; ++e) d += bf2f((bf16_t)v8[e]) * nn[8 * j + e]; }
        den[F.tid] = d + (denp[F.tid * 4] + denp[F.tid * 4 + 1]) + (denp[F.tid * 4 + 2] + denp[F.tid * 4 + 3]);
    }
    const int nt = F.wave >> 1, q = F.lane >> 4, cl = F.lane & 15, t = 16 * nt + cl;
    f32x4 acc[4];
#pragma unroll
    for (int j = 0; j < 4; ++j) { const int mt = 4 * (F.wave & 1) + j;
        acc[j] = mma_tile<64>(CT, 72, Qd, 72, 16 * mt, 16 * nt, (f32x4){0.f, 0.f, 0.f, 0.f}, F.lane);
        acc[j] = mma_tile<64>(VT, 72, P, 72, 16 * mt, 16 * nt, acc[j], F.lane); }
    __syncthreads();
    {
        const float dinv = 1.f / fmaxf(fabsf(den[t]), 1.f); float sq = 0.f;
#pragma unroll
        for (int j = 0; j < 4; ++j) { acc[j] = acc[j] * dinv; sq += (acc[j][0] * acc[j][0] + acc[j][1] * acc[j][1]) + (acc[j][2] * acc[j][2] + acc[j][3] * acc[j][3]); }
        sq += __shfl_xor(sq, 16); sq += __shfl_xor(sq, 32);
        if (q == 0) ssq[t * 2 + (F.wave & 1)] = sq;
    }
    __syncthreads();
    {
        const float rms = rsqrtf((ssq[t * 2] + ssq[t * 2 + 1]) * (1.f / 128.f) + 1e-6f);
        const float* ng = INP(I_ML_NG) + l * 512 + h * 128; bf16_t* Y = (bf16_t*)(F.ws + WS_Y) + (size_t)(row0 + t) * 1536 + 512 + h * 128; const bf16_t* zo = Z + (size_t)(row0 + t) * ZW + ZC_MO + h * 128;
#pragma unroll
        for (int j = 0; j < 4; ++j) { const int v0 = 16 * (4 * (F.wave & 1) + j) + 4 * q; const f32x4 g4 = *(const f32x4*)(ng + v0); const f32x4 o4 = unpack4(*(const u32x2*)(zo + v0));
            f32x4 y;
#pragma unroll
            for (int r = 0; r < 4; ++r) y[r] = acc[j][r] * rms * g4[r] * sigmoidf_(o4[r]);
            *(u32x2*)(Y + v0) = pack4(y); }
    }
    __syncthreads();
}


template <int DK, bool VEC_G>
__device__ __forceinline__ void scan_block(Frame& F, const bf16_t* gM, bf16_t* gS, const float* gG, const int slice0) {
    constexpr int MT = DK / 16, KS = DK / 32, LD = DK + 8, SLOT = DK * LD * 2 + (VEC_G ? DK * 4 : 0), CH = DK * DK, NP = CH / 8 / 256;
    if (F.wave >= 4) {
        const int lt = F.tid - 256;
        u32x4 R[4][NP]; float Gr[4];
#define SCL_LOAD(j, c_) do { const bf16_t* m_ = gM + (size_t)(c_) * CH; _Pragma("unroll") for (int k = 0; k < NP; ++k) { const int e = lt + 256 * k; R[j][k] = *(const u32x4*)(m_ + (e / (DK / 8)) * DK + (e % (DK / 8)) * 8); } \
            if (VEC_G) Gr[j] = gG[(size_t)(c_) * DK + (lt & (DK - 1))]; } while (0)
#define SCL_WRITE(j, slot) do { LAS unsigned char* sb_ = F.lds + (slot) * SLOT; _Pragma("unroll") for (int k = 0; k < NP; ++k) { const int e = lt + 256 * k; *(u32x4*)((LAS bf16_t*)sb_ + (e / (DK / 8)) * LD + (e % (DK / 8)) * 8) = R[j][k]; } \
            if (VEC_G) { if (lt < DK) ((LAS float*)(sb_ + DK * LD * 2))[lt] = Gr[j]; } } while (0)
        SCL_LOAD(0, 0); SCL_LOAD(1, 1); SCL_LOAD(2, 2); SCL_LOAD(3, 3);
        SCL_WRITE(0, 0); SCL_LOAD(0, 4);
        __syncthreads();
        for (int c = 0; c < 128; c += 4) {
            SCL_WRITE(1, 1); SCL_LOAD(1, (c + 5 < 128 ? c + 5 : 127)); __syncthreads();
            SCL_WRITE(2, 0); SCL_LOAD(2, (c + 6 < 128 ? c + 6 : 127)); __syncthreads();
            SCL_WRITE(3, 1); SCL_LOAD(3, (c + 7 < 128 ? c + 7 : 127)); __syncthreads();
            SCL_WRITE(0, 0); SCL_LOAD(0, (c + 8 < 128 ? c + 8 : 127)); __syncthreads();
        }
#undef SCL_LOAD
#undef SCL_WRITE
    } else {
        const int q = F.lane >> 4, cl = F.lane & 15;
        f32x4 S[MT];
#pragma unroll
        for (int m = 0; m < MT; ++m) S[m] = (f32x4){0.f, 0.f, 0.f, 0.f};
        u32x2 BA[MT], BB[MT], BC[MT], BD[MT];
        const float glv0 = VEC_G ? 0.f : gG[F.lane], glv1 = VEC_G ? 0.f : gG[64 + F.lane];
        bf16_t* sbase = gS + (size_t)(slice0 + F.wave) * (MT * 256) + F.lane * 4;
#define SCC_LOADB(buf, c_) do { _Pragma("unroll") for (int m = 0; m < MT; ++m) buf[m] = *(const u32x2*)(sbase + (size_t)(c_) * CH + m * 256); } while (0)
#define SCC_STEP(buf, c_, slot) do { const LAS bf16_t* MB = (const LAS bf16_t*)(F.lds + (slot) * SLOT); const LAS float* GB = (const LAS float*)(F.lds + (slot) * SLOT + DK * LD * 2); \
            const float gs = VEC_G ? 0.f : __uint_as_float(__builtin_amdgcn_readlane(__float_as_uint(((c_) < 64) ? glv0 : glv1), (c_) & 63)); \
            bf16x8 Bop[KS]; \
            _Pragma("unroll") for (int ks = 0; ks < KS; ++ks) { u32x4 w; w.x = cvt_pk_bf16(S[2 * ks][0], S[2 * ks][1]); w.y = cvt_pk_bf16(S[2 * ks][2], S[2 * ks][3]); w.z = cvt_pk_bf16(S[2 * ks + 1][0], S[2 * ks + 1][1]); w.w = cvt_pk_bf16(S[2 * ks + 1][2], S[2 * ks + 1][3]); Bop[ks] = *(bf16x8*)&w; } \
            bf16x8 Afr[MT][KS]; f32x4 Gf[MT]; \
            _Pragma("unroll") for (int m = 0; m < 2; ++m) { _Pragma("unroll") for (int ks = 0; ks < KS; ++ks) Afr[m][ks] = *(const LAS bf16x8*)(MB + (16 * m + cl) * LD + 32 * ks + 8 * q); } \
            _Pragma("unroll") for (int m = 0; m < MT; ++m) Gf[m] = VEC_G ? *(const LAS f32x4*)(GB + 16 * m + 4 * q) : (f32x4){gs, gs, gs, gs}; \
            _Pragma("unroll") for (int m = 0; m < MT; ++m) { u32x2 w; w.x = ((const unsigned*)&Bop[m >> 1])[2 * (m & 1)]; w.y = ((const unsigned*)&Bop[m >> 1])[2 * (m & 1) + 1]; \
                if (m + 2 < MT) { _Pragma("unroll") for (int ks = 0; ks < KS; ++ks) Afr[m + 2][ks] = *(const LAS bf16x8*)(MB + (16 * (m + 2) + cl) * LD + 32 * ks + 8 * q); }     \
                f32x4 acc = Gf[m] * S[m] + unpack4(buf[m]); \
                *(u32x2*)(sbase + (size_t)(c_) * CH + m * 256) = w; \
                _Pragma("unroll") for (int ks = 0; ks < KS; ++ks) acc = __builtin_amdgcn_mfma_f32_16x16x32_bf16(Afr[m][ks], Bop[ks], acc, 0, 0, 0); \
                S[m] = acc; } } while (0)
        SCC_LOADB(BA, 0); SCC_LOADB(BB, 1); SCC_LOADB(BC, 2); SCC_LOADB(BD, 3);
        __syncthreads();
        for (int c = 0; c < 128; c += 4) {
            SCC_STEP(BA, c, 0); SCC_LOADB(BA, (c + 4 < 128 ? c + 4 : 127)); __syncthreads();
            SCC_STEP(BB, c + 1, 1); SCC_LOADB(BB, (c + 5 < 128 ? c + 5 : 127)); __syncthreads();
            SCC_STEP(BC, c + 2, 0); SCC_LOADB(BC, (c + 6 < 128 ? c + 6 : 127)); __syncthreads();
            SCC_STEP(BD, c + 3, 1); SCC_LOADB(BD, (c + 7 < 128 ? c + 7 : 127)); __syncthreads();
        }
#undef SCC_LOADB
#undef SCC_STEP
    }
}

constexpr size_t WS_RWM = WS_S0;
constexpr size_t WS_RWS = WS_S0 + 16 * MB;
constexpr size_t WS_RWR = WS_S0 + 32 * MB;
constexpr size_t WS_RWY = WS_S0 + 48 * MB;
constexpr size_t WS_RWG = WS_S0 + 64 * MB;
constexpr size_t WS_RWB = WS_S0 + 64 * MB + 512 * 1024;
template <int CTRL> __device__ __forceinline__ float dpp_add(float x) { const int y = __builtin_amdgcn_update_dpp(0, __float_as_int(x), CTRL, 0xf, 0xf, true); return x + __int_as_float(y); }
__device__ __forceinline__ void tri_inv8(const LAS float* N, int ld, LAS bf16_t* TT, int ldt, const LAS float* colscale, int wave, int lane) {
    const int p = lane & 7, c = 8 * wave + (lane >> 3);
    const float cs = colscale ? colscale[c] : 1.f;
    float t[8];
#pragma unroll
    for (int e = 0; e < 8; ++e) t[e] = 0.f;
    for (int B = 0; B < 8; ++B) {
        f32x4 na[8], nb[8];
#pragma unroll
        for (int r = 0; r < 8; ++r) { na[r] = *(const LAS f32x4*)(N + (8 * B + r) * ld + 8 * p); nb[r] = *(const LAS f32x4*)(N + (8 * B + r) * ld + 8 * p + 4); }
#pragma unroll
        for (int g = 0; g < 2; ++g) {
            const int i0 = 8 * B + 4 * g;
            const LAS float* nd = N + i0 * ld + i0;
            const float c10 = nd[ld], c20 = nd[2 * ld], c21 = nd[2 * ld + 1], c30 = nd[3 * ld], c31 = nd[3 * ld + 1], c32 = nd[3 * ld + 2];
            float sv[4];
#pragma unroll
            for (int a = 0; a < 4; ++a) { const int r = 4 * g + a;
                sv[a] = (na[r][0] * t[0] + na[r][1] * t[1]) + (na[r][2] * t[2] + na[r][3] * t[3]) + (nb[r][0] * t[4] + nb[r][1] * t[5]) + (nb[r][2] * t[6] + nb[r][3] * t[7]); }
#pragma unroll
            for (int a = 0; a < 4; ++a) sv[a] = dpp_add<0xB1>(sv[a]);
#pragma unroll
            for (int a = 0; a < 4; ++a) sv[a] = dpp_add<0x4E>(sv[a]);
#pragma unroll
            for (int a = 0; a < 4; ++a) sv[a] = dpp_add<0x141>(sv[a]);
            const float T0 = ((i0 == c) ? 1.f : 0.f) + sv[0];
            const float T1 = ((i0 + 1 == c) ? 1.f : 0.f) + sv[1] + c10 * T0;
            const float T2 = ((i0 + 2 == c) ? 1.f : 0.f) + sv[2] + c20 * T0 + c21 * T1;
            const float T3 = ((i0 + 3 == c) ? 1.f : 0.f) + sv[3] + c30 * T0 + c31 * T1 + c32 * T2;
            const bool mine = (p == B);
            t[4 * g] = mine ? T0 : t[4 * g]; t[4 * g + 1] = mine ? T1 : t[4 * g + 1]; t[4 * g + 2] = mine ? T2 : t[4 * g + 2]; t[4 * g + 3] = mine ? T3 : t[4 * g + 3];
            TT[i0 * ldt + c] = (bf16_t)(pk2(T0 * cs, 0.f) & 0xffffu); TT[(i0 + 1) * ldt + c] = (bf16_t)(pk2(T1 * cs, 0.f) & 0xffffu);
            TT[(i0 + 2) * ldt + c] = (bf16_t)(pk2(T2 * cs, 0.f) & 0xffffu); TT[(i0 + 3) * ldt + c] = (bf16_t)(pk2(T3 * cs, 0.f) & 0xffffu);
        }
    }
}
__device__ __forceinline__ float zsh(const bf16_t* zr, int t, int col, float mu) { const float cur = bf2f(zr[col]); const float prev = t > 0 ? bf2f(zr[col - ZW]) : 0.f; return cur + mu * (prev - cur); }

__device__ __forceinline__ void rw_sa_item(Frame& F, int l, int item, int next_item) {
    LAUNDER(F);
    const int bh = item >> 7, c = item & 127, b = bh >> 3, h = bh & 7, row0 = b * SEQ + c * 64, tq0 = c * 64;
    LAS bf16_t* RAW = (LAS bf16_t*)F.lds; LAS bf16_t* XW = (LAS bf16_t*)(F.lds + 24960); LAS bf16_t* XA = (LAS bf16_t*)(F.lds + 34176); LAS bf16_t* XV = (LAS bf16_t*)(F.lds + 43392);
    LAS float* KKP = (LAS float*)(F.lds + 48640); LAS float* BPP = (LAS float*)(F.lds + 49664); LAS float* HT = (LAS float*)(F.lds + 50688);
    LAS float* AF = (LAS float*)F.lds; LAS bf16_t* LAK = (LAS bf16_t*)(F.lds + 17408); LAS bf16_t* QRB = (LAS bf16_t*)(F.lds + 26624); LAS bf16_t* QRK = (LAS bf16_t*)(F.lds + 35840); LAS bf16_t* TT = (LAS bf16_t*)(F.lds + 45056);
    LAS bf16_t* ALB = (LAS bf16_t*)(F.lds + 54272); LAS bf16_t* BEH = ALB + 4608; LAS bf16_t* KH = BEH + 4608; LAS bf16_t* RB = KH + 4608; LAS bf16_t* ALBT = RB + 4608; LAS bf16_t* VT = ALBT + 4608; LAS bf16_t* BEET = VT + 4608; LAS bf16_t* KET = BEET + 4608;
    LAS bf16_t* XT = ALB; LAS bf16_t* WUT = BEH; LAS bf16_t* U0T = KH;
    const bf16_t* Z = (const bf16_t*)(F.ws + WS_Z);
    const float* mu = INP(I_RW_MU) + l * 1792;
    const bf16_t* lorat = (const bf16_t*)(F.ws + WS_LORAT) + (size_t)l * LORAT_LAYER;
    const int q = F.lane >> 4, cl = F.lane & 15;
    for (int e = F.tid; e < 65 * 24; e += NTHREADS) { const int rr = e / 24, pc = e % 24, g = pc >> 3, cc = (pc & 7) * 8;
        u32x4 v = (u32x4){0u, 0u, 0u, 0u};
        if (rr > 0 || tq0 > 0) v = *(const u32x4*)(Z + (size_t)(row0 + rr - 1) * ZW + (g == 0 ? ZC_RR : (g == 1 ? ZC_RK : ZC_RV)) + h * 64 + cc);
        *(u32x4*)(RAW + rr * 192 + g * 64 + cc) = v; }
    {
        LAS bf16_t* RAWL = ALB;
        for (int e = F.tid; e < 65 * 20; e += NTHREADS) { const int rr = e / 20, pc = e % 20;
            u32x4 v = (u32x4){0u, 0u, 0u, 0u};
            if ((rr > 0 || tq0 > 0) && (pc < 16 || l == 1)) v = *(const u32x4*)(Z + (size_t)(row0 + rr - 1) * ZW + (pc < 16 ? ZC_RW + pc * 8 : ZC_XV + (pc - 16) * 8));
            *(u32x4*)(RAWL + rr * 160 + pc * 8) = v; }
        __syncthreads();
        const int t = F.tid & 63, u = F.tid >> 6;
        const f32x4 c0 = unpack4(*(const LAS u32x2*)(RAWL + (t + 1) * 160 + 8 * u)), c1 = unpack4(*(const LAS u32x2*)(RAWL + (t + 1) * 160 + 8 * u + 4)), p0 = unpack4(*(const LAS u32x2*)(RAWL + t * 160 + 8 * u)), p1 = unpack4(*(const LAS u32x2*)(RAWL + t * 160 + 8 * u + 4));
        const f32x4 m0 = *(const f32x4*)(mu + 1536 + 8 * u), m1 = *(const f32x4*)(mu + 1536 + 8 * u + 4);
        f32x4 x0 = c0 + m0 * (p0 - c0), x1 = c1 + m1 * (p1 - c1);
        u32x4 w; w.x = pk2(tanhf_(x0[0]), tanhf_(x0[1])); w.y = pk2(tanhf_(x0[2]), tanhf_(x0[3])); w.z = pk2(tanhf_(x1[0]), tanhf_(x1[1])); w.w = pk2(tanhf_(x1[2]), tanhf_(x1[3]));
        *(u32x4*)(XW + t * 72 + 8 * u) = w;
        const f32x4 d0 = unpack4(*(const LAS u32x2*)(RAWL + (t + 1) * 160 + 64 + 8 * u)), d1 = unpack4(*(const LAS u32x2*)(RAWL + (t + 1) * 160 + 64 + 8 * u + 4)), q0 = unpack4(*(const LAS u32x2*)(RAWL + t * 160 + 64 + 8 * u)), q1 = unpack4(*(const LAS u32x2*)(RAWL + t * 160 + 64 + 8 * u + 4));
        const f32x4 n0 = *(const f32x4*)(mu + 1600 + 8 * u), n1 = *(const f32x4*)(mu + 1600 + 8 * u + 4);
        x0 = d0 + n0 * (q0 - d0); x1 = d1 + n1 * (q1 - d1);
        w.x = pk2(x0[0], x0[1]); w.y = pk2(x0[2], x0[3]); w.z = pk2(x1[0], x1[1]); w.w = pk2(x1[2], x1[3]);
        *(u32x4*)(XA + t * 72 + 8 * u) = w;
        if (l == 1 && u < 4) { const float* muv = INP(I_RW_MUV1);
            const f32x4 e0 = unpack4(*(const LAS u32x2*)(RAWL + (t + 1) * 160 + 128 + 8 * u)), e1 = unpack4(*(const LAS u32x2*)(RAWL + (t + 1) * 160 + 128 + 8 * u + 4)), r0_ = unpack4(*(const LAS u32x2*)(RAWL + t * 160 + 128 + 8 * u)), r1_ = unpack4(*(const LAS u32x2*)(RAWL + t * 160 + 128 + 8 * u + 4));
            const f32x4 k0_ = *(const f32x4*)(muv + 8 * u), k1_ = *(const f32x4*)(muv + 8 * u + 4);
            x0 = e0 + k0_ * (r0_ - e0); x1 = e1 + k1_ * (r1_ - e1);
            w.x = pk2(x0[0], x0[1]); w.y = pk2(x0[2], x0[3]); w.z = pk2(x1[0], x1[1]); w.w = pk2(x1[2], x1[3]);
            *(u32x4*)(XV + t * 40 + 8 * u) = w; }
    }
    __syncthreads();
    const int nt = F.wave & 3, th = F.wave >> 2, ch = 16 * nt + cl, gch = h * 64 + ch;
    float lwv[2][4], av[2][4], kv[2][4], vv[2][4], rv[2][4], kpv[2][4], kkv[2][4];
    {
        const float w0 = INP(I_RW_W0)[l * 512 + gch], a0 = INP(I_RW_A0)[l * 512 + gch], k_k = INP(I_RW_KK)[l * 512 + gch], k_a = INP(I_RW_KA)[l * 512 + gch], r_k = INP(I_RW_RK)[l * 512 + gch];
        const float mur = mu[gch], muk = mu[512 + gch], muv_ = mu[1024 + gch];
        const float v0 = (l == 1) ? INP(I_RW_V0)[gch] : 0.f;
        bf16_t* VFp = (bf16_t*)(F.ws + WS_VF);
        float kk2[2][4], bp[2][4];
#pragma unroll
        for (int j = 0; j < 2; ++j) { const int mt = 2 * th + j;
            const f32x4 LW = mma_tile<64>(XW, 72, lorat + (size_t)(h * 64) * 64, 64, 16 * mt, 16 * nt, (f32x4){0.f, 0.f, 0.f, 0.f}, F.lane);
            const f32x4 LA = mma_tile<64>(XA, 72, lorat + 512 * 64 + (size_t)(h * 64) * 64, 64, 16 * mt, 16 * nt, (f32x4){0.f, 0.f, 0.f, 0.f}, F.lane);
            f32x4 LV = (f32x4){0.f, 0.f, 0.f, 0.f};
            if (l == 1) LV = mma_tile<32>(XV, 40, lorat + 2 * 512 * 64 + 512 * 128 + (size_t)(h * 64) * 32, 32, 16 * mt, 16 * nt, LV, F.lane);
#pragma unroll
            for (int r = 0; r < 4; ++r) { const int t = 16 * mt + 4 * q + r;
                const float rc = bf2f(RAW[(t + 1) * 192 + ch]), rp = bf2f(RAW[t * 192 + ch]), kc = bf2f(RAW[(t + 1) * 192 + 64 + ch]), kp_ = bf2f(RAW[t * 192 + 64 + ch]), vc = bf2f(RAW[(t + 1) * 192 + 128 + ch]), vp = bf2f(RAW[t * 192 + 128 + ch]);
                const float rr = rc + mur * (rp - rc), kk_ = kc + muk * (kp_ - kc); float vx = vc + muv_ * (vp - vc);
                lwv[j][r] = -__expf(-softplusf_(-(w0 + LW[r])) - 0.5f);
                const float a = sigmoidf_(a0 + LA[r]);
                if (l == 1) { const float vf = bf2f(VFp[(size_t)(row0 + t) * 512 + gch]); vx = vx + (vf - vx) * sigmoidf_(v0 + LV[r]); }
                VFp[(size_t)(row0 + t) * 512 + gch] = f2bfh(vx);
                const float kkr = kk_ * k_k, kp = kk_ * (1.f + (a - 1.f) * k_a);
                av[j][r] = a; kv[j][r] = kk_; vv[j][r] = vx; rv[j][r] = rr; kpv[j][r] = kp; kkv[j][r] = kkr; kk2[j][r] = kkr * kkr; bp[j][r] = rr * kp * r_k; }
        }
#pragma unroll
        for (int j = 0; j < 2; ++j)
#pragma unroll
            for (int r = 0; r < 4; ++r) { float x = kk2[j][r], y = bp[j][r];
#pragma unroll
                for (int o = 1; o < 16; o <<= 1) { x += __shfl_xor(x, o); y += __shfl_xor(y, o); }
                if (cl == 0) { const int t = 16 * (2 * th + j) + 4 * q + r; KKP[t * 4 + nt] = x; BPP[t * 4 + nt] = y; } }
    }
    float cum[2][4]; float halftot;
    {
        float base = 0.f;
#pragma unroll
        for (int j = 0; j < 2; ++j) {
            float p0 = lwv[j][0], p1 = p0 + lwv[j][1], p2 = p1 + lwv[j][2], p3 = p2 + lwv[j][3];
            const float s1 = __shfl_up(p3, 16), s2 = __shfl_up(p3, 32), s3 = __shfl_up(p3, 48);
            const float excl = (q >= 1 ? s1 : 0.f) + (q >= 2 ? s2 : 0.f) + (q >= 3 ? s3 : 0.f);
            float tot = p3; tot += __shfl_xor(tot, 16); tot += __shfl_xor(tot, 32);
            cum[j][0] = base + excl + p0; cum[j][1] = base + excl + p1; cum[j][2] = base + excl + p2; cum[j][3] = base + excl + p3;
            base += tot; }
        halftot = base;
        if (q == 0) HT[th * 64 + ch] = halftot;
    }
    __syncthreads();
    pf_done(F.pfv); F.pfv = pf_rw_sa(F.ws, next_item, F.tid);
    {
        const float lwl = HT[ch] + HT[64 + ch]; const float hb = th ? HT[ch] : 0.f;
        if (th == 0 && q == 0) ((float*)(F.ws + WS_RWG))[(size_t)item * 64 + ch] = __expf(lwl);
#pragma unroll
        for (int j = 0; j < 2; ++j) { const int mt = 2 * th + j; f32x4 albT, vT, beeT, keT;
#pragma unroll
            for (int r = 0; r < 4; ++r) { const int t = 16 * mt + 4 * q + r;
                const float nrm = rsqrtf((KKP[t * 4] + KKP[t * 4 + 1]) + (KKP[t * 4 + 2] + KKP[t * 4 + 3]) + 1e-6f);
                const float kk = kkv[j][r] * nrm, lwi = cum[j][r] + hb, lwe = lwi - lwv[j][r], be = kk * av[j][r];
                const float ei = __expf(lwi), en = __expf(-lwi), ee = __expf(lwl - lwi);
                const float alb = -kk * __expf(lwe);
                ALB[t * 72 + ch] = f2bfh(alb); BEH[t * 72 + ch] = f2bfh(be * en); KH[t * 72 + ch] = f2bfh(kpv[j][r] * en); RB[t * 72 + ch] = f2bfh(rv[j][r] * ei);
                albT[r] = alb; vT[r] = vv[j][r]; beeT[r] = be * ee; keT[r] = kpv[j][r] * ee; }
            const int t0 = 16 * mt + 4 * q;
            *(u32x2*)(ALBT + ch * 72 + t0) = pack4(albT); *(u32x2*)(VT + ch * 72 + t0) = pack4(vT); *(u32x2*)(BEET + ch * 72 + t0) = pack4(beeT); *(u32x2*)(KET + ch * 72 + t0) = pack4(keT); }
        if (F.tid < 64) ((float*)(F.ws + WS_RWB))[(size_t)(row0 + F.tid) * 8 + h] = (BPP[F.tid * 4] + BPP[F.tid * 4 + 1]) + (BPP[F.tid * 4 + 2] + BPP[F.tid * 4 + 3]);
    }
    __syncthreads();
#pragma unroll
    for (int k2 = 0; k2 < 2; ++k2) { const int tile = F.wave * 2 + k2, mt = tile & 3, n2 = tile >> 2;
        const int i = 16 * n2 + cl, j0 = 16 * mt + 4 * q;
        f32x4 lab = mma_tile<64>(BEH, 72, ALB, 72, 16 * mt, 16 * n2, (f32x4){0.f, 0.f, 0.f, 0.f}, F.lane);
        f32x4 lak = mma_tile<64>(KH, 72, ALB, 72, 16 * mt, 16 * n2, (f32x4){0.f, 0.f, 0.f, 0.f}, F.lane);
        f32x4 qrb = mma_tile<64>(BEH, 72, RB, 72, 16 * mt, 16 * n2, (f32x4){0.f, 0.f, 0.f, 0.f}, F.lane);
        f32x4 qrk = mma_tile<64>(KH, 72, RB, 72, 16 * mt, 16 * n2, (f32x4){0.f, 0.f, 0.f, 0.f}, F.lane);
#pragma unroll
        for (int r = 0; r < 4; ++r) { const int j = j0 + r; if (!(i > j)) { lab[r] = 0.f; lak[r] = 0.f; } if (!(i >= j)) { qrb[r] = 0.f; qrk[r] = 0.f; } }
        *(f32x4*)(AF + i * 68 + j0) = lab; *(u32x2*)(LAK + i * 72 + j0) = pack4(lak); *(u32x2*)(QRB + i * 72 + j0) = pack4(qrb); *(u32x2*)(QRK + i * 72 + j0) = pack4(qrk); }
    __syncthreads();
    tri_inv8(AF, 68, TT, 72, (const LAS float*)nullptr, F.wave, F.lane);
#pragma unroll
    for (int k2 = 0; k2 < 2; ++k2) { const int tile = F.wave * 2 + k2, mt = tile & 3, n2 = tile >> 2;
        const f32x4 x = mma_tile<64>(LAK, 72, VT, 72, 16 * mt, 16 * n2, (f32x4){0.f, 0.f, 0.f, 0.f}, F.lane);
        *(u32x2*)(XT + (16 * n2 + cl) * 72 + 16 * mt + 4 * q) = pack4(x); }
    __syncthreads();
#pragma unroll
    for (int k2 = 0; k2 < 2; ++k2) { const int tile = F.wave * 2 + k2, mt = tile & 3, n2 = tile >> 2;
        const f32x4 wu = mma_tile<64>(TT, 72, ALBT, 72, 16 * mt, 16 * n2, (f32x4){0.f, 0.f, 0.f, 0.f}, F.lane);
        const f32x4 u0 = mma_tile<64>(TT, 72, XT, 72, 16 * mt, 16 * n2, (f32x4){0.f, 0.f, 0.f, 0.f}, F.lane);
        *(u32x2*)(WUT + (16 * n2 + cl) * 72 + 16 * mt + 4 * q) = pack4(wu); *(u32x2*)(U0T + (16 * n2 + cl) * 72 + 16 * mt + 4 * q) = pack4(u0); }
    __syncthreads();
    bf16_t* gM = (bf16_t*)(F.ws + WS_RWM) + (size_t)item * 4096; bf16_t* gS = (bf16_t*)(F.ws + WS_RWS) + (size_t)item * 4096; bf16_t* gR = (bf16_t*)(F.ws + WS_RWR) + (size_t)item * 4096; bf16_t* gY = (bf16_t*)(F.ws + WS_RWY) + (size_t)item * 4096;
#pragma unroll
    for (int k2 = 0; k2 < 2; ++k2) { const int tile = F.wave * 2 + k2, mt = tile & 3, n2 = tile >> 2; const int col = 16 * n2 + cl, r0 = 16 * mt + 4 * q;
        f32x4 x = mma_tile<64>(WUT, 72, QRB, 72, 16 * mt, 16 * n2, (f32x4){0.f, 0.f, 0.f, 0.f}, F.lane);
        x = x + unpack4(*(const LAS u32x2*)(RB + col * 72 + r0));
        *(u32x2*)(gR + col * 64 + r0) = pack4(x);
        x = mma_tile<64>(U0T, 72, QRB, 72, 16 * mt, 16 * n2, (f32x4){0.f, 0.f, 0.f, 0.f}, F.lane);
        x = mma_tile<64>(VT, 72, QRK, 72, 16 * mt, 16 * n2, x, F.lane);
        *(u32x2*)(gY + col * 64 + r0) = pack4(x);
        x = mma_tile<64>(WUT, 72, BEET, 72, 16 * mt, 16 * n2, (f32x4){0.f, 0.f, 0.f, 0.f}, F.lane);
        *(u32x2*)(gM + col * 64 + 32 * (mt >> 1) + 8 * q + 4 * (mt & 1)) = pack4(x);
        x = mma_tile<64>(BEET, 72, U0T, 72, 16 * mt, 16 * n2, (f32x4){0.f, 0.f, 0.f, 0.f}, F.lane);
        x = mma_tile<64>(KET, 72, VT, 72, 16 * mt, 16 * n2, x, F.lane);
        *(u32x2*)(gS + ((n2 * 4 + mt) * 64 + cl + 16 * q) * 4) = pack4(x); }
    __syncthreads();
}
__device__ __forceinline__ void rw_sc_item(Frame& F, int l, int item) {
    LAUNDER(F);
    const int bh = item >> 7, c = item & 127, b = bh >> 3, h = bh & 7, row0 = b * SEQ + c * 64, tq0 = c * 64;
    LAS bf16_t* ST = (LAS bf16_t*)F.lds; LAS bf16_t* RP = (LAS bf16_t*)(F.lds + 9216); LAS bf16_t* XG = (LAS bf16_t*)(F.lds + 18432); LAS float* red = (LAS float*)(F.lds + 18432 + 17408);
    const bf16_t* Z = (const bf16_t*)(F.ws + WS_Z); const float* mu = INP(I_RW_MU) + l * 1792;
    const bf16_t* g2t = (const bf16_t*)(F.ws + WS_LORAT) + (size_t)l * LORAT_LAYER + 2 * 512 * 64 + (size_t)(h * 64) * 128;
    const bf16_t* gS = (const bf16_t*)(F.ws + WS_RWS) + (size_t)item * 4096; const bf16_t* gR = (const bf16_t*)(F.ws + WS_RWR) + (size_t)item * 4096; const bf16_t* gY = (const bf16_t*)(F.ws + WS_RWY) + (size_t)item * 4096;
    { const int rr = F.tid >> 3, cc = (F.tid & 7) * 8; *(u32x4*)(RP + rr * 72 + cc) = *(const u32x4*)(gR + rr * 64 + cc);
#pragma unroll
      for (int k = 0; k < 2; ++k) { const int pidx = F.tid + 512 * k, w = pidx >> 8, m = (pidx >> 6) & 3, ln = pidx & 63; *(u32x2*)(ST + (16 * w + (ln & 15)) * 72 + 16 * m + 4 * (ln >> 4)) = *(const u32x2*)(gS + (size_t)pidx * 4); }
      LAS bf16_t* RAWG = (LAS bf16_t*)(F.lds + 40960);
      for (int e = F.tid; e < 65 * 16; e += NTHREADS) { const int r2 = e >> 4, pc = e & 15; u32x4 v = (u32x4){0u, 0u, 0u, 0u};
          if (r2 > 0 || tq0 > 0) v = *(const u32x4*)(Z + (size_t)(row0 + r2 - 1) * ZW + ZC_RG + pc * 8);
          *(u32x4*)(RAWG + r2 * 128 + pc * 8) = v; }
      __syncthreads();
      const int t = F.tid & 63, u = F.tid >> 6;
#pragma unroll
      for (int p = 0; p < 2; ++p) { const int cg = 16 * u + 8 * p;
          const f32x4 c0 = unpack4(*(const LAS u32x2*)(RAWG + (t + 1) * 128 + cg)), c1 = unpack4(*(const LAS u32x2*)(RAWG + (t + 1) * 128 + cg + 4)), p0 = unpack4(*(const LAS u32x2*)(RAWG + t * 128 + cg)), p1 = unpack4(*(const LAS u32x2*)(RAWG + t * 128 + cg + 4));
          const f32x4 m0 = *(const f32x4*)(mu + 1664 + cg), m1 = *(const f32x4*)(mu + 1664 + cg + 4);
          const f32x4 x0 = c0 + m0 * (p0 - c0), x1 = c1 + m1 * (p1 - c1);
          u32x4 w; w.x = pk2(sigmoidf_(x0[0]), sigmoidf_(x0[1])); w.y = pk2(sigmoidf_(x0[2]), sigmoidf_(x0[3])); w.z = pk2(sigmoidf_(x1[0]), sigmoidf_(x1[1])); w.w = pk2(sigmoidf_(x1[2]), sigmoidf_(x1[3]));
          *(u32x4*)(XG + t * 136 + cg) = w; } }
    __syncthreads();
    const int n2 = F.wave >> 1, vh = F.wave & 1, q = F.lane >> 4, cl = F.lane & 15, i = 16 * n2 + cl;
    f32x4 y[2], g[2];
#pragma unroll
    for (int j = 0; j < 2; ++j) { const int mt = 2 * vh + j;
        y[j] = mma_tile<64>(ST, 72, RP, 72, 16 * mt, 16 * n2, unpack4(*(const u32x2*)(gY + i * 64 + 16 * mt + 4 * q)), F.lane);
        g[j] = mma_tile<128>(g2t, 128, XG, 136, 16 * mt, 16 * n2, (f32x4){0.f, 0.f, 0.f, 0.f}, F.lane); }
    float s = (y[0][0] + y[0][1]) + (y[0][2] + y[0][3]) + (y[1][0] + y[1][1]) + (y[1][2] + y[1][3]);
    s += __shfl_xor(s, 16); s += __shfl_xor(s, 32);
    if (q == 0) red[i * 2 + vh] = s;
    __syncthreads();
    const float mean = (red[i * 2] + red[i * 2 + 1]) * (1.f / 64.f);
    float s2 = 0.f;
#pragma unroll
    for (int j = 0; j < 2; ++j)
#pragma unroll
        for (int r = 0; r < 4; ++r) { y[j][r] -= mean; s2 += y[j][r] * y[j][r]; }
    s2 += __shfl_xor(s2, 16); s2 += __shfl_xor(s2, 32);
    __syncthreads();
    if (q == 0) red[i * 2 + vh] = s2;
    __syncthreads();
    const float rstd = rsqrtf((red[i * 2] + red[i * 2 + 1]) * (1.f / 64.f) + 64e-5f);
    const float bonus = ((const float*)(F.ws + WS_RWB))[(size_t)(row0 + i) * 8 + h];
    const bf16_t* VFp = (const bf16_t*)(F.ws + WS_VF) + (size_t)(row0 + i) * 512 + h * 64; bf16_t* Y = (bf16_t*)(F.ws + WS_Y) + (size_t)(row0 + i) * 1536 + 1024 + h * 64;
#pragma unroll
    for (int j = 0; j < 2; ++j) { const int v0 = 16 * (2 * vh + j) + 4 * q; const f32x4 lg = *(const f32x4*)(INP(I_RW_LNG) + l * 512 + h * 64 + v0), lb = *(const f32x4*)(INP(I_RW_LNB) + l * 512 + h * 64 + v0); const f32x4 vv = unpack4(*(const u32x2*)(VFp + v0));
        f32x4 o;
#pragma unroll
        for (int r = 0; r < 4; ++r) o[r] = (y[j][r] * rstd * lg[r] + lb[r] + bonus * vv[r]) * g[j][r];
        *(u32x2*)(Y + v0) = pack4(o); }
    __syncthreads();
}


__device__ __forceinline__ void rw_sc_pair(Frame& F, int l, int item0) {
    LAUNDER(F);
    const int bh = item0 >> 7, c0 = item0 & 127, b = bh >> 3, h = bh & 7;
    const bf16_t* Z = (const bf16_t*)(F.ws + WS_Z); const float* mu = INP(I_RW_MU) + l * 1792;
    const bf16_t* g2t = (const bf16_t*)(F.ws + WS_LORAT) + (size_t)l * LORAT_LAYER + 2 * 512 * 64 + (size_t)(h * 64) * 128;
#pragma unroll
    for (int u = 0; u < 2; ++u) {
        const int item = item0 + u, c = c0 + u, row0 = b * SEQ + c * 64, tq0 = c * 64;
        LAS unsigned char* L = F.lds + u * 65536;
        LAS bf16_t* ST = (LAS bf16_t*)L; LAS bf16_t* RP = (LAS bf16_t*)(L + 9216); LAS bf16_t* RAWG = (LAS bf16_t*)(L + 40960);
        const bf16_t* gS = (const bf16_t*)(F.ws + WS_RWS) + (size_t)item * 4096; const bf16_t* gR = (const bf16_t*)(F.ws + WS_RWR) + (size_t)item * 4096;
        { const int rr = F.tid >> 3, cc = (F.tid & 7) * 8; *(u32x4*)(RP + rr * 72 + cc) = *(const u32x4*)(gR + rr * 64 + cc); }
#pragma unroll
        for (int k = 0; k < 2; ++k) { const int pidx = F.tid + 512 * k, w = pidx >> 8, m = (pidx >> 6) & 3, ln = pidx & 63; *(u32x2*)(ST + (16 * w + (ln & 15)) * 72 + 16 * m + 4 * (ln >> 4)) = *(const u32x2*)(gS + (size_t)pidx * 4); }
        for (int e = F.tid; e < 65 * 16; e += NTHREADS) { const int r2 = e >> 4, pc = e & 15; u32x4 v = (u32x4){0u, 0u, 0u, 0u};
            if (r2 > 0 || tq0 > 0) v = *(const u32x4*)(Z + (size_t)(row0 + r2 - 1) * ZW + ZC_RG + pc * 8);
            *(u32x4*)(RAWG + r2 * 128 + pc * 8) = v; }
    }
    __syncthreads();
#pragma unroll
    for (int u = 0; u < 2; ++u) {
        LAS unsigned char* L = F.lds + u * 65536;
        LAS bf16_t* XG = (LAS bf16_t*)(L + 18432); LAS bf16_t* RAWG = (LAS bf16_t*)(L + 40960);
        const int t = F.tid & 63, uu = F.tid >> 6;
#pragma unroll
        for (int p = 0; p < 2; ++p) { const int cg = 16 * uu + 8 * p;
            const f32x4 c0v = unpack4(*(const LAS u32x2*)(RAWG + (t + 1) * 128 + cg)), c1v = unpack4(*(const LAS u32x2*)(RAWG + (t + 1) * 128 + cg + 4)), p0 = unpack4(*(const LAS u32x2*)(RAWG + t * 128 + cg)), p1 = unpack4(*(const LAS u32x2*)(RAWG + t * 128 + cg + 4));
            const f32x4 m0 = *(const f32x4*)(mu + 1664 + cg), m1 = *(const f32x4*)(mu + 1664 + cg + 4);
            const f32x4 x0 = c0v + m0 * (p0 - c0v), x1 = c1v + m1 * (p1 - c1v);
            u32x4 w; w.x = pk2(sigmoidf_(x0[0]), sigmoidf_(x0[1])); w.y = pk2(sigmoidf_(x0[2]), sigmoidf_(x0[3])); w.z = pk2(sigmoidf_(x1[0]), sigmoidf_(x1[1])); w.w = pk2(sigmoidf_(x1[2]), sigmoidf_(x1[3]));
            *(u32x4*)(XG + t * 136 + cg) = w; }
    }
    __syncthreads();
    const int n2 = F.wave >> 1, vh = F.wave & 1, q = F.lane >> 4, cl = F.lane & 15, i = 16 * n2 + cl;
    f32x4 y[2][2], g[2][2];
#pragma unroll
    for (int u = 0; u < 2; ++u) {
        LAS unsigned char* L = F.lds + u * 65536;
        LAS bf16_t* ST = (LAS bf16_t*)L; LAS bf16_t* RP = (LAS bf16_t*)(L + 9216); LAS bf16_t* XG = (LAS bf16_t*)(L + 18432); LAS float* red = (LAS float*)(L + 18432 + 17408);
        const bf16_t* gY = (const bf16_t*)(F.ws + WS_RWY) + (size_t)(item0 + u) * 4096;
#pragma unroll
        for (int j = 0; j < 2; ++j) { const int mt = 2 * vh + j;
            y[u][j] = mma_tile<64>(ST, 72, RP, 72, 16 * mt, 16 * n2, unpack4(*(const u32x2*)(gY + i * 64 + 16 * mt + 4 * q)), F.lane);
            g[u][j] = mma_tile<128>(g2t, 128, XG, 136, 16 * mt, 16 * n2, (f32x4){0.f, 0.f, 0.f, 0.f}, F.lane); }
        float s = (y[u][0][0] + y[u][0][1]) + (y[u][0][2] + y[u][0][3]) + (y[u][1][0] + y[u][1][1]) + (y[u][1][2] + y[u][1][3]);
        s += __shfl_xor(s, 16); s += __shfl_xor(s, 32);
        if (q == 0) red[i * 2 + vh] = s;
    }
    __syncthreads();
    float s2v[2];
#pragma unroll
    for (int u = 0; u < 2; ++u) {
        LAS float* red = (LAS float*)(F.lds + u * 65536 + 18432 + 17408);
        const float mean = (red[i * 2] + red[i * 2 + 1]) * (1.f / 64.f);
        float s2 = 0.f;
#pragma unroll
        for (int j = 0; j < 2; ++j)
#pragma unroll
            for (int r = 0; r < 4; ++r) { y[u][j][r] -= mean; s2 += y[u][j][r] * y[u][j][r]; }
        s2 += __shfl_xor(s2, 16); s2 += __shfl_xor(s2, 32);
        s2v[u] = s2;
    }
    __syncthreads();
#pragma unroll
    for (int u = 0; u < 2; ++u) { LAS float* red = (LAS float*)(F.lds + u * 65536 + 18432 + 17408); if (q == 0) red[i * 2 + vh] = s2v[u]; }
    __syncthreads();
#pragma unroll
    for (int u = 0; u < 2; ++u) {
        LAS float* red = (LAS float*)(F.lds + u * 65536 + 18432 + 17408);
        const int row0 = b * SEQ + (c0 + u) * 64;
        const float rstd = rsqrtf((red[i * 2] + red[i * 2 + 1]) * (1.f / 64.f) + 64e-5f);
        const float bonus = ((const float*)(F.ws + WS_RWB))[(size_t)(row0 + i) * 8 + h];
        const bf16_t* VFp = (const bf16_t*)(F.ws + WS_VF) + (size_t)(row0 + i) * 512 + h * 64; bf16_t* Y = (bf16_t*)(F.ws + WS_Y) + (size_t)(row0 + i) * 1536 + 1024 + h * 64;
#pragma unroll
        for (int j = 0; j < 2; ++j) { const int v0 = 16 * (2 * vh + j) + 4 * q; const f32x4 lg = *(const f32x4*)(INP(I_RW_LNG) + l * 512 + h * 64 + v0), lb = *(const f32x4*)(INP(I_RW_LNB) + l * 512 + h * 64 + v0); const f32x4 vv = unpack4(*(const u32x2*)(VFp + v0));
            f32x4 o;
#pragma unroll
            for (int r = 0; r < 4; ++r) o[r] = (y[u][j][r] * rstd * lg[r] + lb[r] + bonus * vv[r]) * g[u][j][r];
            *(u32x2*)(Y + v0) = pack4(o); }
    }
    __syncthreads();
}


constexpr size_t WS_GDM = WS_H;
constexpr size_t WS_GDS = WS_S + 65 * MB;
constexpr size_t WS_GDR = WS_VF + 16 * MB;
constexpr size_t WS_GDG = WS_LORAT + 640 * 1024;
__device__ __forceinline__ size_t ws_gdo(int l) { return WS_WIN + (size_t)l * NW * 1024 * 2; }
typedef float f32x16 __attribute__((ext_vector_type(16)));

__device__ __forceinline__ void gdn_sa_item(Frame& F, int l, int item, int next_item) {
    LAUNDER(F);
    const int bh = item >> 7, c = item & 127, b = bh >> 2, h = bh & 3, row0 = b * SEQ + c * 64, tq0 = c * 64;
    LAS bf16_t* Qt = (LAS bf16_t*)F.lds; LAS bf16_t* KdT = (LAS bf16_t*)(F.lds + 17408); LAS bf16_t* QKM = (LAS bf16_t*)(F.lds + 35840); LAS bf16_t* KgT = (LAS bf16_t*)(F.lds + 45056); LAS bf16_t* VT = (LAS bf16_t*)(F.lds + 63488);
    LAS bf16_t* TPP = (LAS bf16_t*)(F.lds + 81920); LAS bf16_t* Kt = (LAS bf16_t*)(F.lds + 91136); LAS float* AF = (LAS float*)(F.lds + 108544); LAS bf16_t* WT = (LAS bf16_t*)(F.lds + 91136); LAS bf16_t* UT = (LAS bf16_t*)(F.lds + 109568);
    LAS float* G = (LAS float*)(F.lds + 128000); LAS float* BETA = (LAS float*)(F.lds + 128256); LAS float* SSQ = (LAS float*)(F.lds + 81920);
    const bf16_t* Z = (const bf16_t*)(F.ws + WS_Z);
    const int q = F.lane >> 4, cl = F.lane & 15;
    int p = F.wave; asm volatile("" : "+s"(p));
    const int t = F.lane;
    float g_t, beta_t, gl;
    {
        const bf16_t* zr = Z + (size_t)(row0 + t) * ZW;
        const float a = bf2f(zr[ZC_GA + h]), bb = bf2f(zr[ZC_GB + h]);
        const float graw = -__expf(INP(I_GDN_ALOG)[l * 4 + h]) * softplusf_(a + INP(I_GDN_DTB)[l * 4 + h]);
        g_t = wave_incl_scan(graw, t); beta_t = sigmoidf_(bb); gl = __shfl(g_t, 63);
        if (p == 0) { G[t] = g_t; BETA[t] = beta_t; if (t == 0) ((float*)(F.ws + WS_GDG))[item] = __expf(gl); }
    }
    float xq[16], xk[16], xv[16];
    {
        LAS bf16_t* RAW = (LAS bf16_t*)(F.lds + 17408);
        LAS float* CW = AF;
        if (F.tid < 384) { const int j = F.tid / 96, rem = F.tid % 96, g = rem >> 5, c4 = (rem & 31) * 4;
            *(LAS f32x4*)(CW + (j * 3 + g) * 128 + c4) = *(const f32x4*)(INP(I_GDN_CONV) + (size_t)l * 4 * 1536 + j * 1536 + g * 512 + h * 128 + c4); }
        {
            u32x4 rw[9];
            const bf16_t* zsrc = Z + (size_t)(row0 + p - 3) * ZW + (t >> 4) * 512 + h * 128 + (t & 15) * 8;
#pragma unroll
            for (int it = 0; it < 9; ++it) { const int rr = p + 8 * it;
                rw[it] = (u32x4){0u, 0u, 0u, 0u};
                if (t < 48 && rr < 67 && tq0 + rr - 3 >= 0) rw[it] = *(const u32x4*)(zsrc + (size_t)it * 8 * ZW); }
#pragma unroll
            for (int it = 0; it < 9; ++it) { const int rr = p + 8 * it;
                if (t < 48 && rr < 67) *(LAS u32x4*)(RAW + rr * 392 + t * 8) = rw[it]; }
        }
        __syncthreads();
#define GD_CONV(g_, dstx) do { float acc[16]; _Pragma("unroll") for (int e = 0; e < 16; ++e) acc[e] = 0.f; \
            _Pragma("unroll") for (int j = 0; j < 4; ++j) { const u32x4 s0 = *(const LAS u32x4*)(RAW + (t + j) * 392 + (g_) * 128 + 16 * p), s1 = *(const LAS u32x4*)(RAW + (t + j) * 392 + (g_) * 128 + 16 * p + 8); \
                const unsigned w[8] = {s0.x, s0.y, s0.z, s0.w, s1.x, s1.y, s1.z, s1.w}; \
                _Pragma("unroll") for (int k = 0; k < 4; ++k) { const f32x4 c4v = *(const LAS f32x4*)(CW + (j * 3 + (g_)) * 128 + 16 * p + 4 * k); \
                    acc[4 * k] += c4v[0] * __uint_as_float(w[2 * k] << 16); acc[4 * k + 1] += c4v[1] * __uint_as_float(w[2 * k] & 0xffff0000u); \
                    acc[4 * k + 2] += c4v[2] * __uint_as_float(w[2 * k + 1] << 16); acc[4 * k + 3] += c4v[3] * __uint_as_float(w[2 * k + 1] & 0xffff0000u); } } \
            _Pragma("unroll") for (int e = 0; e < 16; ++e) dstx[e] = siluf_(acc[e]); } while (0)
#define GD_PIN(x) do { _Pragma("unroll") for (int e = 0; e < 16; ++e) asm volatile("" : "+v"(x[e]) :: "memory"); } while (0)
        GD_CONV(0, xq); GD_PIN(xq);
        GD_CONV(1, xk); GD_PIN(xk);
        GD_CONV(2, xv);
#undef GD_PIN
#undef GD_CONV
        float sq = 0.f, sk = 0.f;
#pragma unroll
        for (int e = 0; e < 16; ++e) { sq += xq[e] * xq[e]; sk += xk[e] * xk[e]; }
        SSQ[t * 8 + p] = sq; SSQ[512 + t * 8 + p] = sk;
    }
    __syncthreads();
    {
        float sq = 0.f, sk = 0.f;
#pragma unroll
        for (int e = 0; e < 8; ++e) { sq += SSQ[t * 8 + e]; sk += SSQ[512 + t * 8 + e]; }
        const float rq = rsqrtf(sq + 1e-6f) * 0.08838834764831845f, rk = rsqrtf(sk + 1e-6f);
        const float eg = __expf(g_t), ed = __expf(gl - g_t);
        u32x4 w0, w1; unsigned* p0 = (unsigned*)&w0; unsigned* p1 = (unsigned*)&w1;
#pragma unroll
        for (int e = 0; e < 4; ++e) { p0[e] = pk2(xq[2 * e] * rq, xq[2 * e + 1] * rq); p1[e] = pk2(xq[8 + 2 * e] * rq, xq[8 + 2 * e + 1] * rq); }
        *(u32x4*)(Qt + t * 136 + 16 * p) = w0; *(u32x4*)(Qt + t * 136 + 16 * p + 8) = w1;
#pragma unroll
        for (int e = 0; e < 4; ++e) { p0[e] = pk2(xk[2 * e] * rk, xk[2 * e + 1] * rk); p1[e] = pk2(xk[8 + 2 * e] * rk, xk[8 + 2 * e + 1] * rk); }
        *(u32x4*)(Kt + t * 136 + 16 * p) = w0; *(u32x4*)(Kt + t * 136 + 16 * p + 8) = w1;
#pragma unroll
        for (int e = 0; e < 16; ++e) { const float kn = xk[e] * rk; KgT[(16 * p + e) * 72 + t] = f2bfh(kn * eg); KdT[(16 * p + e) * 72 + t] = f2bfh(kn * ed); VT[(16 * p + e) * 72 + t] = f2bfh(xv[e]); }
    }
    __syncthreads();
    pf_done(F.pfv); F.pfv = pf_gdn_sa(F.ws, next_item, F.tid);
#pragma unroll
    for (int k2 = 0; k2 < 2; ++k2) { const int tile = F.wave * 2 + k2, mt = tile & 3, n2 = tile >> 2; const int i = 16 * n2 + cl, j0 = 16 * mt + 4 * q;
        f32x4 kk = mma_tile<128>(Kt, 136, Kt, 136, 16 * mt, 16 * n2, (f32x4){0.f, 0.f, 0.f, 0.f}, F.lane);
        f32x4 qk = mma_tile<128>(Kt, 136, Qt, 136, 16 * mt, 16 * n2, (f32x4){0.f, 0.f, 0.f, 0.f}, F.lane);
        const float gi = G[i], bi = BETA[i];
#pragma unroll
        for (int r = 0; r < 4; ++r) { const int j = j0 + r; const float d = __expf(gi - G[j]); kk[r] = (i > j) ? -bi * kk[r] * d : 0.f; qk[r] = (i >= j) ? qk[r] * d : 0.f; }
        *(f32x4*)(AF + i * 68 + j0) = kk; *(u32x2*)(QKM + i * 72 + j0) = pack4(qk); }
    __syncthreads();
    tri_inv8(AF, 68, TPP, 72, BETA, F.wave, F.lane);
    __syncthreads();
    {
        f32x4 wv[4], uv[4];
#pragma unroll
        for (int mt = 0; mt < 4; ++mt) { wv[mt] = mma_tile<64>(TPP, 72, KgT, 72, 16 * mt, 16 * F.wave, (f32x4){0.f, 0.f, 0.f, 0.f}, F.lane); uv[mt] = mma_tile<64>(TPP, 72, VT, 72, 16 * mt, 16 * F.wave, (f32x4){0.f, 0.f, 0.f, 0.f}, F.lane); }
#pragma unroll
        for (int mt = 0; mt < 4; ++mt) { *(u32x2*)(WT + (16 * F.wave + cl) * 72 + 16 * mt + 4 * q) = pack4(wv[mt]); *(u32x2*)(UT + (16 * F.wave + cl) * 72 + 16 * mt + 4 * q) = pack4(uv[mt]); }
    }
    __syncthreads();
    bf16_t* gM = (bf16_t*)(F.ws + WS_GDM) + (size_t)item * 16384; bf16_t* gS = (bf16_t*)(F.ws + WS_GDS) + (size_t)item * 16384; bf16_t* gR = (bf16_t*)(F.ws + WS_GDR) + (size_t)item * 8192; bf16_t* gO = (bf16_t*)(F.ws + ws_gdo(l)) + (size_t)item * 8192;
#pragma unroll
    for (int mt = 0; mt < 8; ++mt) { const int n2 = F.wave, col = 16 * n2 + cl;
        f32x4 x = mma_tile<64>(WT, 72, KdT, 72, 16 * mt, 16 * n2, (f32x4){0.f, 0.f, 0.f, 0.f}, F.lane);
        *(u32x2*)(gM + col * 128 + 32 * (mt >> 1) + 8 * q + 4 * (mt & 1)) = pack4(-x);
        x = mma_tile<64>(KdT, 72, UT, 72, 16 * mt, 16 * n2, (f32x4){0.f, 0.f, 0.f, 0.f}, F.lane);
        *(u32x2*)(gS + (((col >> 4) * 8 + mt) * 64 + (col & 15) + 16 * q) * 4) = pack4(x); }
#pragma unroll
    for (int k2 = 0; k2 < 4; ++k2) { const int tile = F.wave * 4 + k2, mt = tile & 7, n2 = tile >> 3; const int i = 16 * n2 + cl, r0 = 16 * mt + 4 * q;
        f32x4 x = mma_tile<64>(WT, 72, QKM, 72, 16 * mt, 16 * n2, (f32x4){0.f, 0.f, 0.f, 0.f}, F.lane);
        x = unpack4(*(const LAS u32x2*)(Qt + i * 136 + r0)) * __expf(G[i]) - x;
        *(u32x2*)(gR + i * 128 + r0) = pack4(x);
        x = mma_tile<64>(UT, 72, QKM, 72, 16 * mt, 16 * n2, (f32x4){0.f, 0.f, 0.f, 0.f}, F.lane);
        *(u32x2*)(gO + i * 128 + r0) = pack4(x); }
    __syncthreads();
}
__device__ __forceinline__ void gdn_sc_item(Frame& F, int l, int item) {
    LAUNDER(F);
    const int bh = item >> 7, c = item & 127, b = bh >> 2, h = bh & 3, row0 = b * SEQ + c * 64;
    LAS bf16_t* ST = (LAS bf16_t*)F.lds; LAS bf16_t* RP = (LAS bf16_t*)(F.lds + 34816); LAS float* red = (LAS float*)(F.lds + 34816 + 17408);
    const bf16_t* gS = (const bf16_t*)(F.ws + WS_GDS) + (size_t)item * 16384; const bf16_t* gR = (const bf16_t*)(F.ws + WS_GDR) + (size_t)item * 8192; const bf16_t* gO = (const bf16_t*)(F.ws + ws_gdo(l)) + (size_t)item * 8192;
#pragma unroll
    for (int k = 0; k < 8; ++k) { const int pidx = F.tid + 512 * k, w = pidx >> 9, m = (pidx >> 6) & 7, ln = pidx & 63;
        *(u32x2*)(ST + (16 * w + (ln & 15)) * 136 + 16 * m + 4 * (ln >> 4)) = *(const u32x2*)(gS + (size_t)pidx * 4); }
#pragma unroll
    for (int k = 0; k < 2; ++k) { const int e = F.tid + 512 * k; *(u32x4*)(RP + (e >> 4) * 136 + (e & 15) * 8) = *(const u32x4*)(gR + (e >> 4) * 128 + (e & 15) * 8); }
    __syncthreads();
    const int n2 = F.wave >> 1, vh = F.wave & 1, q = F.lane >> 4, cl = F.lane & 15, i = 16 * n2 + cl;
    f32x4 o[4]; float sq = 0.f;
#pragma unroll
    for (int j = 0; j < 4; ++j) { const int mt = 4 * vh + j;
        o[j] = mma_tile<128>(ST, 136, RP, 136, 16 * mt, 16 * n2, unpack4(*(const u32x2*)(gO + i * 128 + 16 * mt + 4 * q)), F.lane);
        sq += (o[j][0] * o[j][0] + o[j][1] * o[j][1]) + (o[j][2] * o[j][2] + o[j][3] * o[j][3]); }
    sq += __shfl_xor(sq, 16); sq += __shfl_xor(sq, 32);
    if (q == 0) red[i * 2 + vh] = sq;
    __syncthreads();
    const float rms = rsqrtf((red[i * 2] + red[i * 2 + 1]) * (1.f / 128.f) + 1e-6f);
    const bf16_t* zg = (const bf16_t*)(F.ws + WS_Z) + (size_t)(row0 + i) * ZW + ZC_GZ + h * 128; bf16_t* Y = (bf16_t*)(F.ws + WS_Y) + (size_t)(row0 + i) * 1536 + h * 128; const float* ng = INP(I_GDN_NG) + l * 128;
#pragma unroll
    for (int j = 0; j < 4; ++j) { const int v0 = 16 * (4 * vh + j) + 4 * q; const f32x4 g4 = *(const f32x4*)(ng + v0); const f32x4 z4 = unpack4(*(const u32x2*)(zg + v0)); f32x4 y;
#pragma unroll
        for (int r = 0; r < 4; ++r) y[r] = o[j][r] * rms * g4[r] * siluf_(z4[r]);
        *(u32x2*)(Y + v0) = pack4(y); }
    __syncthreads();
}

#define SITE(N) int g_ = F.G, b_ = F.bid; unsigned char* w_ = ws; asm volatile("; gemm site " #N : "+s"(g_), "+s"(b_), "+s"(w_))
#define XB_TMO      128
#define XB_XCNT(j)  (256  + 64 * (j))
#define XB_XSUB(j)  (1280 + 64 * (j))
#define XB_XGEN(j)  (2304 + 64 * (j))
#define XB_TOP      3328
#define XB_TOPGEN   3392
#define XCD_BAR_WORDS 3456
#define XB_SPIN_CAP (1u << 20)
__device__ __forceinline__ unsigned xb_ld(unsigned* p)              { return __hip_atomic_load(p, __ATOMIC_RELAXED, __HIP_MEMORY_SCOPE_AGENT); }
__device__ __forceinline__ unsigned xb_add(unsigned* p, unsigned v) { return __hip_atomic_fetch_add(p, v, __ATOMIC_RELAXED, __HIP_MEMORY_SCOPE_AGENT); }
__device__ __forceinline__ unsigned xb_xcc_id() { return (unsigned)__builtin_amdgcn_s_getreg((3 << 11) | 20) & 0xFu; }
#define XB_SPIN(cond, bar) do { unsigned _sp = 0; while (cond) { __builtin_amdgcn_s_sleep(1); \
    if ((++_sp & 255u) == 0u) { if (xb_ld(&(bar)[XB_TMO])) break; if (_sp > XB_SPIN_CAP) { atomicAdd(&(bar)[XB_TMO], 1u); break; } } } } while (0)
struct XcdBarrier { unsigned* bar; unsigned x; volatile LAS unsigned* st; };
__device__ __forceinline__ XcdBarrier xcd_barrier_post(unsigned* bar, volatile LAS unsigned* st) {
    XcdBarrier b; b.bar = bar; b.x = xb_xcc_id(); b.st = st;
    if (threadIdx.x == 0) (void)xb_add(&bar[XB_XCNT(b.x)], 1u);
    return b;
}
__device__ __forceinline__ void xcd_barrier_complete(unsigned* bar, unsigned x, unsigned& nloc, unsigned& nx) {
    const unsigned G = gridDim.x * gridDim.y * gridDim.z;
    unsigned sum, cnt, mine, sp = 0u;
    for (;;) {
        sum = 0u; cnt = 0u; mine = 0u;
#pragma unroll
        for (unsigned j = 0; j < 16; ++j) { const unsigned c = xb_ld(&bar[XB_XCNT(j)]); sum += c; cnt += (c > 0u) ? 1u : 0u; mine = (j == x) ? c : mine; }
        if (sum == G) break;
        __builtin_amdgcn_s_sleep(1);
        if ((++sp & 255u) == 0u) { if (xb_ld(&bar[XB_TMO])) break; if (sp > XB_SPIN_CAP) { atomicAdd(&bar[XB_TMO], 1u); break; } }
    }
    nloc = mine > 0u ? mine : 1u; nx = cnt > 0u ? cnt : 1u;
}
__device__ __forceinline__ void xcd_barrier(const XcdBarrier& b) {
    asm volatile("s_waitcnt vmcnt(0)" ::: "memory");
    __syncthreads();
    if (threadIdx.x == 0) {
        unsigned* bar = b.bar;
        __builtin_amdgcn_s_waitcnt(0);
        unsigned nloc = b.st[0], nx = b.st[1];
        if (nloc == 0u) { xcd_barrier_complete(bar, b.x, nloc, nx); b.st[0] = nloc; b.st[1] = nx; }
        const unsigned old = xb_add(&bar[XB_XSUB(b.x)], 1u);
        const unsigned gen = old / nloc;
        if (old + 1u == (gen + 1u) * nloc) {
            __builtin_amdgcn_fence(__ATOMIC_RELEASE, "agent");
            asm volatile("s_waitcnt vmcnt(0)" ::: "memory");
            const unsigned og = xb_add(&bar[XB_TOP], 1u);
            const unsigned tg = og / nx;
            if (og + 1u == (tg + 1u) * nx) xb_add(&bar[XB_TOPGEN], 1u);
            else XB_SPIN(xb_ld(&bar[XB_TOPGEN]) == tg, bar);
            __builtin_amdgcn_fence(__ATOMIC_ACQUIRE, "agent");
            xb_add(&bar[XB_XGEN(b.x)], 1u);
            asm volatile("s_waitcnt vmcnt(0)" ::: "memory");
        } else {
            XB_SPIN(xb_ld(&bar[XB_XGEN(b.x)]) == gen, bar);
            __builtin_amdgcn_fence(__ATOMIC_ACQUIRE, "agent");
            asm volatile("s_waitcnt vmcnt(0)" ::: "memory");
        }
    }
    __syncthreads();
}

enum { PH_CONV0 = 0, PH_LNIN, PH_INPROJ0, PH_SA0, PH_SBC0, PH_MERGE0, PH_WO0, PH_LN1_0, PH_FFN1, PH_FFN2, PH_LN2_0,
       PH_INPROJ1, PH_SA1, PH_SBC1, PH_MERGE1, PH_WO1, PH_LN1_1, PH_MOESET, PH_MOE1, PH_MOE2, PH_LN2_1, PH_END };

__device__ __forceinline__ bool is_gdn_scanner(int bid) { return bid >= 100 && bid < 116; }
__device__ __forceinline__ void phase_sa(Frame& F, int l) {
    LAUNDER(F);
    unsigned* ctl = (unsigned*)(F.ws + WS_CTL);
    for (int item = F.bid; item < 1024; item += F.G) gdn_sa_item(F, l, item, item + F.G);
    pf_done(F.pfv); F.pfv = 0u;
    asm volatile("s_waitcnt vmcnt(0)" ::: "memory");
    __syncthreads();
    if (F.tid == 0) { __builtin_amdgcn_fence(__ATOMIC_RELEASE, "agent"); asm volatile("s_waitcnt vmcnt(0)" ::: "memory");
        __hip_atomic_fetch_add(ctl + CW_GSA + 64 * l, 1u, __ATOMIC_RELAXED, __HIP_MEMORY_SCOPE_AGENT); }
    if (is_gdn_scanner(F.bid)) {
        if (F.tid == 0) { unsigned sp = 0;
            while (__hip_atomic_load(ctl + CW_GSA + 64 * l, __ATOMIC_RELAXED, __HIP_MEMORY_SCOPE_AGENT) < (unsigned)F.G) { __builtin_amdgcn_s_sleep(4); if (++sp > (1u << 22)) break; }
            __builtin_amdgcn_fence(__ATOMIC_ACQUIRE, "agent"); asm volatile("s_waitcnt vmcnt(0)" ::: "memory"); }
        __syncthreads();
        const int bh = (F.bid - 100) >> 1, half = (F.bid - 100) & 1;
        scan_block<128, false>(F, (const bf16_t*)(F.ws + WS_GDM) + (size_t)bh * 128 * 16384, (bf16_t*)(F.ws + WS_GDS) + (size_t)bh * 128 * 16384, (const float*)(F.ws + WS_GDG) + bh * 128, 4 * half);
    } else {
        const int rank = F.bid < 100 ? F.bid : F.bid - 16, NR = F.G - 16;
        for (int item = rank; item < 2048; item += NR) rw_sa_item(F, l, item, item + NR);
        pf_done(F.pfv); F.pfv = 0u;
        const int per = 2048 / NR, n9 = 2048 - per * NR;
        if (n9 > 0 && n9 < NR && 2 * n9 < 1024) {
            if (rank < n9) { for (int k = 0; k < 2; ++k) ml_sa_item(F, l, k * n9 + rank); }
            else { for (int item = 2 * n9 + (rank - n9); item < 1024; item += NR - n9) ml_sa_item(F, l, item); }
        } else { for (int item = rank; item < 1024; item += NR) ml_sa_item(F, l, item); }
    }
}
__device__ __forceinline__ void phase_sbc(Frame& F, int l) {
    LAUNDER(F);
    unsigned* ctl = (unsigned*)(F.ws + WS_CTL);
    volatile LAS unsigned* bc = (volatile LAS unsigned*)(F.lds + LDS_BYTES - 64 + 16);
    int mixer = -1;
    if (F.bid < 16) { ml_scan(F, F.bid, -1); mixer = 0; } else if (F.bid == 16) { ml_scan(F, -1, 0); mixer = 0; }
    else if (F.bid >= 32 && F.bid < 48) { const int bh = F.bid - 32; mixer = 1;
        scan_block<64, true>(F, (const bf16_t*)(F.ws + WS_RWM) + (size_t)bh * 128 * 4096, (bf16_t*)(F.ws + WS_RWS) + (size_t)bh * 128 * 4096, (const float*)(F.ws + WS_RWG) + (size_t)bh * 128 * 64, 0); }
    if (mixer >= 0) {
        asm volatile("s_waitcnt vmcnt(0)" ::: "memory");
        __syncthreads();
        if (F.tid == 0) { __builtin_amdgcn_fence(__ATOMIC_RELEASE, "agent"); asm volatile("s_waitcnt vmcnt(0)" ::: "memory");
            __hip_atomic_fetch_add(ctl + CW_FLG + 64 * (3 * l + mixer), 1u, __ATOMIC_RELAXED, __HIP_MEMORY_SCOPE_AGENT); }
    }
    unsigned seen = 4u;
    unsigned nxt_pop = 0u;
    if (F.tid == 0) asm volatile("global_atomic_add %0, %1, %2, off sc0" : "=v"(nxt_pop) : "v"(ctl + CW_Q + 64 * l), "v"(1u) : "memory");
    for (;;) {
        __syncthreads();
        if (F.tid == 0) { pf_done(nxt_pop); bc[0] = nxt_pop; asm volatile("global_atomic_add %0, %1, %2, off sc0" : "=v"(nxt_pop) : "v"(ctl + CW_Q + 64 * l), "v"(1u) : "memory"); }
        __syncthreads();
        const int qi = (int)bc[0];
        if (qi >= 3072) break;
        const int k = qi < 1024 ? 2 : (qi < 2048 ? 0 : 1);
        if (!((seen >> k) & 1u)) {
            if (F.tid == 0) { const unsigned need = (k == 0) ? 17u : 16u; unsigned sp = 0;
                while (__hip_atomic_load(ctl + CW_FLG + 64 * (3 * l + k), __ATOMIC_RELAXED, __HIP_MEMORY_SCOPE_AGENT) < need) { __builtin_amdgcn_s_sleep(4); if (++sp > (1u << 22)) break; }
                __builtin_amdgcn_fence(__ATOMIC_ACQUIRE, "agent"); asm volatile("s_waitcnt vmcnt(0)" ::: "memory"); }
            __syncthreads();
            seen |= 1u << k;
        }
        if (k == 2) gdn_sc_item(F, l, qi); else if (k == 0) ml_sc_item(F, l, qi - 1024); else rw_sc_pair(F, l, 2 * (qi - 2048));
    }
    pf_done(nxt_pop);
}

__device__ __forceinline__ void run_phase(Frame& F, const Args* ap, unsigned char* ws, const int ph) {
    const int l = (ph >= PH_INPROJ1) ? 1 : 0;
    switch (ph) {
    case PH_CONV0:
        phase_mod(F);
        phase_convert(F, 0, NJOBS0, 0, ap->l1_lo, F.bid * NWAVES + F.wave, F.G * NWAVES);
        phase_convert(F, 0, NJOBS0, ap->l1_end, ap->ff_lo, F.bid * NWAVES + F.wave, F.G * NWAVES);
        break;
    case PH_LNIN: phase_ln(F, 0, INP(I_LNIN_G), INP(I_LNIN_B), 0, 0, 0, 0, 1024, false, false); break;
    case PH_INPROJ0: case PH_INPROJ1: {
        SITE(1); pg8::StaticOrder S{(const char*)(w_ + WS_H), (const char*)(w_ + WS_WIN + (size_t)l * NW * 1024 * 2), NTOK / 256, NW / 256, 1024, g_, b_};
        pg8::EpiZ E{(bf16_t*)(w_ + WS_Z), (bf16_t*)(w_ + WS_GATE)};
        pg8::gemm_phase(F.lds, 1024, S, E); }
        if (ph == PH_INPROJ0 && F.bid >= ap->busyA) phase_convert(F, 0, NJOBS0, ap->ff_lo, ap->items0, (F.bid - ap->busyA) * NWAVES + F.wave, (F.G - ap->busyA) * NWAVES);
        break;
    case PH_SA0: case PH_SA1: phase_sa(F, l); break;
    case PH_SBC0: case PH_SBC1: phase_sbc(F, l); break;
    case PH_MERGE0: case PH_MERGE1: {
        SITE(2); pg8::StaticOrder S{(const char*)(w_ + WS_Y), (const char*)(w_ + WS_WBR + (size_t)l * 1024 * 1536 * 2), NTOK / 256, 4, 1536, g_, b_};
        pg8::EpiMerge E{(const bf16_t*)(w_ + WS_GATE), (bf16_t*)(w_ + WS_H)};
        pg8::gemm_phase(F.lds, 1536, S, E); } break;
    case PH_WO0: case PH_WO1: {
        SITE(3); pg8::StaticOrder S{(const char*)(w_ + WS_H), (const char*)(w_ + WS_WO + (size_t)l * 1024 * 1024 * 2), NTOK / 256, 4, 1024, g_, b_};
        pg8::EpiBf16 E{(bf16_t*)(w_ + WS_YF), 1024};
        pg8::gemm_phase(F.lds, 1024, S, E); } break;
    case PH_LN1_0: phase_ln(F, 1, INP(I_LN1_G), INP(I_LN1_B), 0, 2048, 0, 3072, 4096, false, false); break;
    case PH_LN1_1: phase_ln(F, 1, INP(I_LN1_G) + 1024, INP(I_LN1_B) + 1024, 1, 2048, 1, 3072, 4096, true, false); break;
    case PH_FFN1: {
        SITE(4); pg8::StaticOrder S{(const char*)(w_ + WS_H), (const char*)(w_ + WS_WGU), NTOK / 256, 2 * DFF / 256, 1024, g_, b_};
        pg8::EpiSwiglu E{(bf16_t*)(w_ + WS_ACT0), DFF};
        pg8::gemm_phase(F.lds, 1024, S, E); }
        if (F.bid >= ap->busyB) phase_convert(F, 0, NJOBS0, ap->l1_lo, ap->l1_end, (F.bid - ap->busyB) * NWAVES + F.wave, (F.G - ap->busyB) * NWAVES);
        break;
    case PH_FFN2: {
        SITE(6); pg8::StaticOrder S{(const char*)(w_ + WS_ACT0), (const char*)(w_ + WS_WD), NTOK / 256, 4, DFF, g_, b_};
        pg8::EpiBf16 E{(bf16_t*)(w_ + WS_YF), 1024};
        pg8::gemm_phase(F.lds, DFF, S, E); } break;
    case PH_LN2_0: phase_ln(F, 1, INP(I_LN2_G), INP(I_LN2_B), 0, 5120, 1, 0, 1024, false, false); break;
    case PH_MOESET: phase_moe_setup(F); phase_convert(F, NJOBS0, NJOBS, ap->items0, ap->items0 + ap->items1, F.bid * NWAVES + F.wave, F.G * NWAVES); break;
    case PH_MOE1: {
        const int* texp = (const int*)(ws + WS_TEXP); const int nrt = texp[MOE_RT_MAX];
        SITE(5); pg8::MoeOrder S{(const char*)(w_ + WS_MA), (const char*)(w_ + WS_MW), texp, MW_EXP_BYTES, nrt, 2 * DFFE / 256, 1024, g_, b_};
        pg8::EpiSwiglu E{(bf16_t*)(w_ + WS_MACT), DFFE};
        pg8::gemm_phase(F.lds, 1024, S, E); } break;
    case PH_MOE2: {
        const int* texp = (const int*)(ws + WS_TEXP); const int nrt = texp[MOE_RT_MAX];
        SITE(7); int nr, ns; pg8::moe2_split(nrt, g_, nr, ns);
        pg8::MoeSplitOrder S{(const char*)(w_ + WS_MACT), (const char*)(w_ + WS_MW + (size_t)7168 * 1024 * 2), texp, MW_EXP_BYTES, nrt, 4, DFFE, g_, b_, nr, ns};
        pg8::EpiMoe2 E{(bf16_t*)(w_ + WS_MY), (float*)(w_ + WS_MA)};
        pg8::gemm_phase(F.lds, DFFE, S, E); } break;
    case PH_LN2_1: phase_ln(F, 3, INP(I_LN2_G) + 1024, INP(I_LN2_B) + 1024, 1, 5120, 0, 0, 0, false, true); break;
    default: break;
    }
}
#define FRAME_SETUP() \
        const Args* ap = &args; \
        int tid_ = threadIdx.x; asm volatile("" : "+v"(tid_)); \
        Frame F; F.lds = (LAS unsigned char*)lds_raw; F.tid = tid_; F.lane = tid_ & 63; F.wave = __builtin_amdgcn_readfirstlane(tid_ >> 6); F.G = gridDim.x; F.bid = blockIdx.x; F.a = ap; F.pfv = 0u; \
        unsigned char* ws = args.ws; F.ws = ws;

#ifdef TS_SEL_A
#define TS_STAMP(k) do { if (blockIdx.x == 0 && threadIdx.x == 0) { ((unsigned long long*)(args.ws + WS_TS))[(k)] = __builtin_amdgcn_s_memrealtime(); } } while (0)
#else
#define TS_STAMP(k) do { } while (0)
#endif
#ifndef REP_MASK
#define REP_MASK 0u
#endif
#ifndef REP_N
#define REP_N 1
#endif
#define PHASE(k) do { TS_STAMP(k); { FRAME_SETUP(); run_phase(F, ap, ws, (k)); } \
    if ((REP_MASK >> (k)) & 1u) { _Pragma("unroll") for (int rep_ = 0; rep_ < REP_N; ++rep_) { xcd_barrier(xbar); { FRAME_SETUP(); run_phase(F, ap, ws, (k)); } } } \
    if ((k) + 1 < PH_END) { if ((k) == 0 && args.cg_seam0) cg::this_grid().sync(); else xcd_barrier(xbar); } } while (0)
__global__ void __launch_bounds__(NTHREADS, 2) mk(Args args) {
    extern __shared__ __attribute__((aligned(16))) unsigned char lds_raw[];
    volatile LAS unsigned* xst = (volatile LAS unsigned*)((LAS unsigned char*)lds_raw + LDS_BYTES - 64);
    if (threadIdx.x < 4) xst[threadIdx.x] = 0u;
    __syncthreads();
    const XcdBarrier xbar = xcd_barrier_post((unsigned*)(args.ws + WS_BAR), xst);
    PHASE(0); PHASE(1); PHASE(2); PHASE(3); PHASE(4); PHASE(5); PHASE(6); PHASE(7); PHASE(8); PHASE(9); PHASE(10); PHASE(11);
    PHASE(12); PHASE(13); PHASE(14); PHASE(15); PHASE(16); PHASE(17); PHASE(18); PHASE(19); PHASE(20);
#ifdef TS_SEL_A
    TS_STAMP(21);
    if (blockIdx.x == 0 && threadIdx.x == 0) {
        const unsigned long long* ts = (const unsigned long long*)(args.ws + WS_TS);
        const unsigned long long d = (ts[TS_SEL_B] - ts[TS_SEL_A]) * TS_AMP, t0 = __builtin_amdgcn_s_memrealtime();
        while (__builtin_amdgcn_s_memrealtime() - t0 < d) __builtin_amdgcn_s_sleep(8);
    }
#endif
    static_assert(PH_END == 21, "phase list");
}

constexpr int CONV_SLOT_X = 4;
static int fill_jobs(Args& a, void* const* d_in, unsigned char* ws, int grid_blocks) {
    int nj = 0, item = 0;
    auto add = [&](const float* src, bf16_t* dst, int K, int ld_src, int col0, int ncols, int ld_dst, int r0, int mode, int batch, long long sbs, long long dbs) {
        Job& J = a.jobs[nj++]; J.src = src; J.dst = dst; J.src_bs = sbs; J.dst_bs = dbs; J.K = K; J.ld_src = ld_src; J.col0 = col0; J.ncols = ncols; J.ld_dst = ld_dst; J.r0 = r0; J.mode = mode; J.batch = batch;
        J.item0 = item; J.nitems = batch * ((K + 63) / 64) * ((ncols + 31) / 32); item += J.nitems; J.pad0 = 0; J.pad1 = 0; };
    int c0_end = 0;
    auto add_layer = [&](int l) {
        const float* w = (const float*)d_in[I_W_IN] + (size_t)l * 1024 * IN_W; bf16_t* d = (bf16_t*)(ws + WS_WIN) + (size_t)l * NW * 1024;
        add(w, d, 1024, IN_W, 0, 2048, 1024, 0, 0, 1, 0, 0);
        add(w, d, 1024, IN_W, 2056, 1536, 1024, 2048, 0, 1, 0, 0);
        add(w, d, 1024, IN_W, 3600, 1792, 1024, 3584, 0, 1, 0, 0);
        add(w, d, 1024, IN_W, 2048, 8, 1024, 5376, 0, 1, 0, 0);
        add(w, d, 1024, IN_W, 3592, 8, 1024, 5384, 0, 1, 0, 0);
        add(w, d, 1024, IN_W, 5392, 3072, 1024, 5632, 0, 1, 0, 0);
        if (l == 1) add((const float*)d_in[I_RW_V1], d, 1024, 32, 0, 32, 1024, 5392, 0, 1, 0, 0);
        add((const float*)d_in[I_W_BR] + (size_t)l * 3 * 512 * 1024, (bf16_t*)(ws + WS_WBR) + (size_t)l * 1024 * 1536, 512, 1024, 0, 1024, 1536, 0, 0, 3, 512ll * 1024, 512);
        add((const float*)d_in[I_W_O] + (size_t)l * 1024 * 1024, (bf16_t*)(ws + WS_WO) + (size_t)l * 1024 * 1024, 1024, 1024, 0, 1024, 1024, 0, 0, 1, 0, 0);
    };
    add_layer(0);
    for (int l = 0; l < 2; ++l) {
        bf16_t* d = (bf16_t*)(ws + WS_LORAT) + (size_t)l * LORAT_LAYER;
        add((const float*)d_in[I_RW_W2] + (size_t)l * 64 * 512, d, 64, 512, 0, 512, 64, 0, 0, 1, 0, 0);
        add((const float*)d_in[I_RW_A2] + (size_t)l * 64 * 512, d + 512 * 64, 64, 512, 0, 512, 64, 0, 0, 1, 0, 0);
        add((const float*)d_in[I_RW_G2] + (size_t)l * 128 * 512, d + 2 * 512 * 64, 128, 512, 0, 512, 128, 0, 0, 1, 0, 0);
        if (l == 1) add((const float*)d_in[I_RW_V2], d + 2 * 512 * 64 + 512 * 128, 32, 512, 0, 512, 32, 0, 0, 1, 0, 0);
    }
    c0_end = item;
    add_layer(1);
    a.l1_end = item;
    add((const float*)d_in[I_FFN_G], (bf16_t*)(ws + WS_WGU), 1024, DFF, 0, DFF, 1024, 0, 1, 1, 0, 0);
    add((const float*)d_in[I_FFN_U], (bf16_t*)(ws + WS_WGU), 1024, DFF, 0, DFF, 1024, 128, 1, 1, 0, 0);
    add((const float*)d_in[I_FFN_D], (bf16_t*)(ws + WS_WD), DFF, 1024, 0, 1024, DFF, 0, 0, 1, 0, 0);
    if (nj != NJOBS0) return -1;
    a.items0 = item;
    {
        const int G = grid_blocks;
        auto busy_of = [&](int units) { const int rounds = (units + G - 1) / G; const int b = units - (rounds - 1) * G; return b; };
        a.busyA = busy_of((NTOK / 256) * (NW / 256)); a.busyB = busy_of((NTOK / 256) * (2 * DFF / 256));
        const int capA = (G - a.busyA) * NWAVES * CONV_SLOT_X, capB = (G - a.busyB) * NWAVES * CONV_SLOT_X;
        a.ff_lo = (a.items0 - capA > a.l1_end) ? a.items0 - capA : a.l1_end;
        a.l1_lo = (a.l1_end - capB > c0_end) ? a.l1_end - capB : c0_end;
        a.pad2_ = 0;
    }
    const long long eb = (long long)(MW_EXP_BYTES / 2);
    add((const float*)d_in[I_MOE_G], (bf16_t*)(ws + WS_MW), 1024, DFFE, 0, DFFE, 1024, 0, 1, 8, 1024ll * DFFE, eb);
    add((const float*)d_in[I_MOE_U], (bf16_t*)(ws + WS_MW), 1024, DFFE, 0, DFFE, 1024, 128, 1, 8, 1024ll * DFFE, eb);
    add((const float*)d_in[I_MOE_D], (bf16_t*)(ws + WS_MW) + (size_t)7168 * 1024, DFFE, 1024, 0, 1024, DFFE, 0, 0, 8, (long long)DFFE * 1024, eb);
    if (nj != NJOBS) return -1;
    a.items1 = item - a.items0;
    return 0;
}

extern "C" void kernel_launch(void* const* d_in, const int* in_sizes, int n_in, void* d_out, int out_size, void* d_ws, size_t ws_size, hipStream_t stream) {
    static int grid = 0;
    if (grid == 0) {
        if (n_in != 43 || out_size != NTOK * D || ws_size < WS_END) { fprintf(stderr, "kernel_launch: unexpected shapes n_in %d out %d ws %zu (need %zu)\n", n_in, out_size, ws_size, (size_t)WS_END); grid = -1; return; }
        int dev = 0, cus = 0, per_cu = 0;
        (void)hipGetDevice(&dev); (void)hipDeviceGetAttribute(&cus, hipDeviceAttributeMultiprocessorCount, dev); (void)per_cu;
        if (hipFuncSetAttribute((const void*)mk, hipFuncAttributeMaxDynamicSharedMemorySize, LDS_BYTES) != hipSuccess) { fprintf(stderr, "hipFuncSetAttribute failed\n"); grid = -1; return; }
        (void)hipOccupancyMaxActiveBlocksPerMultiprocessor(&per_cu, (const void*)mk, NTHREADS, LDS_BYTES);
        if (per_cu < 1) { fprintf(stderr, "occupancy query says %d\n", per_cu); per_cu = 1; }
        (void)hipGetLastError();
        grid = cus;
    }
    if (grid < 0) return;
    Args a{};
    for (int i = 0; i < 43; ++i) a.in[i] = (const float*)d_in[i];
    a.out = (float*)d_out; a.ws = (unsigned char*)d_ws;
    if (fill_jobs(a, d_in, (unsigned char*)d_ws, grid) != 0) { fprintf(stderr, "job table mismatch\n"); return; }
    a.cg_seam0 = 0; a.pad_ = 0;
    if (hipMemsetAsync((char*)d_ws + WS_CTL, 0, CTL_ZERO_BYTES, stream) != hipSuccess) { fprintf(stderr, "memset failed\n"); return; }
    void* kargs[] = {&a};
    hipError_t e = hipLaunchCooperativeKernel((const void*)mk, dim3(grid), dim3(NTHREADS), kargs, LDS_BYTES, stream);
    if (e != hipSuccess) fprintf(stderr, "cooperative launch failed: %s\n", hipGetErrorString(e));
}
```
